# Optimizing an MI355X kernel written in HIP

```python
import math
import jax, jax.numpy as jnp
from jax import lax
import numpy as np

D_MODEL = 2048
BATCH = 4
SEQ = 2048
DEPTH = 1

HEAD_DIM = 128
MEM_LEN = 256
ATT_GROUPS = ((128, 1), (512, 4), (2048, 16))
ATT_HEADS_PER_GROUP = 4
N_ATT_GROUPS = len(ATT_GROUPS)
ATT_WIDTH = N_ATT_GROUPS * ATT_HEADS_PER_GROUP * HEAD_DIM
ATT_OUT_WIDTH = ATT_HEADS_PER_GROUP * HEAD_DIM
ATT_BLOCK = 128
HG_HEADS = 8
HG_KEY = 128
HG_VAL = 128
HG_WIDTH = HG_HEADS * HG_KEY
HG_CHUNK = 64
N_BRANCH = 2
IN_WIDTH = 3 * ATT_WIDTH + 4 * HG_WIDTH + N_BRANCH * D_MODEL
CROSS_HEADS = 4
CROSS_WIDTH = CROSS_HEADS * HEAD_DIM
D_FF = int(math.ceil(8 * D_MODEL / 3 / 256) * 256)
RMS_EPS = 1e-6

kernel_name = "hybrid_dilated_attn_hgrn2_gated_block"


def rms_norm(x, w):
    xf = x.astype(jnp.float32)
    y = xf * lax.rsqrt(jnp.mean(xf * xf, axis=-1, keepdims=True) + RMS_EPS)
    return (y * w.astype(jnp.float32)).astype(x.dtype)


def banded_window_attention(q, k, v, window):
    assert window <= ATT_BLOCK
    lead = q.shape[:-2]
    L, dh = q.shape[-2], q.shape[-1]
    nb = -(-L // ATT_BLOCK)
    Lp = nb * ATT_BLOCK
    if Lp != L:
        pad = [(0, 0)] * len(lead) + [(0, Lp - L), (0, 0)]
        q, k, v = jnp.pad(q, pad), jnp.pad(k, pad), jnp.pad(v, pad)
    qb = q.reshape(*lead, nb, ATT_BLOCK, dh)
    kb = k.reshape(*lead, nb, ATT_BLOCK, dh)
    vb = v.reshape(*lead, nb, ATT_BLOCK, dh)
    kk = jnp.concatenate([jnp.concatenate([jnp.zeros_like(kb[..., :1, :, :]), kb[..., :-1, :, :]], axis=-3), kb], axis=-2)
    vv = jnp.concatenate([jnp.concatenate([jnp.zeros_like(vb[..., :1, :, :]), vb[..., :-1, :, :]], axis=-3), vb], axis=-2)
    blk = jnp.arange(nb)[:, None, None] * ATT_BLOCK
    qpos = blk + jnp.arange(ATT_BLOCK)[None, :, None]
    kpos = blk - ATT_BLOCK + jnp.arange(2 * ATT_BLOCK)[None, None, :]
    dist = qpos - kpos
    mask = (dist >= 0) & (dist <= window) & (kpos >= 0)
    s = jnp.einsum('...nqd,...nkd->...nqk', qb, kk).astype(jnp.float32) * (dh ** -0.5)
    s = jnp.where(mask, s, -jnp.inf)
    m = jnp.max(s, axis=-1, keepdims=True)
    p = jnp.exp(s - m)
    l = jnp.sum(p, axis=-1, keepdims=True)
    o = jnp.einsum('...nqk,...nkd->...nqd', (p / l).astype(v.dtype), vv)
    lse = (m + jnp.log(l))[..., 0]
    o = o.reshape(*lead, Lp, dh)[..., :L, :]
    lse = lse.reshape(*lead, Lp)[..., :L]
    return o, lse


def dilated_window_attention(q, k, v, window, dilation):
    B, H, S, dh = q.shape
    L = S // dilation

    def to_residue(t):
        return t.reshape(B, H, L, dilation, dh).transpose(0, 1, 3, 2, 4)

    o, lse = banded_window_attention(to_residue(q), to_residue(k), to_residue(v), window // dilation)
    o = o.transpose(0, 1, 3, 2, 4).reshape(B, H, S, dh)
    lse = lse.transpose(0, 1, 3, 2).reshape(B, H, S)
    return o, lse


def hgrn2_chunked(q, log_f, k, v):
    B, H, S, K = q.shape
    V = v.shape[-1]
    C = HG_CHUNK
    N = S // C
    q, log_f, k = (t.reshape(B, H, N, C, K) for t in (q, log_f, k))
    v = v.reshape(B, H, N, C, V)
    b = jnp.cumsum(log_f, axis=-2)
    b_last = b[..., -1:, :]
    chunk_kv = jnp.einsum('bhnck,bhncv->bhnkv', k * jnp.exp(b_last - b), v)
    decay = jnp.exp(b_last[..., 0, :])

    def step(state, inp):
        dec, kv = inp
        return dec[..., None] * state + kv, state

    _, states = lax.scan(step, jnp.zeros((B, H, K, V), jnp.float32),
                         (jnp.moveaxis(decay, 2, 0), jnp.moveaxis(chunk_kv, 2, 0)))
    states = jnp.moveaxis(states, 0, 2)
    inter = jnp.einsum('bhnck,bhnkv->bhncv', q * jnp.exp(b), states)
    b_ref = b[..., C // 2:C // 2 + 1, :]
    a = jnp.einsum('bhnck,bhnsk->bhncs', q * jnp.exp(b - b_ref), k * jnp.exp(b_ref - b))
    causal = jnp.arange(C)[:, None] >= jnp.arange(C)[None, :]
    a = jnp.where(causal, a, 0.0)
    intra = jnp.einsum('bhncs,bhnsv->bhncv', a, v)
    return (inter + intra).reshape(B, H, S, V)


def setup_inputs(seed: int = 0) -> dict:
    key = jax.random.key(seed)
    ks = jax.random.split(key, 20)
    nrm = lambda k, shape, fan_in: jax.random.normal(k, shape, jnp.float32) * (fan_in ** -0.5)
    gain = lambda k, shape: 1.0 + 0.02 * jax.random.normal(k, shape, jnp.float32)
    return {
        "x": jax.random.normal(ks[0], (BATCH, SEQ, D_MODEL), jnp.float32),
        "mem": jax.random.normal(ks[1], (BATCH, MEM_LEN, D_MODEL), jnp.float32),
        "ln_mix_w": gain(ks[2], (DEPTH, D_MODEL)),
        "w_in": nrm(ks[3], (DEPTH, D_MODEL, IN_WIDTH), D_MODEL),
        "hg_norm_w": gain(ks[4], (DEPTH, HG_VAL)),
        "hg_lower_bounds": 0.1 * jax.random.normal(ks[5], (DEPTH + 1, HG_WIDTH), jnp.float32),
        "w_branch_a": nrm(ks[6], (DEPTH, ATT_OUT_WIDTH, D_MODEL), ATT_OUT_WIDTH),
        "w_branch_b": nrm(ks[7], (DEPTH, HG_WIDTH, D_MODEL), HG_WIDTH),
        "w_out": nrm(ks[8], (DEPTH, D_MODEL, D_MODEL), D_MODEL),
        "ln_cross_w": gain(ks[9], (DEPTH, D_MODEL)),
        "ln_mem_w": gain(ks[10], (DEPTH, D_MODEL)),
        "wq_cross": nrm(ks[11], (DEPTH, D_MODEL, CROSS_WIDTH), D_MODEL),
        "wkv_cross": nrm(ks[12], (DEPTH, D_MODEL, 2 * CROSS_WIDTH), D_MODEL),
        "wo_cross": nrm(ks[13], (DEPTH, CROSS_WIDTH, D_MODEL), CROSS_WIDTH),
        "ln_ffn_w": gain(ks[14], (DEPTH, D_MODEL)),
        "w1": nrm(ks[15], (DEPTH, D_MODEL, D_FF), D_MODEL),
        "w3": nrm(ks[16], (DEPTH, D_MODEL, D_FF), D_MODEL),
        "w2": nrm(ks[17], (DEPTH, D_FF, D_MODEL), D_FF),
        "ln_final_w": gain(ks[18], (D_MODEL,)),
    }


def reference(x, mem, ln_mix_w, w_in, hg_norm_w, hg_lower_bounds, w_branch_a, w_branch_b, w_out,
              ln_cross_w, ln_mem_w, wq_cross, wkv_cross, wo_cross, ln_ffn_w, w1, w3, w2, ln_final_w):
    B, S, D = x.shape
    M = mem.shape[1]
    lower_bounds = jnp.cumsum(jax.nn.softmax(hg_lower_bounds.astype(jnp.float32), axis=0), axis=0)
    for l in range(DEPTH):
        h = rms_norm(x, ln_mix_w[l])
        proj = h @ w_in[l]
        q_a, k_a, v_a, q_h, f_h, i_h, g_h, gates = jnp.split(
            proj, np.cumsum([ATT_WIDTH] * 3 + [HG_WIDTH] * 4).tolist(), axis=-1)

        def att_heads(t):
            return t.reshape(B, S, N_ATT_GROUPS, ATT_HEADS_PER_GROUP, HEAD_DIM).transpose(0, 2, 3, 1, 4)
        qa, ka, va = att_heads(q_a), att_heads(k_a), att_heads(v_a)
        outs, lses = [], []
        for g, (window, dilation) in enumerate(ATT_GROUPS):
            o_g, lse_g = dilated_window_attention(qa[:, g], ka[:, g], va[:, g], window, dilation)
            outs.append(o_g)
            lses.append(lse_g)
        outs = jnp.stack(outs, axis=1)
        alpha = jax.nn.softmax(jnp.stack(lses, axis=1), axis=1)
        o_att = jnp.sum(alpha[..., None].astype(outs.dtype) * outs, axis=1)
        o_att = o_att.transpose(0, 2, 1, 3).reshape(B, S, ATT_OUT_WIDTH)

        def hg_heads(t):
            return t.reshape(B, S, HG_HEADS, HG_KEY).transpose(0, 2, 1, 3).astype(jnp.float32)
        lb = lower_bounds[l].reshape(HG_HEADS, HG_KEY)[None, :, None, :]
        f = lb + (1.0 - lb) * jax.nn.sigmoid(hg_heads(f_h))
        o_hg = hgrn2_chunked(jax.nn.silu(hg_heads(q_h)), jnp.log(f), 1.0 - f, hg_heads(i_h))
        o_hg = o_hg * lax.rsqrt(jnp.mean(o_hg * o_hg, axis=-1, keepdims=True) + RMS_EPS) * hg_norm_w[l].astype(jnp.float32)
        o_hg = (o_hg * jax.nn.silu(hg_heads(g_h))).transpose(0, 2, 1, 3).reshape(B, S, HG_WIDTH).astype(x.dtype)

        gate_a, gate_b = jnp.split(jax.nn.sigmoid(gates), N_BRANCH, axis=-1)
        merged = gate_a * (o_att @ w_branch_a[l]) + gate_b * (o_hg @ w_branch_b[l])
        x = x + merged @ w_out[l]

        hc = rms_norm(x, ln_cross_w[l])
        mn = rms_norm(mem, ln_mem_w[l])
        qc = (hc @ wq_cross[l]).reshape(B, S, CROSS_HEADS, HEAD_DIM)
        kvc = (mn @ wkv_cross[l]).reshape(B, M, 2, CROSS_HEADS, HEAD_DIM)
        sc = jnp.einsum('bshd,bmhd->bhsm', qc, kvc[:, :, 0]).astype(jnp.float32) * (HEAD_DIM ** -0.5)
        pc = jax.nn.softmax(sc, axis=-1).astype(x.dtype)
        oc = jnp.einsum('bhsm,bmhd->bshd', pc, kvc[:, :, 1]).reshape(B, S, CROSS_WIDTH)
        x = x + oc @ wo_cross[l]

        hf = rms_norm(x, ln_ffn_w[l])
        x = x + (jax.nn.silu(hf @ w1[l]) * (hf @ w3[l])) @ w2[l]
    return rms_norm(x, ln_final_w)
```

```cpp
#include <hip/hip_runtime.h>
#include <hip/hip_cooperative_groups.h>
#include <cstdio>
#include <cstdint>
#include <cmath>
namespace cg = cooperative_groups;
namespace pg8 {
#define PG8_LAS __attribute__((address_space(3)))
typedef unsigned short bf16_t;
typedef short bf16x8 __attribute__((ext_vector_type(8)));
typedef float f32x4 __attribute__((ext_vector_type(4)));
typedef unsigned u32x4 __attribute__((ext_vector_type(4)));
constexpr int BM = 256, BK = 64, HALF = 128, HTB = HALF * BK * 2  , STAGE_BYTES = 8 * HTB, NXCD = 8, WGM = 8;

__host__ __device__ __forceinline__ int lds_byte(int r, int c) { const int st = (r >> 4) * 2 + (c >> 5), rr = r & 15, cc = c & 31, ob = rr * 64 + cc * 2; return st * 1024 + (ob ^ (((ob >> 9) & 1) << 5)); }
__host__ __device__ __forceinline__ void stage_rc(int b, int& R, int& C) { const int st = b / 1024, sb = b % 1024, swz = sb ^ (((sb >> 9) & 1) << 5); R = (st >> 1) * 16 + swz / 64; C = (st & 1) * 32 + (swz % 64) / 2; }
__host__ __device__ __forceinline__ int perm32(int rho) { const int n = rho >> 4, i = rho & 15; return 8 * (i >> 2) + 4 * n + (i & 3); }

struct Unit { int pm, pn; };
struct Gemm { const bf16_t* A; const bf16_t* Bt; int M, N, K; };

struct StaticOrder {
    int nM, nN, nwg, G, c;
    __host__ __device__ void init(int M, int N, int G_, int c_) { nM = M / BM; nN = N / BM; nwg = nM * nN; G = G_; c = c_; }
    __host__ __device__ bool next(int i, Unit& u) const {
        const long L = (long)i * G + c; if (L >= nwg) return false;
        int wgid = (int)L; { const int q = nwg / NXCD, r = nwg % NXCD, xcd = wgid % NXCD, off = wgid / NXCD; wgid = (xcd < r ? xcd * (q + 1) : r * (q + 1) + (xcd - r) * q) + off; }
        const int nig = WGM * nN, gid = wgid / nig, fm = gid * WGM, gsz = (nM - fm) < WGM ? (nM - fm) : WGM;
        u.pm = fm + ((wgid % nig) % gsz); u.pn = (wgid % nig) / gsz; return true;
    }
    __device__ __forceinline__ void a_ready(const Unit&) const {}
    __device__ __forceinline__ void done(const Unit&) const {}
};

__device__ __forceinline__ unsigned cvt_pk_bf16(float lo, float hi) { unsigned r; asm volatile("v_cvt_pk_bf16_f32 %0, %1, %2" : "=v"(r) : "v"(lo), "v"(hi)); return r; }
typedef float f32x2 __attribute__((ext_vector_type(2)));
typedef unsigned u32x2 __attribute__((ext_vector_type(2)));
__device__ __forceinline__ float sigm(float x) { return __builtin_amdgcn_rcpf(1.f + __expf(-x)); }
__device__ __forceinline__ float silu(float x) { return x * sigm(x); }
__device__ __forceinline__ float bflo(unsigned w) { return __uint_as_float(w << 16); }
__device__ __forceinline__ float bfhi(unsigned w) { return __uint_as_float(w & 0xffff0000u); }
constexpr float RMS_EPS_ = 1e-6f;

struct Order1 {
    StaticOrder so; int nmain;
    __host__ __device__ void init(int G_, int c_) { so.init(8192, 12800, G_, c_); nmain = so.nwg; }
    __host__ __device__ bool next(int i, Unit& u) const {
        const long L = (long)i * so.G + so.c;
        if (L < nmain) return so.next(i, u);
        const int e = (int)(L - nmain); if (e >= 16) return false;
        u.pm = 32 + (e >> 2); u.pn = 50 + (e & 3); return true;
    }
    __device__ __forceinline__ void a_ready(const Unit&) const {}
    __device__ __forceinline__ void done(const Unit&) const {}
};

struct EpiProj {
    static constexpr bool PERM = true, AFTER_DRAIN = false;
    bf16_t* qkv; bf16_t* hg; bf16_t* gates; bf16_t* kvc;
    __device__ __forceinline__ void operator()(const f32x4 (&acc)[2][2][4][2], const Unit& u, int wr, int wc, int fr, int fq) const {
        const int pn = u.pn; bf16_t* base; int ldc, colt, act, rowt = u.pm * BM;
        if (pn < 18) { base = qkv; ldc = 4608; colt = pn * 256; act = 0; }
        else if (pn < 34) { base = hg; ldc = 4096; colt = (pn - 18) * 256; const int s = (pn - 18) >> 2; act = (s == 0 || s == 3) ? 1 : 0; }
        else if (pn < 50) { base = gates; ldc = 4096; colt = (pn - 34) * 256; act = 2; }
        else { base = kvc; ldc = 1024; colt = (pn - 50) * 256; act = 0; rowt -= 8192; }
        const int row0 = rowt + wr * 64 + fr, col0 = colt + wc * 32 + 8 * fq;
#pragma unroll
        for (int ai = 0; ai < 2; ++ai)
#pragma unroll
            for (int m = 0; m < 4; ++m) { bf16_t* rowp = base + (size_t)(row0 + ai * HALF + m * 16) * ldc + col0;
#pragma unroll
                for (int bj = 0; bj < 2; ++bj) { f32x4 v0 = acc[ai][bj][m][0], v1 = acc[ai][bj][m][1];
                    if (act == 1) {
#pragma unroll
                        for (int e = 0; e < 4; ++e) { v0[e] = silu(v0[e]); v1[e] = silu(v1[e]); } }
                    else if (act == 2) {
#pragma unroll
                        for (int e = 0; e < 4; ++e) { v0[e] = sigm(v0[e]); v1[e] = sigm(v1[e]); } }
                    u32x4 w; w.x = cvt_pk_bf16(v0[0], v0[1]); w.y = cvt_pk_bf16(v0[2], v0[3]); w.z = cvt_pk_bf16(v1[0], v1[1]); w.w = cvt_pk_bf16(v1[2], v1[3]);
                    *(u32x4*)(rowp + bj * HALF) = w; } }
    }
};

struct EpiGateA {
    static constexpr bool PERM = true, AFTER_DRAIN = false;
    const bf16_t* gates; float* tmp;
    __device__ __forceinline__ void operator()(const f32x4 (&acc)[2][2][4][2], const Unit& u, int wr, int wc, int fr, int fq) const {
        const int row0 = u.pm * BM + wr * 64 + fr, col0 = u.pn * BM + wc * 32 + 8 * fq;
#pragma unroll
        for (int ai = 0; ai < 2; ++ai)
#pragma unroll
            for (int m = 0; m < 4; ++m) { const size_t r = (size_t)(row0 + ai * HALF + m * 16);
#pragma unroll
                for (int bj = 0; bj < 2; ++bj) { const int c = col0 + bj * HALF; const u32x4 g = *(const u32x4*)(gates + r * 4096 + c);
                    f32x4 o0 = acc[ai][bj][m][0], o1 = acc[ai][bj][m][1];
                    o0[0] *= bflo(g.x); o0[1] *= bfhi(g.x); o0[2] *= bflo(g.y); o0[3] *= bfhi(g.y); o1[0] *= bflo(g.z); o1[1] *= bfhi(g.z); o1[2] *= bflo(g.w); o1[3] *= bfhi(g.w);
                    *(f32x4*)(tmp + r * 2048 + c) = o0; *(f32x4*)(tmp + r * 2048 + c + 4) = o1; } }
    }
};
struct EpiGateB {
    static constexpr bool PERM = true, AFTER_DRAIN = false;
    const bf16_t* gates; const float* tmp; bf16_t* out;
    __device__ __forceinline__ void operator()(const f32x4 (&acc)[2][2][4][2], const Unit& u, int wr, int wc, int fr, int fq) const {
        const int row0 = u.pm * BM + wr * 64 + fr, col0 = u.pn * BM + wc * 32 + 8 * fq;
#pragma unroll
        for (int ai = 0; ai < 2; ++ai)
#pragma unroll
            for (int m = 0; m < 4; ++m) { const size_t r = (size_t)(row0 + ai * HALF + m * 16);
#pragma unroll
                for (int bj = 0; bj < 2; ++bj) { const int c = col0 + bj * HALF; const u32x4 g = *(const u32x4*)(gates + r * 4096 + c);
                    f32x4 o0 = *(const f32x4*)(tmp + r * 2048 + c), o1 = *(const f32x4*)(tmp + r * 2048 + c + 4); const f32x4 a0 = acc[ai][bj][m][0], a1 = acc[ai][bj][m][1];
                    o0[0] += a0[0] * bflo(g.x); o0[1] += a0[1] * bfhi(g.x); o0[2] += a0[2] * bflo(g.y); o0[3] += a0[3] * bfhi(g.y);
                    o1[0] += a1[0] * bflo(g.z); o1[1] += a1[1] * bfhi(g.z); o1[2] += a1[2] * bflo(g.w); o1[3] += a1[3] * bfhi(g.w);
                    u32x4 w; w.x = cvt_pk_bf16(o0[0], o0[1]); w.y = cvt_pk_bf16(o0[2], o0[3]); w.z = cvt_pk_bf16(o1[0], o1[1]); w.w = cvt_pk_bf16(o1[2], o1[3]);
                    *(u32x4*)(out + r * 2048 + c) = w; } }
    }
};
template <bool RES_BF16> struct EpiRes {
    static constexpr bool PERM = true, AFTER_DRAIN = false;
    const void* resid; bf16_t* outb; float* sumsq;
    __device__ __forceinline__ void operator()(const f32x4 (&acc)[2][2][4][2], const Unit& u, int wr, int wc, int fr, int fq) const {
        const int row0 = u.pm * BM + wr * 64 + fr, col0 = u.pn * BM + wc * 32 + 8 * fq;
#pragma unroll
        for (int ai = 0; ai < 2; ++ai)
#pragma unroll
            for (int m = 0; m < 4; ++m) { const size_t r = (size_t)(row0 + ai * HALF + m * 16); float ss = 0.f;
#pragma unroll
                for (int bj = 0; bj < 2; ++bj) { const int c = col0 + bj * HALF; f32x4 o0, o1;
                    if (RES_BF16) { const u32x4 g = *(const u32x4*)((const bf16_t*)resid + r * 2048 + c);
                        o0 = (f32x4){bflo(g.x), bfhi(g.x), bflo(g.y), bfhi(g.y)} + acc[ai][bj][m][0]; o1 = (f32x4){bflo(g.z), bfhi(g.z), bflo(g.w), bfhi(g.w)} + acc[ai][bj][m][1]; }
                    else { o0 = *(const f32x4*)((const float*)resid + r * 2048 + c) + acc[ai][bj][m][0]; o1 = *(const f32x4*)((const float*)resid + r * 2048 + c + 4) + acc[ai][bj][m][1]; }
                    ss += (o0[0] * o0[0] + o0[1] * o0[1]) + (o0[2] * o0[2] + o0[3] * o0[3]) + (o1[0] * o1[0] + o1[1] * o1[1]) + (o1[2] * o1[2] + o1[3] * o1[3]);
                    u32x4 w; w.x = cvt_pk_bf16(o0[0], o0[1]); w.y = cvt_pk_bf16(o0[2], o0[3]); w.z = cvt_pk_bf16(o1[0], o1[1]); w.w = cvt_pk_bf16(o1[2], o1[3]); *(u32x4*)(outb + r * 2048 + c) = w; }
                ss += __shfl_xor(ss, 16); ss += __shfl_xor(ss, 32);
                if (fq == 0) atomicAdd(sumsq + r, ss); }
    }
};
struct EpiQ {
    static constexpr bool PERM = true, AFTER_DRAIN = false;
    const float* sumsq; bf16_t* out; float scale;
    __device__ __forceinline__ void operator()(const f32x4 (&acc)[2][2][4][2], const Unit& u, int wr, int wc, int fr, int fq) const {
        const int row0 = u.pm * BM + wr * 64 + fr, col0 = u.pn * BM + wc * 32 + 8 * fq;
#pragma unroll
        for (int ai = 0; ai < 2; ++ai)
#pragma unroll
            for (int m = 0; m < 4; ++m) { const size_t r = (size_t)(row0 + ai * HALF + m * 16); const float rs = rsqrtf(sumsq[r] * (1.f / 2048.f) + RMS_EPS_) * scale;
#pragma unroll
                for (int bj = 0; bj < 2; ++bj) { const int c = col0 + bj * HALF; const f32x4 v0 = acc[ai][bj][m][0] * rs, v1 = acc[ai][bj][m][1] * rs;
                    u32x4 w; w.x = cvt_pk_bf16(v0[0], v0[1]); w.y = cvt_pk_bf16(v0[2], v0[3]); w.z = cvt_pk_bf16(v1[0], v1[1]); w.w = cvt_pk_bf16(v1[2], v1[3]);
                    *(u32x4*)(out + r * 512 + c) = w; } }
    }
};
struct EpiSwiGLU {
    static constexpr bool PERM = true, AFTER_DRAIN = false;
    const float* sumsq; bf16_t* out;
    __device__ __forceinline__ void operator()(const f32x4 (&acc)[2][2][4][2], const Unit& u, int wr, int wc, int fr, int fq) const {
        const int row0 = u.pm * BM + wr * 64 + fr, col0 = u.pn * HALF + wc * 32 + 8 * fq;
#pragma unroll
        for (int ai = 0; ai < 2; ++ai)
#pragma unroll
            for (int m = 0; m < 4; ++m) { const size_t r = (size_t)(row0 + ai * HALF + m * 16); const float rs = rsqrtf(sumsq[r] * (1.f / 2048.f) + RMS_EPS_);
                float g[8];
#pragma unroll
                for (int n = 0; n < 2; ++n)
#pragma unroll
                    for (int e = 0; e < 4; ++e) g[4 * n + e] = silu(acc[ai][0][m][n][e] * rs) * (acc[ai][1][m][n][e] * rs);
                u32x4 w; w.x = cvt_pk_bf16(g[0], g[1]); w.y = cvt_pk_bf16(g[2], g[3]); w.z = cvt_pk_bf16(g[4], g[5]); w.w = cvt_pk_bf16(g[6], g[7]);
                *(u32x4*)(out + r * 5632 + col0) = w; }
    }
};
struct Unit2 : Unit { const char* A; const char* B; int nt; int mode, slot, aux, pstr; };
__device__ __forceinline__ void part_store(const f32x4 (&acc)[2][2][4][2], float* part, unsigned* flags, const Unit2& u, int tid, int lane) {
    float* p = part + ((size_t)(u.slot * u.pstr + u.aux) * 32) * 2048 + (size_t)tid * 4;
#pragma unroll
    for (int ai = 0; ai < 2; ++ai)
#pragma unroll
        for (int bj = 0; bj < 2; ++bj)
#pragma unroll
            for (int m = 0; m < 4; ++m)
#pragma unroll
                for (int n = 0; n < 2; ++n) *(f32x4*)(p + (size_t)(((ai * 2 + bj) * 4 + m) * 2 + n) * 2048) = acc[ai][bj][m][n];
    __builtin_amdgcn_fence(__ATOMIC_RELEASE, "agent");
    asm volatile("s_waitcnt vmcnt(0)" ::: "memory");
    if (lane == 0) __hip_atomic_fetch_add(flags + 16 * u.slot, 1u, __ATOMIC_RELAXED, __HIP_MEMORY_SCOPE_AGENT);
}
__device__ __forceinline__ void part_wait_add(f32x4 (&acc)[2][2][4][2], const float* part, unsigned* flags, const Unit2& u, int tid, int lane) {
    const int np = (u.mode == 2) ? u.aux : 0;
    if (np > 0) { const unsigned want = 8u * (unsigned)np; unsigned spins = 0;
        for (;;) { unsigned v = 0; if (lane == 0) v = __hip_atomic_load(flags + 16 * u.slot, __ATOMIC_RELAXED, __HIP_MEMORY_SCOPE_AGENT);
            if ((unsigned)__builtin_amdgcn_readfirstlane(v) >= want) break;
            __builtin_amdgcn_s_sleep(1); if (++spins > (1u << 20)) break; }
        __builtin_amdgcn_fence(__ATOMIC_ACQUIRE, "agent"); }
    for (int pi = 0; pi < np; ++pi) { const float* p = part + ((size_t)(u.slot * u.pstr + pi) * 32) * 2048 + (size_t)tid * 4;
#pragma unroll
        for (int ai = 0; ai < 2; ++ai)
#pragma unroll
            for (int bj = 0; bj < 2; ++bj) {
#pragma unroll
                for (int m = 0; m < 4; ++m)
#pragma unroll
                    for (int n = 0; n < 2; ++n) acc[ai][bj][m][n] += *(const f32x4*)(p + (size_t)(((ai * 2 + bj) * 4 + m) * 2 + n) * 2048);
                asm volatile("" ::: "memory"); } }
}

template <class Epi, class Sched>
__device__ __forceinline__ void gemm_phase2(PG8_LAS unsigned char* lds, const Sched& S, const Epi& E, float* part, unsigned* flags, const unsigned ld2  ) {
    const int tid = threadIdx.x, wid = __builtin_amdgcn_readfirstlane(tid >> 6), lane = tid & 63, wr = wid >> 2, wc = wid & 3, fr = lane & 15, fq = lane >> 4;
    unsigned voffA[2], voffB[2];
#pragma unroll
    for (int i = 0; i < 2; ++i) { int R, C; stage_rc(tid * 16 + i * 8192, R, C); const int Rb = Epi::PERM ? ((R & ~31) + perm32(R & 31)) : R;
        voffA[i] = (unsigned)R * ld2 + (unsigned)C * 2u; voffB[i] = (unsigned)Rb * ld2 + (unsigned)C * 2u; }
    const size_t kstep = (size_t)(BK * 2);
    const size_t hs = (size_t)HALF * ld2;
    const unsigned ldsw = (unsigned)wid * 1024u;
    const int aoff = lds_byte(wr * 64 + fr, fq * 8), boff = lds_byte(wc * 32 + fr, fq * 8);
#define PG8_SA(b, h) (((b) * 2 + (h)) * HTB)
#define PG8_SB(b, h) ((4 + (b) * 2 + (h)) * HTB)
#define PG8_STAGE(bufoff, gbase, voff) do { _Pragma("unroll") for (int _i = 0; _i < 2; ++_i) \
        __builtin_amdgcn_global_load_lds((const unsigned*)((const char*)(gbase) + (voff)[_i]), (PG8_LAS unsigned*)(lds + (bufoff) + ldsw + _i * 8192), 16, 0, 0); } while (0)
#define PG8_LDA(dst, b, h) do { _Pragma("unroll") for (int m = 0; m < 4; ++m) _Pragma("unroll") for (int k = 0; k < 2; ++k) dst[m][k] = *(const PG8_LAS bf16x8*)(lds + PG8_SA(b, h) + aoff + m * 2048 + k * 1024); } while (0)
#define PG8_LDB(dst, b, h) do { _Pragma("unroll") for (int n = 0; n < 2; ++n) _Pragma("unroll") for (int k = 0; k < 2; ++k) dst[n][k] = *(const PG8_LAS bf16x8*)(lds + PG8_SB(b, h) + boff + n * 2048 + k * 1024); } while (0)
#define PG8_MMA(ai, bj, At, Bt) do { __builtin_amdgcn_s_setprio(1); _Pragma("unroll") for (int m = 0; m < 4; ++m) _Pragma("unroll") for (int n = 0; n < 2; ++n) _Pragma("unroll") for (int k = 0; k < 2; ++k) \
        acc[ai][bj][m][n] = __builtin_amdgcn_mfma_f32_16x16x32_bf16(Bt[n][k], At[m][k], acc[ai][bj][m][n], 0, 0, 0); __builtin_amdgcn_s_setprio(0); } while (0)
#define PG8_WAIT_V(n) asm volatile("s_waitcnt vmcnt(" #n ")" ::: "memory")
#define PG8_WAIT_L(n) asm volatile("s_waitcnt lgkmcnt(" #n ")" ::: "memory")
#define PG8_BAR __builtin_amdgcn_s_barrier()
#define PG8_SCHED __builtin_amdgcn_sched_barrier(0)
    Unit2 cur, nxt; int ui = 0;
    if (!S.next(0, cur)) return;
    f32x4 acc[2][2][4][2];
#pragma unroll
    for (int a = 0; a < 2; ++a)
#pragma unroll
        for (int b = 0; b < 2; ++b)
#pragma unroll
            for (int m = 0; m < 4; ++m)
#pragma unroll
                for (int n = 0; n < 2; ++n) acc[a][b][m][n] = (f32x4){0.f, 0.f, 0.f, 0.f};
    bf16x8 At[4][2], B0[2][2], B1[2][2];
    const char* cA = cur.A; const char* cB = cur.B;
    {
        PG8_STAGE(PG8_SB(0, 0), cB, voffB); PG8_STAGE(PG8_SB(0, 1), cB + hs, voffB); PG8_STAGE(PG8_SA(0, 0), cA, voffA); PG8_STAGE(PG8_SA(0, 1), cA + hs, voffA);
        if (wr == 1) PG8_BAR;
        PG8_WAIT_V(2); PG8_BAR;
        PG8_STAGE(PG8_SB(1, 0), cB + kstep, voffB); PG8_STAGE(PG8_SA(1, 0), cA + kstep, voffA); PG8_STAGE(PG8_SB(1, 1), cB + hs + kstep, voffB);
        PG8_WAIT_V(6); PG8_BAR;
    }
    for (;;) {
        const bool has_next = S.next(ui + 1, nxt);
        const char* nA = has_next ? nxt.A : cA; const char* nB = has_next ? nxt.B : cB;
        const int nt = cur.nt;
        for (int t = 0; t < nt; t += 2) {
            const bool last = (t == nt - 2);
            const char* a1 = cA + (size_t)(t + 1) * kstep;
            const char* a2 = last ? nA : cA + (size_t)(t + 2) * kstep; const char* b2 = last ? nB : cB + (size_t)(t + 2) * kstep;
            const char* a3 = a2 + kstep; const char* b3 = b2 + kstep;
            PG8_LDB(B0, 0, 0); PG8_LDB(B1, 0, 1); PG8_SCHED; PG8_LDA(At, 0, 0); PG8_STAGE(PG8_SA(1, 1), a1 + hs, voffA);
            PG8_WAIT_V(8); PG8_WAIT_L(0); PG8_BAR; PG8_MMA(0, 0, At, B0); PG8_MMA(0, 1, At, B1); PG8_BAR; PG8_SCHED;
            PG8_LDA(At, 0, 1); PG8_STAGE(PG8_SB(0, 0), b2, voffB); PG8_STAGE(PG8_SB(0, 1), b2 + hs, voffB); PG8_STAGE(PG8_SA(0, 0), a2, voffA);
            PG8_WAIT_V(8); PG8_WAIT_L(0); PG8_BAR; PG8_MMA(1, 0, At, B0); PG8_MMA(1, 1, At, B1); PG8_BAR; PG8_SCHED;
            PG8_LDB(B0, 1, 0); PG8_LDB(B1, 1, 1); PG8_SCHED; PG8_LDA(At, 1, 0); PG8_STAGE(PG8_SA(0, 1), a2 + hs, voffA);
            PG8_WAIT_V(8); PG8_WAIT_L(0); PG8_BAR; PG8_MMA(0, 0, At, B0); PG8_MMA(0, 1, At, B1); PG8_BAR; PG8_SCHED;
            PG8_LDA(At, 1, 1); PG8_STAGE(PG8_SB(1, 0), b3, voffB); PG8_STAGE(PG8_SB(1, 1), b3 + hs, voffB); PG8_STAGE(PG8_SA(1, 0), a3, voffA);
            PG8_WAIT_V(8); PG8_WAIT_L(0); PG8_BAR; PG8_MMA(1, 0, At, B0); PG8_MMA(1, 1, At, B1); PG8_BAR; PG8_SCHED;
        }
        if (wr == 0) PG8_BAR;
        {
            int tid_ = tid, lane_ = lane, fr_ = fr, fq_ = fq; asm volatile("" : "+v"(tid_), "+v"(lane_), "+v"(fr_), "+v"(fq_));
            E(acc, cur, wr, wc, fr_, fq_); }
        if (!has_next) break;
        if (cur.mode != 3) {
#pragma unroll
            for (int a = 0; a < 2; ++a)
#pragma unroll
                for (int b = 0; b < 2; ++b)
#pragma unroll
                    for (int m = 0; m < 4; ++m)
#pragma unroll
                        for (int n = 0; n < 2; ++n) acc[a][b][m][n] = (f32x4){0.f, 0.f, 0.f, 0.f};
        }
        cur = nxt; cA = nA; cB = nB; ++ui;
        if (wr == 1) PG8_BAR;
    }
    PG8_WAIT_V(0);
    PG8_BAR;
#undef PG8_SA
#undef PG8_SB
#undef PG8_STAGE
#undef PG8_LDA
#undef PG8_LDB
#undef PG8_MMA
#undef PG8_WAIT_V
#undef PG8_WAIT_L
#undef PG8_BAR
#undef PG8_SCHED
}

__device__ __forceinline__ void unit_of(int L, int nM, int nN, int& pm, int& pn) {
    const int nwg = nM * nN;
    if (L >= nwg) { const int e = L - nwg; pm = nM + (e >> 2); pn = nN + (e & 3); return; }
    int wgid = L; { const int q = nwg / NXCD, r = nwg % NXCD, xcd = wgid % NXCD, off = wgid / NXCD; wgid = (xcd < r ? xcd * (q + 1) : r * (q + 1) + (xcd - r) * q) + off; }
    const int nig = WGM * nN, gid = wgid / nig, fm = gid * WGM, gsz = (nM - fm) < WGM ? (nM - fm) : WGM;
    pm = fm + ((wgid % nig) % gsz); pn = (wgid % nig) / gsz;
}
struct SplitOrder {
    const bf16_t* A; const bf16_t* B; int K, nM, nN, U, G, c, nfull, tail, ways;
    __device__ __forceinline__ void init(const bf16_t* A_, const bf16_t* B_, int M, int N, int K_, int nextra, int G_, int c_) {
        A = A_; B = B_; K = K_; nM = M / BM; nN = N / BM; U = nM * nN + nextra; G = G_; c = c_; nfull = U / G; tail = U - nfull * G;
        ways = 1;
    }
    __device__ __forceinline__ bool next(int i, Unit2& u) const {
        int L, kt0 = 0, ntu = K / BK; u.mode = 0; u.slot = 0; u.aux = 0; u.pstr = ways - 1;
        if (i < nfull) L = i * G + c;
        else if (i == nfull && c < tail * ways) { const int j = c % tail, p = c / tail; L = nfull * G + j;
            if (ways > 1) { ntu = (K / BK) / ways; kt0 = p * ntu; u.mode = (p == 0) ? 2 : 1; u.slot = j; u.aux = (p == 0) ? ways - 1 : p - 1; } }
        else return false;
        unit_of(L, nM, nN, u.pm, u.pn);
        u.A = (const char*)(A + (size_t)u.pm * BM * K + (size_t)kt0 * BK); u.B = (const char*)(B + (size_t)u.pn * BM * K + (size_t)kt0 * BK); u.nt = ntu;
        return true;
    }
};
struct DeferOrder {
    const bf16_t* A; const bf16_t* B; int K, d0, d1, step;
    __device__ __forceinline__ bool next(int i, Unit2& u) const {
        const int d = d0 + i * step; if (d >= d1) return false;
        if (d < 64) { u.pm = d >> 1; u.pn = 48 + (d & 1); } else { const int e = d - 64; u.pm = 32 + (e >> 2); u.pn = 50 + (e & 3); }
        u.mode = 0; u.slot = 0; u.aux = 0; u.pstr = 0; u.nt = K / BK;
        u.A = (const char*)(A + (size_t)u.pm * BM * K); u.B = (const char*)(B + (size_t)u.pn * BM * K);
        return true;
    }
};
struct ChainOrder {
    const bf16_t *A, *B; int K, nt1, nM, nN, G, c;
    __device__ __forceinline__ bool next(int i, Unit2& u) const {
        const int L = (i >> 1) * G + c; if (L >= nM * nN) return false;
        unit_of(L, nM, nN, u.pm, u.pn); u.slot = 0; u.aux = 0; u.pstr = 0;
        const int kt0 = (i & 1) ? nt1 : 0; u.nt = (i & 1) ? K / BK - nt1 : nt1; u.mode = (i & 1) ? 0 : 3;
        u.A = (const char*)(A + (size_t)u.pm * BM * K + (size_t)kt0 * BK); u.B = (const char*)(B + (size_t)u.pn * BM * K + (size_t)kt0 * BK);
        return true;
    }
};
struct EpiFinal {
    static constexpr bool PERM = true, AFTER_DRAIN = false;
    const bf16_t* resid; float* out; float* sumsq; const float* wf; unsigned* cnt;
    __device__ __forceinline__ void operator()(f32x4 (&acc)[2][2][4][2], const Unit2& u, int wr, int wc, int fr, int fq) const {
        const int row0 = u.pm * BM + wr * 64 + fr, col0 = u.pn * BM + wc * 32 + 8 * fq;
#pragma unroll
        for (int ai = 0; ai < 2; ++ai)
#pragma unroll
            for (int m = 0; m < 4; ++m) { const size_t r = (size_t)(row0 + ai * HALF + m * 16); float ss = 0.f;
#pragma unroll
                for (int bj = 0; bj < 2; ++bj) { const int c = col0 + bj * HALF; const u32x4 g = *(const u32x4*)(resid + r * 2048 + c);
                    const f32x4 o0 = (f32x4){bflo(g.x), bfhi(g.x), bflo(g.y), bfhi(g.y)} + acc[ai][bj][m][0], o1 = (f32x4){bflo(g.z), bfhi(g.z), bflo(g.w), bfhi(g.w)} + acc[ai][bj][m][1];
                    acc[ai][bj][m][0] = o0; acc[ai][bj][m][1] = o1;
                    ss += (o0[0] * o0[0] + o0[1] * o0[1]) + (o0[2] * o0[2] + o0[3] * o0[3]) + (o1[0] * o1[0] + o1[1] * o1[1]) + (o1[2] * o1[2] + o1[3] * o1[3]); }
                ss += __shfl_xor(ss, 16); ss += __shfl_xor(ss, 32);
                if (fq == 0) atomicAdd(sumsq + r, ss); }
        asm volatile("s_waitcnt vmcnt(0)" ::: "memory");
        const int lane = fq * 16 + fr;
        if (lane == 0) __hip_atomic_fetch_add(cnt + 16 * u.pm, 1u, __ATOMIC_RELAXED, __HIP_MEMORY_SCOPE_AGENT);
        { unsigned spins = 0;
          for (;;) { unsigned v = 0; if (lane == 0) v = __hip_atomic_load(cnt + 16 * u.pm, __ATOMIC_RELAXED, __HIP_MEMORY_SCOPE_AGENT);
              if ((unsigned)__builtin_amdgcn_readfirstlane(v) >= 64u) break;
              __builtin_amdgcn_s_sleep(2); if (++spins > (1u << 20)) break; } }
#pragma unroll
        for (int ai = 0; ai < 2; ++ai)
#pragma unroll
            for (int m = 0; m < 4; ++m) { const size_t r = (size_t)(row0 + ai * HALF + m * 16);
                const float rs = rsqrtf(__hip_atomic_load(sumsq + r, __ATOMIC_RELAXED, __HIP_MEMORY_SCOPE_AGENT) * (1.f / 2048.f) + RMS_EPS_);
#pragma unroll
                for (int bj = 0; bj < 2; ++bj) { const int c = col0 + bj * HALF; const f32x4 w0 = *(const f32x4*)(wf + c), w1 = *(const f32x4*)(wf + c + 4);
                    *(f32x4*)(out + r * 2048 + c) = acc[ai][bj][m][0] * rs * w0; *(f32x4*)(out + r * 2048 + c + 4) = acc[ai][bj][m][1] * rs * w1; } }
    }
};
struct EpiMerge {
    static constexpr bool PERM = true, AFTER_DRAIN = false;
    const bf16_t* gates; bf16_t* out;
    __device__ __forceinline__ void operator()(f32x4 (&acc)[2][2][4][2], const Unit2& u, int wr, int wc, int fr, int fq) const {
        const int row0 = u.pm * BM + wr * 64 + fr, col0 = u.pn * BM + wc * 32 + 8 * fq;
#pragma unroll
        for (int ai = 0; ai < 2; ++ai)
#pragma unroll
            for (int m = 0; m < 4; ++m) { const size_t r = (size_t)(row0 + ai * HALF + m * 16);
#pragma unroll
                for (int bj = 0; bj < 2; ++bj) { const int c = col0 + bj * HALF; const u32x4 gb = *(const u32x4*)(gates + r * 4096 + 2048 + c);
                    float b[8] = {bflo(gb.x), bfhi(gb.x), bflo(gb.y), bfhi(gb.y), bflo(gb.z), bfhi(gb.z), bflo(gb.w), bfhi(gb.w)};
                    if (u.mode == 3) { const u32x4 ga = *(const u32x4*)(gates + r * 4096 + c);
                        const float a[8] = {bflo(ga.x), bfhi(ga.x), bflo(ga.y), bfhi(ga.y), bflo(ga.z), bfhi(ga.z), bflo(ga.w), bfhi(ga.w)};
#pragma unroll
                        for (int e = 0; e < 4; ++e) { acc[ai][bj][m][0][e] *= a[e] * __builtin_amdgcn_rcpf(fmaxf(b[e], 1e-30f)); acc[ai][bj][m][1][e] *= a[4 + e] * __builtin_amdgcn_rcpf(fmaxf(b[4 + e], 1e-30f)); } }
                    else { const f32x4 a0 = acc[ai][bj][m][0], a1 = acc[ai][bj][m][1];
                        u32x4 w; w.x = cvt_pk_bf16(a0[0] * b[0], a0[1] * b[1]); w.y = cvt_pk_bf16(a0[2] * b[2], a0[3] * b[3]); w.z = cvt_pk_bf16(a1[0] * b[4], a1[1] * b[5]); w.w = cvt_pk_bf16(a1[2] * b[6], a1[3] * b[7]);
                        *(u32x4*)(out + r * 2048 + c) = w; } } }
    }
};
}
using pg8::bf16_t; using pg8::bf16x8; using pg8::f32x4; using pg8::u32x4; using pg8::u32x2; using pg8::cvt_pk_bf16; using pg8::sigm; using pg8::bflo; using pg8::bfhi;
#define LAS __attribute__((address_space(3)))
constexpr int NTHR = 512;
constexpr int DMODEL = 2048, MTOK = 8192, SEQL = 2048, MMEM = 1024, DFF_ = 5632;
constexpr float EPS = 1e-6f;
constexpr float ATT_SCALE = 0.08838834764831845f;

constexpr size_t MiB = 1u << 20;
constexpr size_t WS_SUMSQ = 0;
constexpr size_t WS_LB = 128 * 1024;
constexpr size_t WS_BAR = 192 * 1024, BAR_BYTES = 48 * 1024, WS_FLAGS = WS_BAR + 16 * 1024;
constexpr size_t WS_LSE = 256 * 1024;
constexpr size_t WS_DEC = 1 * MiB;
constexpr size_t WS_WIN = 2 * MiB, WS_WKV = 52 * MiB, WS_WA = 56 * MiB, WS_WB = 58 * MiB, WS_WOUT = 62 * MiB, WS_WQ = 70 * MiB, WS_WO = 72 * MiB, WS_W13 = 74 * MiB, WS_W2 = 118 * MiB;
constexpr size_t WS_HN = 140 * MiB;
constexpr size_t WS_OG = 140 * MiB;
constexpr size_t WS_OATT = 164 * MiB;
constexpr size_t WS_QC = 164 * MiB;
constexpr size_t WS_OC = 140 * MiB;
constexpr size_t WS_QKV = 176 * MiB;
constexpr size_t WS_OCAT = 176 * MiB;
constexpr size_t WS_XB = 176 * MiB;
constexpr size_t WS_STB = 208 * MiB;
constexpr size_t WS_HG = 248 * MiB;
constexpr size_t WS_TMP = 248 * MiB;
constexpr size_t WS_G = 248 * MiB;
constexpr size_t WS_GATES = 312 * MiB;
constexpr size_t WS_KVC = 376 * MiB;
constexpr size_t WS_OHG = 378 * MiB;
constexpr size_t WS_END = 394 * MiB;

constexpr int LDS_BYTES = 147456, LDS_MISC = 147392;

__device__ __forceinline__ float wave_sum(float v) {
#pragma unroll
    for (int o = 1; o < 64; o <<= 1) v += __shfl_xor(v, o);
    return v;
}
#define LDS_FENCE() asm volatile("s_waitcnt lgkmcnt(0)" ::: "memory")

__device__ __forceinline__ void transpose_item(const float* __restrict__ W, int K, int N, bf16_t* WT, int dst_row0, const float* kscale, LAS float* scr, int k0, int n0, int lane, int dld = 0, int dcol = 0) {
    if (dld == 0) dld = K;
    const int lr = lane >> 4, lc = lane & 15;
    f32x4 v[16];
#pragma unroll
    for (int it = 0; it < 16; ++it) v[it] = *(const f32x4*)(W + (size_t)(k0 + it * 4 + lr) * N + n0 + 4 * lc);
    if (kscale) {
#pragma unroll
        for (int it = 0; it < 16; ++it) v[it] = v[it] * kscale[k0 + it * 4 + lr]; }
#pragma unroll
    for (int it = 0; it < 16; ++it) { LAS float* d = scr + (it * 4 + lr) * 65 + 4 * lc; d[0] = v[it][0]; d[1] = v[it][1]; d[2] = v[it][2]; d[3] = v[it][3]; }
    LDS_FENCE();
    const int c = lane & 7;
#pragma unroll
    for (int j = 0; j < 8; ++j) { const int n = (lane >> 3) + 8 * j; const LAS float* s = scr + (8 * c) * 65 + n;
        u32x4 o; o.x = cvt_pk_bf16(s[0], s[65]); o.y = cvt_pk_bf16(s[130], s[195]); o.z = cvt_pk_bf16(s[260], s[325]); o.w = cvt_pk_bf16(s[390], s[455]);
        *(u32x4*)(WT + (size_t)(dst_row0 + n) * dld + dcol + k0 + 8 * c) = o; }
    LDS_FENCE();
}
__device__ __forceinline__ void rms_row_bf16(const float* xrow, const float* w, bf16_t* orow, int lane) {
    f32x4 v[8]; float s = 0.f;
#pragma unroll
    for (int j = 0; j < 8; ++j) { v[j] = ((const f32x4*)xrow)[lane + 64 * j]; s += (v[j][0] * v[j][0] + v[j][1] * v[j][1]) + (v[j][2] * v[j][2] + v[j][3] * v[j][3]); }
    const float rstd = rsqrtf(wave_sum(s) * (1.f / 2048.f) + EPS);
#pragma unroll
    for (int j = 0; j < 8; ++j) { const f32x4 ww = ((const f32x4*)w)[lane + 64 * j]; const f32x4 o = v[j] * rstd * ww;
        u32x2 p; p.x = cvt_pk_bf16(o[0], o[1]); p.y = cvt_pk_bf16(o[2], o[3]); ((u32x2*)orow)[lane + 64 * j] = p; }
}

struct Args { const float* in[19]; float* out; unsigned char* ws; int ph_lo, ph_hi; };

__device__ __forceinline__ void phase_prologue(const Args& a, LAS unsigned char* lds, int tid) {
    const int lane = tid & 63, wave = tid >> 6; const int G = gridDim.x;
    LAS float* scr = (LAS float*)(lds + wave * 16896);
    const int gw = blockIdx.x * 8 + wave, NGW = G * 8;
    unsigned char* ws = a.ws;
    const float *w_in = a.in[3], *w_a = a.in[6], *w_b = a.in[7], *w_out = a.in[8], *wq = a.in[11], *wkv = a.in[12], *wo = a.in[13], *w1 = a.in[15], *w3 = a.in[16], *w2 = a.in[17];
    const float *ln_cross = a.in[9], *ln_ffn = a.in[14];
    constexpr int I_IN = 32 * 200, I_KV = 32 * 16, I_A = 8 * 32, I_B = 16 * 32, I_OUT = 32 * 32, I_Q = 32 * 8, I_O = 8 * 32, I_1 = 32 * 88, I_2 = 88 * 32;
    constexpr int NITEMS = I_IN + I_KV + I_A + I_B + I_OUT + I_Q + I_O + 2 * I_1 + I_2;
    for (int it = gw; it < NITEMS; it += NGW) {
        int r = it;
        if (r < I_IN) { transpose_item(w_in, 2048, 12800, (bf16_t*)(ws + WS_WIN), 64 * (r % 200), nullptr, scr, 64 * (r / 200), 64 * (r % 200), lane); continue; } r -= I_IN;
        if (r < I_KV) { transpose_item(wkv, 2048, 1024, (bf16_t*)(ws + WS_WKV), 64 * (r % 16), nullptr, scr, 64 * (r / 16), 64 * (r % 16), lane); continue; } r -= I_KV;
        if (r < I_A) { transpose_item(w_a, 512, 2048, (bf16_t*)(ws + WS_WA), 64 * (r % 32), nullptr, scr, 64 * (r / 32), 64 * (r % 32), lane, 1536, 0); continue; } r -= I_A;
        if (r < I_B) { transpose_item(w_b, 1024, 2048, (bf16_t*)(ws + WS_WA), 64 * (r % 32), nullptr, scr, 64 * (r / 32), 64 * (r % 32), lane, 1536, 512); continue; } r -= I_B;
        if (r < I_OUT) { transpose_item(w_out, 2048, 2048, (bf16_t*)(ws + WS_WOUT), 64 * (r % 32), nullptr, scr, 64 * (r / 32), 64 * (r % 32), lane); continue; } r -= I_OUT;
        if (r < I_Q) { transpose_item(wq, 2048, 512, (bf16_t*)(ws + WS_WQ), 64 * (r % 8), ln_cross, scr, 64 * (r / 8), 64 * (r % 8), lane); continue; } r -= I_Q;
        if (r < I_O) { transpose_item(wo, 512, 2048, (bf16_t*)(ws + WS_WO), 64 * (r % 32), nullptr, scr, 64 * (r / 32), 64 * (r % 32), lane); continue; } r -= I_O;
        if (r < I_1) { const int n0 = 64 * (r % 88); transpose_item(w1, 2048, 5632, (bf16_t*)(ws + WS_W13), 256 * (n0 >> 7) + (n0 & 127), ln_ffn, scr, 64 * (r / 88), n0, lane); continue; } r -= I_1;
        if (r < I_1) { const int n0 = 64 * (r % 88); transpose_item(w3, 2048, 5632, (bf16_t*)(ws + WS_W13), 256 * (n0 >> 7) + 128 + (n0 & 127), ln_ffn, scr, 64 * (r / 88), n0, lane); continue; } r -= I_1;
        transpose_item(w2, 5632, 2048, (bf16_t*)(ws + WS_W2), 64 * (r % 32), nullptr, scr, 64 * (r / 32), 64 * (r % 32), lane);
    }
    bf16_t* hn = (bf16_t*)(ws + WS_HN);
    for (int m = gw; m < MTOK + MMEM; m += NGW) {
        if (m < MTOK) rms_row_bf16(a.in[0] + (size_t)m * 2048, a.in[2], hn + (size_t)m * 2048, lane);
        else rms_row_bf16(a.in[1] + (size_t)(m - MTOK) * 2048, a.in[10], hn + (size_t)m * 2048, lane);
    }
    const int gt = blockIdx.x * NTHR + tid, NGT = G * NTHR;
    float* sumsq = (float*)(ws + WS_SUMSQ);
    for (int i = gt; i < 3 * 8192; i += NGT) sumsq[i] = 0.f;
    float* lb = (float*)(ws + WS_LB); const float* hlb = a.in[5];
    for (int i = gt; i < 1024; i += NGT) lb[i] = 1.f / (1.f + __expf(hlb[1024 + i] - hlb[i]));
}

constexpr int VTS = 136, KSS = 68;
constexpr int ATT_K_OFF = 128 * VTS * 4;
template <bool MASKED, bool QPRE = false>
__device__ __forceinline__ void attn_unit(LAS unsigned char* lds, const bf16_t* Qb, long qs, const bf16_t* Kown, long ks, const bf16_t* Vown, long vs, bool hasprev,
                                          bf16_t* Ob, long os, float* lsep, long lses, int tid, const bf16x8* qpre = nullptr) {
    const int lane = tid & 63, w = tid >> 6, fr = lane & 15, fq = lane >> 4;
    LAS unsigned* VT = (LAS unsigned*)lds; LAS unsigned* KS = (LAS unsigned*)(lds + ATT_K_OFF);
    const int iq = 16 * w + fr;
    u32x4 kx[8], vx[4], vy[4]; bf16x8 qf[4];
#pragma unroll
    for (int it = 0; it < 8; ++it) { const int id = tid + NTHR * it; long r = (id >> 4) - 128; if (!hasprev && r < 0) r = 0; kx[it] = *(const u32x4*)(Kown + r * ks + 8 * (id & 15)); }
#pragma unroll
    for (int it = 0; it < 4; ++it) { const int task = tid + NTHR * it; const int p = task & 127, c = task >> 7;
        long r0 = 2 * p - 128; if (!hasprev && r0 < 0) r0 = 0;
        const bf16_t* src = Vown + r0 * vs + 8 * c; vx[it] = *(const u32x4*)src; vy[it] = *(const u32x4*)(src + vs); }
#pragma unroll
    for (int k4 = 0; k4 < 4; ++k4) { if (QPRE) qf[k4] = qpre[k4]; else qf[k4] = *(const bf16x8*)(Qb + (long)iq * qs + 32 * k4 + 8 * fq); }
    __syncthreads();
#pragma unroll
    for (int it = 0; it < 8; ++it) { const int id = tid + NTHR * it; *(LAS u32x4*)(KS + (id >> 4) * KSS + 4 * (id & 15)) = kx[it]; }
#pragma unroll
    for (int it = 0; it < 4; ++it) { const int task = tid + NTHR * it; const int p = task & 127, c = task >> 7; const u32x4 x = vx[it], y = vy[it];
        LAS unsigned* d = VT + (8 * c) * VTS + p;
        d[0 * VTS] = (x.x & 0xffffu) | (y.x << 16); d[1 * VTS] = (x.x >> 16) | (y.x & 0xffff0000u);
        d[2 * VTS] = (x.y & 0xffffu) | (y.y << 16); d[3 * VTS] = (x.y >> 16) | (y.y & 0xffff0000u);
        d[4 * VTS] = (x.z & 0xffffu) | (y.z << 16); d[5 * VTS] = (x.z >> 16) | (y.z & 0xffff0000u);
        d[6 * VTS] = (x.w & 0xffffu) | (y.w << 16); d[7 * VTS] = (x.w >> 16) | (y.w & 0xffff0000u); }
    __syncthreads();
    constexpr int NT = MASKED ? 10 : 16; const int t0 = MASKED ? w : 0;
    f32x4 s[NT];
    float mx = -INFINITY;
#pragma unroll
    for (int i = 0; i < NT; ++i) { const int t = t0 + i, tc = t < 15 ? t : 15;
        const LAS unsigned* kp = KS + (16 * tc + fr) * KSS + 4 * fq;
        f32x4 acc = {0.f, 0.f, 0.f, 0.f};
#pragma unroll
        for (int k4 = 0; k4 < 4; ++k4) { const bf16x8 kf = __builtin_bit_cast(bf16x8, *(const LAS u32x4*)(kp + 16 * k4)); acc = __builtin_amdgcn_mfma_f32_16x16x32_bf16(kf, qf[k4], acc, 0, 0, 0); }
#pragma unroll
        for (int j = 0; j < 4; ++j) { const int kk = 16 * t + 4 * fq + j; bool ok = (t <= 15);
            if (MASKED) ok = ok && (kk >= iq) && (kk <= iq + 128);
            ok = ok && (hasprev || kk >= 128);
            const float v = ok ? acc[j] * ATT_SCALE : -INFINITY; acc[j] = v; mx = fmaxf(mx, v); }
        s[i] = acc; }
    mx = fmaxf(mx, __shfl_xor(mx, 16)); mx = fmaxf(mx, __shfl_xor(mx, 32));
    float l = 0.f;
#pragma unroll
    for (int i = 0; i < NT; ++i)
#pragma unroll
        for (int j = 0; j < 4; ++j) { const float p = __expf(s[i][j] - mx); s[i][j] = p; l += p; }
    l += __shfl_xor(l, 16); l += __shfl_xor(l, 32);
    f32x4 o[8];
#pragma unroll
    for (int mt = 0; mt < 8; ++mt) o[mt] = (f32x4){0.f, 0.f, 0.f, 0.f};
#pragma unroll
    for (int sp = 0; sp < NT / 2; ++sp) { const int ta = t0 + 2 * sp, tb = ta + 1; const int tca = ta < 15 ? ta : 15, tcb = tb < 15 ? tb : 15;
        u32x4 pw; pw.x = cvt_pk_bf16(s[2 * sp][0], s[2 * sp][1]); pw.y = cvt_pk_bf16(s[2 * sp][2], s[2 * sp][3]); pw.z = cvt_pk_bf16(s[2 * sp + 1][0], s[2 * sp + 1][1]); pw.w = cvt_pk_bf16(s[2 * sp + 1][2], s[2 * sp + 1][3]);
        const bf16x8 pf = __builtin_bit_cast(bf16x8, pw);
#pragma unroll
        for (int mt = 0; mt < 8; ++mt) { const LAS unsigned* vr = VT + (16 * mt + fr) * VTS + 2 * fq;
            const u32x2 lo = *(const LAS u32x2*)(vr + 8 * tca), hi = *(const LAS u32x2*)(vr + 8 * tcb);
            u32x4 vw; vw.x = lo.x; vw.y = lo.y; vw.z = hi.x; vw.w = hi.y;
            o[mt] = __builtin_amdgcn_mfma_f32_16x16x32_bf16(__builtin_bit_cast(bf16x8, vw), pf, o[mt], 0, 0, 0); } }
    const float il = 1.f / l;
    bf16_t* op = Ob + (long)iq * os + 4 * fq;
#pragma unroll
    for (int mt = 0; mt < 8; ++mt) { u32x2 wv; wv.x = cvt_pk_bf16(o[mt][0] * il, o[mt][1] * il); wv.y = cvt_pk_bf16(o[mt][2] * il, o[mt][3] * il); *(u32x2*)(op + 16 * mt) = wv; }
    if (lsep && fq == 0) lsep[(long)iq * lses] = mx + __logf(l);
}

constexpr int QB_STRIDE = 144, QB_BYTES = 128 * QB_STRIDE, QT_OFF = 2 * QB_BYTES, QT_STRIDE = 272;
__device__ __forceinline__ void cross_q_tile(LAS unsigned char* lds, const bf16_t* XBp, const bf16_t* WQT, const float* ssq, int tid, bf16x8 (&qf)[4]) {
    const int lane = tid & 63, w = tid >> 6, fr = lane & 15, fq = lane >> 4;
    const bf16_t* ap = XBp + (size_t)(16 * w + fr) * 2048 + 8 * fq;
    const int br = tid >> 3, bc = tid & 7;
    const bf16_t* bp = WQT + (size_t)br * 2048 + 8 * bc;
    f32x4 acc[8];
#pragma unroll
    for (int nt = 0; nt < 8; ++nt) acc[nt] = (f32x4){0.f, 0.f, 0.f, 0.f};
    u32x4 b0[4], b1[4]; bf16x8 a0[4], a1[4];
#pragma unroll
    for (int i = 0; i < 4; ++i) { b0[i] = *(const u32x4*)(bp + 64 * i); b1[i] = *(const u32x4*)(bp + (size_t)64 * 2048 + 64 * i); a0[i] = *(const bf16x8*)(ap + 64 * i); a1[i] = *(const bf16x8*)(ap + 64 * i + 32); }
    __syncthreads();
    for (int kq = 0; kq < 8; ++kq) {
#pragma unroll
        for (int i = 0; i < 4; ++i) { const int kc = 4 * kq + i;
            LAS unsigned char* buf = lds + (i & 1) * QB_BYTES;
            *(LAS u32x4*)(buf + br * QB_STRIDE + 16 * bc) = b0[i]; *(LAS u32x4*)(buf + (br + 64) * QB_STRIDE + 16 * bc) = b1[i];
            const bf16x8 c0 = a0[i], c1 = a1[i];
            if (kq < 7) { b0[i] = *(const u32x4*)(bp + 64 * (kc + 4)); b1[i] = *(const u32x4*)(bp + (size_t)64 * 2048 + 64 * (kc + 4)); a0[i] = *(const bf16x8*)(ap + 64 * (kc + 4)); a1[i] = *(const bf16x8*)(ap + 64 * (kc + 4) + 32); }
            __syncthreads();
#pragma unroll
            for (int nt = 0; nt < 8; ++nt) { const LAS unsigned char* rp = buf + (16 * nt + fr) * QB_STRIDE + 16 * fq;
                const bf16x8 f0 = __builtin_bit_cast(bf16x8, *(const LAS u32x4*)rp), f1 = __builtin_bit_cast(bf16x8, *(const LAS u32x4*)(rp + 64));
                acc[nt] = __builtin_amdgcn_mfma_f32_16x16x32_bf16(c0, f0, acc[nt], 0, 0, 0); acc[nt] = __builtin_amdgcn_mfma_f32_16x16x32_bf16(c1, f1, acc[nt], 0, 0, 0); } }
    }
    float rs[4];
#pragma unroll
    for (int j = 0; j < 4; ++j) rs[j] = rsqrtf(ssq[16 * w + 4 * fq + j] * (1.f / 2048.f) + EPS);
    LAS unsigned char* qt = lds + QT_OFF;
#pragma unroll
    for (int nt = 0; nt < 8; ++nt)
#pragma unroll
        for (int j = 0; j < 4; ++j) *(LAS bf16_t*)(qt + (16 * w + 4 * fq + j) * QT_STRIDE + 2 * (16 * nt + fr)) = (bf16_t)(cvt_pk_bf16(acc[nt][j] * rs[j], 0.f) & 0xffffu);
    __syncthreads();
#pragma unroll
    for (int k4 = 0; k4 < 4; ++k4) qf[k4] = __builtin_bit_cast(bf16x8, *(const LAS u32x4*)(qt + (16 * w + fr) * QT_STRIDE + 2 * (32 * k4 + 8 * fq)));
}

__device__ __forceinline__ void hg_gates(const unsigned (&fw)[8], float lb0, float lb1, LAS float* psum, int tid, float (&f)[2][8], float (&b)[2][8], float (&tot)[2]) {
    const int k0 = 2 * (tid & 63), part = tid >> 6;
    float r0 = 0.f, r1 = 0.f;
#pragma unroll
    for (int cc = 0; cc < 8; ++cc) { const float f0 = lb0 + (1.f - lb0) * sigm(bflo(fw[cc])), f1 = lb1 + (1.f - lb1) * sigm(bfhi(fw[cc]));
        f[0][cc] = f0; f[1][cc] = f1; r0 += __logf(f0); r1 += __logf(f1); b[0][cc] = r0; b[1][cc] = r1; }
    psum[part * 128 + k0] = r0; psum[part * 128 + k0 + 1] = r1;
    __syncthreads();
    float off0 = 0.f, off1 = 0.f, t0 = 0.f, t1 = 0.f;
#pragma unroll
    for (int p = 0; p < 8; ++p) { const float a0 = psum[p * 128 + k0], a1 = psum[p * 128 + k0 + 1]; if (p < part) { off0 += a0; off1 += a1; } t0 += a0; t1 += a1; }
#pragma unroll
    for (int cc = 0; cc < 8; ++cc) { b[0][cc] += off0; b[1][cc] += off1; }
    tot[0] = t0; tot[1] = t1;
}
constexpr int HS = 36;
__device__ __forceinline__ void hg_write_vt(const u32x4 x, const u32x4 y, LAS unsigned* VTh, int tid) {
    const int p = tid & 31, ch = tid >> 5;
    LAS unsigned* d = VTh + (8 * ch) * HS + p;
    d[0 * HS] = (x.x & 0xffffu) | (y.x << 16); d[1 * HS] = (x.x >> 16) | (y.x & 0xffff0000u);
    d[2 * HS] = (x.y & 0xffffu) | (y.y << 16); d[3 * HS] = (x.y >> 16) | (y.y & 0xffff0000u);
    d[4 * HS] = (x.z & 0xffffu) | (y.z << 16); d[5 * HS] = (x.z >> 16) | (y.z & 0xffff0000u);
    d[6 * HS] = (x.w & 0xffffu) | (y.w << 16); d[7 * HS] = (x.w >> 16) | (y.w & 0xffff0000u);
}
struct HgIn { unsigned fw[8]; u32x4 x, y; float lb0, lb1; };
__device__ __forceinline__ void hg_load(HgIn& I, const bf16_t* hg, const float* lbp, int hu, int tid) {
    const int bh = hu >> 5, n = hu & 31, b_ = bh >> 3, h = bh & 7, row0 = b_ * 2048 + n * 64; const int k0 = 2 * (tid & 63), part = tid >> 6;
#pragma unroll
    for (int cc = 0; cc < 8; ++cc) I.fw[cc] = *(const unsigned*)(hg + (size_t)(row0 + part * 8 + cc) * 4096 + 1024 + h * 128 + k0);
    const bf16_t* src = hg + (size_t)(row0 + 2 * (tid & 31)) * 4096 + 2048 + h * 128 + 8 * (tid >> 5);
    I.x = *(const u32x4*)src; I.y = *(const u32x4*)(src + 4096);
    I.lb0 = lbp[h * 128 + k0]; I.lb1 = lbp[h * 128 + k0 + 1];
}
__device__ __forceinline__ void hg_kv_phase(LAS unsigned char* lds, const bf16_t* hg, const float* lbp, bf16_t* ST, float* DEC, int tid, int bid, int G) {
    const int lane = tid & 63, w = tid >> 6, fr = lane & 15, fq = lane >> 4;
    LAS unsigned* VTh = (LAS unsigned*)lds;
    LAS unsigned* KDT = (LAS unsigned*)(lds + 18432);
    LAS float* psum = (LAS float*)(lds + 36864);
    const int k0 = 2 * (tid & 63), part = tid >> 6;
    HgIn I; if (bid < 1024) hg_load(I, hg, lbp, bid, tid);
    for (int hu = bid; hu < 1024; hu += G) {
        __syncthreads();
        hg_write_vt(I.x, I.y, VTh, tid);
        float f[2][8], b[2][8], tot[2];
        hg_gates(I.fw, I.lb0, I.lb1, psum, tid, f, b, tot);
        if (hu + G < 1024) hg_load(I, hg, lbp, hu + G, tid);
#pragma unroll
        for (int q = 0; q < 2; ++q) { float kd[8];
#pragma unroll
            for (int cc = 0; cc < 8; ++cc) kd[cc] = (1.f - f[q][cc]) * __expf(tot[q] - b[q][cc]);
            u32x4 wv; wv.x = cvt_pk_bf16(kd[0], kd[1]); wv.y = cvt_pk_bf16(kd[2], kd[3]); wv.z = cvt_pk_bf16(kd[4], kd[5]); wv.w = cvt_pk_bf16(kd[6], kd[7]);
            *(LAS u32x4*)(KDT + (k0 + q) * HS + 4 * part) = wv; }
        if (part == 0) { DEC[(size_t)hu * 128 + k0] = __expf(tot[0]); DEC[(size_t)hu * 128 + k0 + 1] = __expf(tot[1]); }
        __syncthreads();
        bf16x8 af[2];
#pragma unroll
        for (int k2 = 0; k2 < 2; ++k2) af[k2] = __builtin_bit_cast(bf16x8, *(const LAS u32x4*)(VTh + (16 * w + fr) * HS + 16 * k2 + 4 * fq));
        bf16_t* stp = ST + (size_t)hu * 16384 + (size_t)(16 * w + 4 * fq) * 128 + fr;
#pragma unroll
        for (int nt = 0; nt < 8; ++nt) { f32x4 acc = {0.f, 0.f, 0.f, 0.f};
#pragma unroll
            for (int k2 = 0; k2 < 2; ++k2) { const bf16x8 bf = __builtin_bit_cast(bf16x8, *(const LAS u32x4*)(KDT + (16 * nt + fr) * HS + 16 * k2 + 4 * fq)); acc = __builtin_amdgcn_mfma_f32_16x16x32_bf16(af[k2], bf, acc, 0, 0, 0); }
#pragma unroll
            for (int j = 0; j < 4; ++j) { const float nb = __shfl_down(acc[j], 1); if (!(fr & 1)) *(unsigned*)(stp + j * 128 + 16 * nt) = cvt_pk_bf16(acc[j], nb); } }
    }
}
constexpr int QS = 68;
__device__ __forceinline__ void hg_out_phase(LAS unsigned char* lds, const bf16_t* hg, const float* lbp, const float* hg_norm_w, const bf16_t* STB, bf16_t* OHG, int tid, int bid, int G) {
    const int lane = tid & 63, w = tid >> 6, fr = lane & 15, fq = lane >> 4;
    LAS unsigned* VTh = (LAS unsigned*)lds;
    LAS unsigned* QD = (LAS unsigned*)(lds + 18432);
    LAS unsigned* QM = (LAS unsigned*)(lds + 18432 + 17408);
    LAS unsigned* KM = (LAS unsigned*)(lds + 18432 + 2 * 17408);
    LAS float* psum = (LAS float*)(lds + 18432 + 3 * 17408);
    LAS float* bref = psum + 1024;
    LAS float* ssq = bref + 128;
    const int k0 = 2 * (tid & 63), part = tid >> 6, ct = w & 3, vh = w >> 2, c = 16 * ct + fr;
    HgIn I; unsigned qw[8];
    if (bid < 1024) { hg_load(I, hg, lbp, bid, tid); const int bh = bid >> 5, row0 = (bh >> 3) * 2048 + (bid & 31) * 64;
#pragma unroll
        for (int cc = 0; cc < 8; ++cc) qw[cc] = *(const unsigned*)(hg + (size_t)(row0 + part * 8 + cc) * 4096 + (bh & 7) * 128 + k0); }
    for (int hu = bid; hu < 1024; hu += G) {
        const int bh = hu >> 5, n = hu & 31, b_ = bh >> 3, h = bh & 7, row0 = b_ * 2048 + n * 64;
        u32x4 sa[4][4]; u32x2 gw[4]; f32x4 nw[4];
#pragma unroll
        for (int mi = 0; mi < 4; ++mi) { const bf16_t* sp = STB + (size_t)hu * 16384 + (size_t)(16 * (vh * 4 + mi) + fr) * 128 + 8 * fq;
#pragma unroll
            for (int k4 = 0; k4 < 4; ++k4) sa[mi][k4] = *(const u32x4*)(sp + 32 * k4);
            const int v0 = 16 * (vh * 4 + mi) + 4 * fq; gw[mi] = *(const u32x2*)(hg + (size_t)(row0 + c) * 4096 + 3072 + h * 128 + v0); nw[mi] = *(const f32x4*)(hg_norm_w + v0); }
        __syncthreads();
        hg_write_vt(I.x, I.y, VTh, tid);
        float f[2][8], b[2][8], tot[2];
        hg_gates(I.fw, I.lb0, I.lb1, psum, tid, f, b, tot);
        if (part == 4) { bref[k0] = b[0][0]; bref[k0 + 1] = b[1][0]; }
        __syncthreads();
        const float br0 = bref[k0], br1 = bref[k0 + 1];
#pragma unroll
        for (int cc = 0; cc < 8; ++cc) { const int c_ = part * 8 + cc; const float q0 = bflo(qw[cc]), q1 = bfhi(qw[cc]);
            const float e0 = __expf(b[0][cc] - br0), e1 = __expf(b[1][cc] - br1);
            QD[c_ * QS + (k0 >> 1)] = cvt_pk_bf16(q0 * __expf(b[0][cc]), q1 * __expf(b[1][cc]));
            QM[c_ * QS + (k0 >> 1)] = cvt_pk_bf16(q0 * e0, q1 * e1);
            KM[c_ * QS + (k0 >> 1)] = cvt_pk_bf16((1.f - f[0][cc]) * __builtin_amdgcn_rcpf(e0), (1.f - f[1][cc]) * __builtin_amdgcn_rcpf(e1)); }
        if (hu + G < 1024) { const int hn = hu + G; hg_load(I, hg, lbp, hn, tid); const int bhn = hn >> 5, row0n = (bhn >> 3) * 2048 + (hn & 31) * 64;
#pragma unroll
            for (int cc = 0; cc < 8; ++cc) qw[cc] = *(const unsigned*)(hg + (size_t)(row0n + part * 8 + cc) * 4096 + (bhn & 7) * 128 + k0); }
        __syncthreads();
        bf16x8 qmf[4];
#pragma unroll
        for (int k4 = 0; k4 < 4; ++k4) qmf[k4] = __builtin_bit_cast(bf16x8, *(const LAS u32x4*)(QM + (16 * ct + fr) * QS + 16 * k4 + 4 * fq));
        unsigned ap[4][2];
#pragma unroll
        for (int st = 0; st < 4; ++st) { f32x4 acc = {0.f, 0.f, 0.f, 0.f};
#pragma unroll
            for (int k4 = 0; k4 < 4; ++k4) { const bf16x8 kf = __builtin_bit_cast(bf16x8, *(const LAS u32x4*)(KM + (16 * st + fr) * QS + 16 * k4 + 4 * fq)); acc = __builtin_amdgcn_mfma_f32_16x16x32_bf16(kf, qmf[k4], acc, 0, 0, 0); }
#pragma unroll
            for (int j = 0; j < 4; ++j) { const int s_ = 16 * st + 4 * fq + j; if (s_ > c) acc[j] = 0.f; }
            ap[st][0] = cvt_pk_bf16(acc[0], acc[1]); ap[st][1] = cvt_pk_bf16(acc[2], acc[3]); }
        bf16x8 qdf[4];
#pragma unroll
        for (int k4 = 0; k4 < 4; ++k4) qdf[k4] = __builtin_bit_cast(bf16x8, *(const LAS u32x4*)(QD + (16 * ct + fr) * QS + 16 * k4 + 4 * fq));
        f32x4 o[4]; float ss = 0.f;
#pragma unroll
        for (int mi = 0; mi < 4; ++mi) { const int mt = vh * 4 + mi; f32x4 acc = {0.f, 0.f, 0.f, 0.f};
#pragma unroll
            for (int k4 = 0; k4 < 4; ++k4) acc = __builtin_amdgcn_mfma_f32_16x16x32_bf16(__builtin_bit_cast(bf16x8, sa[mi][k4]), qdf[k4], acc, 0, 0, 0);
#pragma unroll
            for (int s2 = 0; s2 < 2; ++s2) { const LAS unsigned* vr = VTh + (16 * mt + fr) * HS + 16 * s2 + 2 * fq;
                const u32x2 lo = *(const LAS u32x2*)vr, hi = *(const LAS u32x2*)(vr + 8);
                u32x4 vw; vw.x = lo.x; vw.y = lo.y; vw.z = hi.x; vw.w = hi.y;
                u32x4 pw; pw.x = ap[2 * s2][0]; pw.y = ap[2 * s2][1]; pw.z = ap[2 * s2 + 1][0]; pw.w = ap[2 * s2 + 1][1];
                acc = __builtin_amdgcn_mfma_f32_16x16x32_bf16(__builtin_bit_cast(bf16x8, vw), __builtin_bit_cast(bf16x8, pw), acc, 0, 0, 0); }
            o[mi] = acc; ss += (acc[0] * acc[0] + acc[1] * acc[1]) + (acc[2] * acc[2] + acc[3] * acc[3]); }
        ss += __shfl_xor(ss, 16); ss += __shfl_xor(ss, 32);
        if (fq == 0) ssq[vh * 64 + c] = ss;
        __syncthreads();
        const float rstd = rsqrtf((ssq[c] + ssq[64 + c]) * (1.f / 128.f) + EPS);
#pragma unroll
        for (int mi = 0; mi < 4; ++mi) { const int v0 = 16 * (vh * 4 + mi) + 4 * fq;
            u32x2 ov; ov.x = cvt_pk_bf16(o[mi][0] * rstd * nw[mi][0] * bflo(gw[mi].x), o[mi][1] * rstd * nw[mi][1] * bfhi(gw[mi].x)); ov.y = cvt_pk_bf16(o[mi][2] * rstd * nw[mi][2] * bflo(gw[mi].y), o[mi][3] * rstd * nw[mi][3] * bfhi(gw[mi].y));
            *(u32x2*)(OHG + (size_t)(row0 + c) * 1536 + 512 + h * 128 + v0) = ov; }
    }
}

#define XB_TMO      128
#define XB_XCNT(j)  (256  + 64 * (j))
#define XB_XSUB(j)  (1280 + 64 * (j))
#define XB_XGEN(j)  (2304 + 64 * (j))
#define XB_TOP      3328
#define XB_TOPGEN   3392
#define XCD_BAR_WORDS 3456
#define XB_SPIN_CAP (1u << 18)

__device__ __forceinline__ unsigned xb_ld(unsigned* p)              { return __hip_atomic_load(p, __ATOMIC_RELAXED, __HIP_MEMORY_SCOPE_AGENT); }
__device__ __forceinline__ unsigned xb_add(unsigned* p, unsigned v) { return __hip_atomic_fetch_add(p, v, __ATOMIC_RELAXED, __HIP_MEMORY_SCOPE_AGENT); }
__device__ __forceinline__ unsigned xb_xcc_id() { return (unsigned)__builtin_amdgcn_s_getreg((3 << 11) | 20) & 0xFu; }
#define XB_SPIN(cond, bar) do { unsigned _sp = 0; while (cond) { __builtin_amdgcn_s_sleep(1); \
    if ((++_sp & 255u) == 0u) { if (xb_ld(&(bar)[XB_TMO])) break; if (_sp > XB_SPIN_CAP) { atomicAdd(&(bar)[XB_TMO], 1u); break; } } } } while (0)

struct XcdBarrier {
    unsigned* bar; unsigned x;
    volatile LAS unsigned* st;
};

__device__ __forceinline__ XcdBarrier xcd_barrier_post(unsigned* bar, volatile LAS unsigned* st) {
    XcdBarrier b; b.bar = bar; b.x = xb_xcc_id(); b.st = st;
    if (threadIdx.x == 0) (void)xb_add(&bar[XB_XCNT(b.x)], 1u);
    return b;
}
__device__ __forceinline__ void xcd_barrier_complete(unsigned* bar, unsigned x, unsigned& nloc, unsigned& nx) {
    const unsigned G = gridDim.x * gridDim.y * gridDim.z;
    unsigned sum, cnt, mine, sp = 0u;
    for (;;) {
        sum = 0u; cnt = 0u; mine = 0u;
#pragma unroll
        for (unsigned j = 0; j < 16; ++j) { const unsigned c = xb_ld(&bar[XB_XCNT(j)]); sum += c; cnt += (c > 0u) ? 1u : 0u; mine = (j == x) ? c : mine; }
        if (sum == G) break;
        __builtin_amdgcn_s_sleep(1);
        if ((++sp & 255u) == 0u) { if (xb_ld(&bar[XB_TMO])) break; if (sp > XB_SPIN_CAP) { atomicAdd(&bar[XB_TMO], 1u); break; } }
    }
    nloc = mine > 0u ? mine : 1u; nx = cnt > 0u ? cnt : 1u;
}

__device__ __forceinline__ void xcd_barrier(const XcdBarrier& b) {
    asm volatile("s_waitcnt vmcnt(0)" ::: "memory");
    __syncthreads();
    if (threadIdx.x == 0) {
        unsigned* bar = b.bar;
        __builtin_amdgcn_s_waitcnt(0);
        unsigned nloc = b.st[0], nx = b.st[1];
        if (nloc == 0u) { xcd_barrier_complete(bar, b.x, nloc, nx); b.st[0] = nloc; b.st[1] = nx; }
        const unsigned old = xb_add(&bar[XB_XSUB(b.x)], 1u);
        const unsigned gen = old / nloc;
        if (old + 1u == (gen + 1u) * nloc) {
            __builtin_amdgcn_fence(__ATOMIC_RELEASE, "agent");
            asm volatile("s_waitcnt vmcnt(0)" ::: "memory");
            const unsigned og = xb_add(&bar[XB_TOP], 1u);
            const unsigned tg = og / nx;
            if (og + 1u == (tg + 1u) * nx) xb_add(&bar[XB_TOPGEN], 1u);
            else XB_SPIN(xb_ld(&bar[XB_TOPGEN]) == tg, bar);
            __builtin_amdgcn_fence(__ATOMIC_ACQUIRE, "agent");
            xb_add(&bar[XB_XGEN(b.x)], 1u);
            asm volatile("s_waitcnt vmcnt(0)" ::: "memory");
        } else {
            XB_SPIN(xb_ld(&bar[XB_XGEN(b.x)]) == gen, bar);
            __builtin_amdgcn_fence(__ATOMIC_ACQUIRE, "agent");
            asm volatile("s_waitcnt vmcnt(0)" ::: "memory");
        }
    }
    __syncthreads();
}

constexpr int NPHASE = 12;
#ifndef REP_PHASE
#define REP_PHASE -1
#endif
#define REPLOOP(k) _Pragma("nounroll") for (int rep_ = 0; rep_ < ((k) == REP_PHASE ? 2 : 1); ++rep_)
__global__ void __launch_bounds__(NTHR, 2) fwd_kernel(Args a) {
    extern __shared__ __attribute__((aligned(16))) unsigned char lds_raw[];
    LAS unsigned char* lds = (LAS unsigned char*)lds_raw;
    cg::grid_group grid = cg::this_grid();
    const int tid = threadIdx.x, G = gridDim.x, bid = blockIdx.x;
    unsigned char* ws = a.ws;
    const int lo = a.ph_lo, hi = a.ph_hi;
#define IN(k) (lo <= (k) && (k) < hi)
#define SEAM(k) do { if (IN(k) && IN((k) + 1)) { if (lo < 0) grid.sync(); else xcd_barrier(bar); } } while (0)
    if (tid < 2) ((volatile LAS unsigned*)(lds + LDS_MISC))[tid] = 0u;
    __syncthreads();
    XcdBarrier bar = xcd_barrier_post((unsigned*)(ws + WS_BAR), (volatile LAS unsigned*)(lds + LDS_MISC));
    float* sumsq = (float*)(ws + WS_SUMSQ);
    bf16_t* QKV = (bf16_t*)(ws + WS_QKV); bf16_t* HGB = (bf16_t*)(ws + WS_HG); bf16_t* GATES = (bf16_t*)(ws + WS_GATES); bf16_t* KVC = (bf16_t*)(ws + WS_KVC);
    bf16_t* OG = (bf16_t*)((unsigned char*)a.out + 32 * MiB);       float* LSE = (float*)(ws + WS_LSE); bf16_t* OCAT = (bf16_t*)(ws + WS_OCAT);
    bf16_t* ST = (bf16_t*)a.out; bf16_t* STB = (bf16_t*)(ws + WS_STB); float* DEC = (float*)(ws + WS_DEC); const float* LB = (const float*)(ws + WS_LB);
    float* PART = a.out; unsigned* FLAGS = (unsigned*)(ws + WS_FLAGS); bf16_t* MERGED = (bf16_t*)a.out; bf16_t* XB = (bf16_t*)(ws + WS_XB);
    bf16_t* QC = (bf16_t*)(ws + WS_QC); bf16_t* OC = (bf16_t*)(ws + WS_OC); bf16_t* GB = (bf16_t*)(ws + WS_G);

    if (IN(0)) REPLOOP(0) { phase_prologue(a, lds, tid); __syncthreads(); }
    SEAM(0);
    if (IN(1)) REPLOOP(1) {
        pg8::SplitOrder S; S.init((const bf16_t*)(ws + WS_HN), (const bf16_t*)(ws + WS_WIN), MTOK, 12288, 2048, 0, G, bid);
        pg8::EpiProj E{QKV, HGB, GATES, KVC};
        pg8::gemm_phase2<pg8::EpiProj, pg8::SplitOrder>(lds, S, E, PART, FLAGS, 2u * 2048u);
    }
    SEAM(1);
    const int NGEM = G >= 160 ? 80 : 0;
    if (IN(2)) REPLOOP(2) {
      { const int bid_ = bid, G_ = G;
        for (int u = bid_; u < 768; u += G_) {
            const int g_ = u >> 8, rem = u & 255; const int dsh = 2 * g_, d = 1 << dsh, nblk = 16 >> dsh;
            const int n = rem & (nblk - 1), r = (rem >> (4 - dsh)) & (d - 1), bhh = rem >> 4, b_ = bhh >> 2, hg_ = bhh & 3;
            const long row0 = (long)b_ * 2048 + (long)(n * 128) * d + r;
            const bf16_t* qb = QKV + row0 * 4608 + (g_ * 4 + hg_) * 128;
            attn_unit<true>(lds, qb, (long)d * 4608, qb + 1536, (long)d * 4608, qb + 3072, (long)d * 4608, n > 0,
                            OG + (size_t)g_ * (8192 * 512) + row0 * 512 + hg_ * 128, (long)d * 512, LSE + (size_t)g_ * (8192 * 4) + row0 * 4 + hg_, (long)d * 4, tid);
        }
        hg_kv_phase(lds, HGB, LB, ST, DEC, tid, bid_, G_);
      }
    }
    SEAM(2);
    if (IN(3)) {
        const int gt = bid * NTHR + tid, NGT = G * NTHR;
        for (int task = gt; task < 8192 * 64; task += NGT) { const int tok = task >> 6, hg_ = (task >> 4) & 3, c = task & 15;
            const float l0 = LSE[(size_t)tok * 4 + hg_], l1 = LSE[(size_t)(8192 + tok) * 4 + hg_], l2 = LSE[(size_t)(16384 + tok) * 4 + hg_];
            const float mx = fmaxf(l0, fmaxf(l1, l2)); float e0 = __expf(l0 - mx), e1 = __expf(l1 - mx), e2 = __expf(l2 - mx); const float inv = 1.f / (e0 + e1 + e2); e0 *= inv; e1 *= inv; e2 *= inv;
            const size_t off = (size_t)tok * 512 + hg_ * 128 + 8 * c;
            const u32x4 x0 = *(const u32x4*)(OG + off), x1 = *(const u32x4*)(OG + (size_t)8192 * 512 + off), x2 = *(const u32x4*)(OG + (size_t)2 * 8192 * 512 + off);
            u32x4 o;
            o.x = cvt_pk_bf16(e0 * bflo(x0.x) + e1 * bflo(x1.x) + e2 * bflo(x2.x), e0 * bfhi(x0.x) + e1 * bfhi(x1.x) + e2 * bfhi(x2.x));
            o.y = cvt_pk_bf16(e0 * bflo(x0.y) + e1 * bflo(x1.y) + e2 * bflo(x2.y), e0 * bfhi(x0.y) + e1 * bfhi(x1.y) + e2 * bfhi(x2.y));
            o.z = cvt_pk_bf16(e0 * bflo(x0.z) + e1 * bflo(x1.z) + e2 * bflo(x2.z), e0 * bfhi(x0.z) + e1 * bfhi(x1.z) + e2 * bfhi(x2.z));
            o.w = cvt_pk_bf16(e0 * bflo(x0.w) + e1 * bflo(x1.w) + e2 * bflo(x2.w), e0 * bfhi(x0.w) + e1 * bfhi(x1.w) + e2 * bfhi(x2.w));
            *(u32x4*)(OCAT + (size_t)tok * 1536 + hg_ * 128 + 8 * c) = o; }
        for (int task = gt; task < 32 * 4096; task += NGT) { const int bh = task >> 12, e4 = task & 4095;
            f32x4 S_ = {0.f, 0.f, 0.f, 0.f};
            const bf16_t* sp = ST + (size_t)bh * 32 * 16384 + 4 * e4; const float* dp = DEC + (size_t)bh * 32 * 128 + ((4 * e4) & 127); bf16_t* op = STB + (size_t)bh * 32 * 16384 + 4 * e4;
#pragma unroll 8
            for (int n = 0; n < 32; ++n) { const u32x2 kw = *(const u32x2*)(sp + (size_t)n * 16384); const f32x4 kv = {bflo(kw.x), bfhi(kw.x), bflo(kw.y), bfhi(kw.y)}; const f32x4 dc = *(const f32x4*)(dp + n * 128);
                u32x2 wv; wv.x = cvt_pk_bf16(S_[0], S_[1]); wv.y = cvt_pk_bf16(S_[2], S_[3]); *(u32x2*)(op + (size_t)n * 16384) = wv; S_ = dc * S_ + kv; } }
    }
    SEAM(3);
    if (IN(4)) REPLOOP(4) {
      if (bid < NGEM || NGEM == 0) {
        pg8::DeferOrder S{(const bf16_t*)(ws + WS_HN), (const bf16_t*)(ws + WS_WIN), 2048, bid, 80, NGEM ? NGEM : G}; pg8::EpiProj E{QKV, HGB, GATES, KVC};
        pg8::gemm_phase2<pg8::EpiProj, pg8::DeferOrder>(lds, S, E, PART, FLAGS, 2u * 2048u); __syncthreads();
      }
      if (bid >= NGEM) hg_out_phase(lds, HGB, LB, a.in[4], STB, OCAT, tid, bid - NGEM, G - NGEM);
    }
    SEAM(4);
    if (IN(5)) REPLOOP(5) {
        pg8::ChainOrder S{OCAT, (const bf16_t*)(ws + WS_WA), 1536, 8, MTOK / 256, 2048 / 256, G, bid};
        pg8::EpiMerge E{GATES, MERGED};
        pg8::gemm_phase2<pg8::EpiMerge, pg8::ChainOrder>(lds, S, E, nullptr, nullptr, 2u * 1536u);
    }
    SEAM(5);
    if (IN(6)) { pg8::SplitOrder S; S.init(MERGED, (const bf16_t*)(ws + WS_WOUT), MTOK, 2048, 2048, 0, G, bid); pg8::EpiRes<false> E{a.in[0], XB, sumsq};
        pg8::gemm_phase2<pg8::EpiRes<false>, pg8::SplitOrder>(lds, S, E, PART, FLAGS, 2u * 2048u); }
    SEAM(6);
    if (IN(8)) REPLOOP(8) {
        for (int u = bid; u < 256; u += G) { const int b_ = u >> 6, h = (u >> 4) & 3, qb = u & 15; const size_t r0 = (size_t)(b_ * 2048 + qb * 128);
            const bf16_t* kb = KVC + (size_t)(b_ * 256 + 128) * 1024 + h * 128;
            bf16x8 qf[4]; cross_q_tile(lds, XB + r0 * 2048, (const bf16_t*)(ws + WS_WQ) + (size_t)(h * 128) * 2048, sumsq + r0, tid, qf);
            attn_unit<false, true>(lds, nullptr, 512, kb, 1024, kb + 512, 1024, true, OC + r0 * 512 + h * 128, 512, nullptr, 0, tid, qf); }
    }
    SEAM(8);
    if (IN(9)) { pg8::SplitOrder S; S.init(OC, (const bf16_t*)(ws + WS_WO), MTOK, 2048, 512, 0, G, bid); pg8::EpiRes<true> E{XB, XB, sumsq + 8192};
        pg8::gemm_phase2<pg8::EpiRes<true>, pg8::SplitOrder>(lds, S, E, PART, FLAGS, 2u * 512u); }
    SEAM(9);
    if (IN(10)) REPLOOP(10) { pg8::SplitOrder S; S.init(XB, (const bf16_t*)(ws + WS_W13), MTOK, 2 * DFF_, 2048, 0, G, bid); pg8::EpiSwiGLU E{sumsq + 8192, GB};
        pg8::gemm_phase2<pg8::EpiSwiGLU, pg8::SplitOrder>(lds, S, E, PART, FLAGS + 4096, 2u * 2048u); }
    SEAM(10);
    if (IN(11)) { pg8::SplitOrder S; S.init(GB, (const bf16_t*)(ws + WS_W2), MTOK, 2048, DFF_, 0, G, bid); pg8::EpiFinal E{XB, a.out, sumsq + 16384, a.in[18], FLAGS};
        pg8::gemm_phase2<pg8::EpiFinal, pg8::SplitOrder>(lds, S, E, PART, FLAGS, 2u * 5632u); }
#undef IN
#undef SEAM
}

#ifndef N_LAUNCH_MODE
#define N_LAUNCH_MODE 1
#endif
extern "C" void kernel_launch(void* const* d_in, const int* in_sizes, int n_in, void* d_out, int out_size, void* d_ws, size_t ws_size, hipStream_t stream) {
    static int grid = 0;
    if (grid == 0) {
        if (n_in != 19 || out_size != MTOK * DMODEL || ws_size < WS_END) { fprintf(stderr, "kernel_launch: unexpected problem (n_in %d out %d ws %zu)\n", n_in, out_size, ws_size); grid = -1; return; }
        int dev = 0, cus = 0, per_cu = 0;
        hipGetDevice(&dev); hipDeviceGetAttribute(&cus, hipDeviceAttributeMultiprocessorCount, dev);
        if (hipFuncSetAttribute((const void*)fwd_kernel, hipFuncAttributeMaxDynamicSharedMemorySize, LDS_BYTES) != hipSuccess) { fprintf(stderr, "kernel_launch: hipFuncSetAttribute failed\n"); grid = -1; return; }
        if (hipOccupancyMaxActiveBlocksPerMultiprocessor(&per_cu, (const void*)fwd_kernel, NTHR, LDS_BYTES) != hipSuccess || per_cu < 1) { fprintf(stderr, "kernel_launch: occupancy query gave %d\n", per_cu); per_cu = 1; }
        (void)hipGetLastError();
        grid = cus * 1;
        fprintf(stderr, "kernel_launch: grid %d (cus %d, per_cu %d)\n", grid, cus, per_cu);
    }
    if (grid < 0) return;
    if (hipMemsetAsync((char*)d_ws + WS_BAR, 0, BAR_BYTES, stream) != hipSuccess) { fprintf(stderr, "kernel_launch: memset failed\n"); return; }
    Args a{};
    for (int i = 0; i < 19; ++i) a.in[i] = (const float*)d_in[i];
    a.out = (float*)d_out; a.ws = (unsigned char*)d_ws;
#if N_LAUNCH_MODE == 1
    a.ph_lo = 0; a.ph_hi = NPHASE;
    void* args[] = {&a};
    hipError_t e = hipLaunchCooperativeKernel((const void*)fwd_kernel, dim3(grid), dim3(NTHR), args, LDS_BYTES, stream);
    if (e != hipSuccess) fprintf(stderr, "kernel_launch: cooperative launch failed: %s (grid %d)\n", hipGetErrorString(e), grid);
#else
    for (int p = 0; p < NPHASE; ++p) { a.ph_lo = p; a.ph_hi = p + 1; hipLaunchKernelGGL(fwd_kernel, dim3(grid), dim3(NTHR), LDS_BYTES, stream, a); }
#endif
}
```

```cpp
#include <hip/hip_runtime.h>
#include <hip/hip_cooperative_groups.h>
#include <cstdio>
#include <cstdint>
#include <cmath>
namespace cg = cooperative_groups;
namespace pg8 {
#define PG8_LAS __attribute__((address_space(3)))
typedef unsigned short bf16_t;
typedef short bf16x8 __attribute__((ext_vector_type(8)));
typedef float f32x4 __attribute__((ext_vector_type(4)));
typedef unsigned u32x4 __attribute__((ext_vector_type(4)));
constexpr int BM = 256, BK = 64, HALF = 128, HTB = HALF * BK * 2  , STAGE_BYTES = 8 * HTB, NXCD = 8, WGM = 8;

__host__ __device__ __forceinline__ int lds_byte(int r, int c) { const int st = (r >> 4) * 2 + (c >> 5), rr = r & 15, cc = c & 31, ob = rr * 64 + cc * 2; return st * 1024 + (ob ^ (((ob >> 9) & 1) << 5)); }
__host__ __device__ __forceinline__ void stage_rc(int b, int& R, int& C) { const int st = b / 1024, sb = b % 1024, swz = sb ^ (((sb >> 9) & 1) << 5); R = (st >> 1) * 16 + swz / 64; C = (st & 1) * 32 + (swz % 64) / 2; }
__host__ __device__ __forceinline__ int perm32(int rho) { const int n = rho >> 4, i = rho & 15; return 8 * (i >> 2) + 4 * n + (i & 3); }

struct Unit { int pm, pn; };
struct Gemm { const bf16_t* A; const bf16_t* Bt; int M, N, K; };

struct StaticOrder {
    int nM, nN, nwg, G, c;
    __host__ __device__ void init(int M, int N, int G_, int c_) { nM = M / BM; nN = N / BM; nwg = nM * nN; G = G_; c = c_; }
    __host__ __device__ bool next(int i, Unit& u) const {
        const long L = (long)i * G + c; if (L >= nwg) return false;
        int wgid = (int)L; { const int q = nwg / NXCD, r = nwg % NXCD, xcd = wgid % NXCD, off = wgid / NXCD; wgid = (xcd < r ? xcd * (q + 1) : r * (q + 1) + (xcd - r) * q) + off; }
        const int nig = WGM * nN, gid = wgid / nig, fm = gid * WGM, gsz = (nM - fm) < WGM ? (nM - fm) : WGM;
        u.pm = fm + ((wgid % nig) % gsz); u.pn = (wgid % nig) / gsz; return true;
    }
    __device__ __forceinline__ void a_ready(const Unit&) const {}
    __device__ __forceinline__ void done(const Unit&) const {}
};

__device__ __forceinline__ unsigned cvt_pk_bf16(float lo, float hi) { unsigned r; asm volatile("v_cvt_pk_bf16_f32 %0, %1, %2" : "=v"(r) : "v"(lo), "v"(hi)); return r; }
typedef float f32x2 __attribute__((ext_vector_type(2)));
typedef unsigned u32x2 __attribute__((ext_vector_type(2)));
__device__ __forceinline__ float sigm(float x) { return __builtin_amdgcn_rcpf(1.f + __expf(-x)); }
__device__ __forceinline__ float silu(float x) { return x * sigm(x); }
__device__ __forceinline__ float bflo(unsigned w) { return __uint_as_float(w << 16); }
__device__ __forceinline__ float bfhi(unsigned w) { return __uint_as_float(w & 0xffff0000u); }
constexpr float RMS_EPS_ = 1e-6f;

struct Order1 {
    StaticOrder so; int nmain;
    __host__ __device__ void init(int G_, int c_) { so.init(8192, 12800, G_, c_); nmain = so.nwg; }
    __host__ __device__ bool next(int i, Unit& u) const {
        const long L = (long)i * so.G + so.c;
        if (L < nmain) return so.next(i, u);
        const int e = (int)(L - nmain); if (e >= 16) return false;
        u.pm = 32 + (e >> 2); u.pn = 50 + (e & 3); return true;
    }
    __device__ __forceinline__ void a_ready(const Unit&) const {}
    __device__ __forceinline__ void done(const Unit&) const {}
};

struct EpiProj {
    static constexpr bool PERM = true, AFTER_DRAIN = false;
    bf16_t* qkv; bf16_t* hg; bf16_t* gates; bf16_t* kvc;
    __device__ __forceinline__ void operator()(const f32x4 (&acc)[2][2][4][2], const Unit& u, int wr, int wc, int fr, int fq) const {
        const int pn = u.pn; bf16_t* base; int ldc, colt, act, rowt = u.pm * BM;
        if (pn < 18) { base = qkv; ldc = 4608; colt = pn * 256; act = 0; }
        else if (pn < 34) { base = hg; ldc = 4096; colt = (pn - 18) * 256; const int s = (pn - 18) >> 2; act = (s == 0 || s == 3) ? 1 : 0; }
        else if (pn < 50) { base = gates; ldc = 4096; colt = (pn - 34) * 256; act = 2; }
        else { base = kvc; ldc = 1024; colt = (pn - 50) * 256; act = 0; rowt -= 8192; }
        const int row0 = rowt + wr * 64 + fr, col0 = colt + wc * 32 + 8 * fq;
#pragma unroll
        for (int ai = 0; ai < 2; ++ai)
#pragma unroll
            for (int m = 0; m < 4; ++m) { bf16_t* rowp = base + (size_t)(row0 + ai * HALF + m * 16) * ldc + col0;
#pragma unroll
                for (int bj = 0; bj < 2; ++bj) { f32x4 v0 = acc[ai][bj][m][0], v1 = acc[ai][bj][m][1];
                    if (act == 1) {
#pragma unroll
                        for (int e = 0; e < 4; ++e) { v0[e] = silu(v0[e]); v1[e] = silu(v1[e]); } }
                    else if (act == 2) {
#pragma unroll
                        for (int e = 0; e < 4; ++e) { v0[e] = sigm(v0[e]); v1[e] = sigm(v1[e]); } }
                    u32x4 w; w.x = cvt_pk_bf16(v0[0], v0[1]); w.y = cvt_pk_bf16(v0[2], v0[3]); w.z = cvt_pk_bf16(v1[0], v1[1]); w.w = cvt_pk_bf16(v1[2], v1[3]);
                    *(u32x4*)(rowp + bj * HALF) = w; } }
    }
};

struct EpiGateA {
    static constexpr bool PERM = true, AFTER_DRAIN = false;
    const bf16_t* gates; float* tmp;
    __device__ __forceinline__ void operator()(const f32x4 (&acc)[2][2][4][2], const Unit& u, int wr, int wc, int fr, int fq) const {
        const int row0 = u.pm * BM + wr * 64 + fr, col0 = u.pn * BM + wc * 32 + 8 * fq;
#pragma unroll
        for (int ai = 0; ai < 2; ++ai)
#pragma unroll
            for (int m = 0; m < 4; ++m) { const size_t r = (size_t)(row0 + ai * HALF + m * 16);
#pragma unroll
                for (int bj = 0; bj < 2; ++bj) { const int c = col0 + bj * HALF; const u32x4 g = *(const u32x4*)(gates + r * 4096 + c);
                    f32x4 o0 = acc[ai][bj][m][0], o1 = acc[ai][bj][m][1];
                    o0[0] *= bflo(g.x); o0[1] *= bfhi(g.x); o0[2] *= bflo(g.y); o0[3] *= bfhi(g.y); o1[0] *= bflo(g.z); o1[1] *= bfhi(g.z); o1[2] *= bflo(g.w); o1[3] *= bfhi(g.w);
                    *(f32x4*)(tmp + r * 2048 + c) = o0; *(f32x4*)(tmp + r * 2048 + c + 4) = o1; } }
    }
};
struct EpiGateB {
    static constexpr bool PERM = true, AFTER_DRAIN = false;
    const bf16_t* gates; const float* tmp; bf16_t* out;
    __device__ __forceinline__ void operator()(const f32x4 (&acc)[2][2][4][2], const Unit& u, int wr, int wc, int fr, int fq) const {
        const int row0 = u.pm * BM + wr * 64 + fr, col0 = u.pn * BM + wc * 32 + 8 * fq;
#pragma unroll
        for (int ai = 0; ai < 2; ++ai)
#pragma unroll
            for (int m = 0; m < 4; ++m) { const size_t r = (size_t)(row0 + ai * HALF + m * 16);
#pragma unroll
                for (int bj = 0; bj < 2; ++bj) { const int c = col0 + bj * HALF; const u32x4 g = *(const u32x4*)(gates + r * 4096 + c);
                    f32x4 o0 = *(const f32x4*)(tmp + r * 2048 + c), o1 = *(const f32x4*)(tmp + r * 2048 + c + 4); const f32x4 a0 = acc[ai][bj][m][0], a1 = acc[ai][bj][m][1];
                    o0[0] += a0[0] * bflo(g.x); o0[1] += a0[1] * bfhi(g.x); o0[2] += a0[2] * bflo(g.y); o0[3] += a0[3] * bfhi(g.y);
                    o1[0] += a1[0] * bflo(g.z); o1[1] += a1[1] * bfhi(g.z); o1[2] += a1[2] * bflo(g.w); o1[3] += a1[3] * bfhi(g.w);
                    u32x4 w; w.x = cvt_pk_bf16(o0[0], o0[1]); w.y = cvt_pk_bf16(o0[2], o0[3]); w.z = cvt_pk_bf16(o1[0], o1[1]); w.w = cvt_pk_bf16(o1[2], o1[3]);
                    *(u32x4*)(out + r * 2048 + c) = w; } }
    }
};
template <bool RES_BF16> struct EpiRes {
    static constexpr bool PERM = true, AFTER_DRAIN = false;
    const void* resid; bf16_t* outb; float* sumsq;
    __device__ __forceinline__ void operator()(const f32x4 (&acc)[2][2][4][2], const Unit& u, int wr, int wc, int fr, int fq) const {
        const int row0 = u.pm * BM + wr * 64 + fr, col0 = u.pn * BM + wc * 32 + 8 * fq;
#pragma unroll
        for (int ai = 0; ai < 2; ++ai)
#pragma unroll
            for (int m = 0; m < 4; ++m) { const size_t r = (size_t)(row0 + ai * HALF + m * 16); float ss = 0.f;
#pragma unroll
                for (int bj = 0; bj < 2; ++bj) { const int c = col0 + bj * HALF; f32x4 o0, o1;
                    if (RES_BF16) { const u32x4 g = *(const u32x4*)((const bf16_t*)resid + r * 2048 + c);
                        o0 = (f32x4){bflo(g.x), bfhi(g.x), bflo(g.y), bfhi(g.y)} + acc[ai][bj][m][0]; o1 = (f32x4){bflo(g.z), bfhi(g.z), bflo(g.w), bfhi(g.w)} + acc[ai][bj][m][1]; }
                    else { o0 = *(const f32x4*)((const float*)resid + r * 2048 + c) + acc[ai][bj][m][0]; o1 = *(const f32x4*)((const float*)resid + r * 2048 + c + 4) + acc[ai][bj][m][1]; }
                    ss += (o0[0] * o0[0] + o0[1] * o0[1]) + (o0[2] * o0[2] + o0[3] * o0[3]) + (o1[0] * o1[0] + o1[1] * o1[1]) + (o1[2] * o1[2] + o1[3] * o1[3]);
                    u32x4 w; w.x = cvt_pk_bf16(o0[0], o0[1]); w.y = cvt_pk_bf16(o0[2], o0[3]); w.z = cvt_pk_bf16(o1[0], o1[1]); w.w = cvt_pk_bf16(o1[2], o1[3]); *(u32x4*)(outb + r * 2048 + c) = w; }
                ss += __shfl_xor(ss, 16); ss += __shfl_xor(ss, 32);
                if (fq == 0) atomicAdd(sumsq + r, ss); }
    }
};
struct EpiQ {
    static constexpr bool PERM = true, AFTER_DRAIN = false;
    const float* sumsq; bf16_t* out; float scale;
    __device__ __forceinline__ void operator()(const f32x4 (&acc)[2][2][4][2], const Unit& u, int wr, int wc, int fr, int fq) const {
        const int row0 = u.pm * BM + wr * 64 + fr, col0 = u.pn * BM + wc * 32 + 8 * fq;
#pragma unroll
        for (int ai = 0; ai < 2; ++ai)
#pragma unroll
            for (int m = 0; m < 4; ++m) { const size_t r = (size_t)(row0 + ai * HALF + m * 16); const float rs = rsqrtf(sumsq[r] * (1.f / 2048.f) + RMS_EPS_) * scale;
#pragma unroll
                for (int bj = 0; bj < 2; ++bj) { const int c = col0 + bj * HALF; const f32x4 v0 = acc[ai][bj][m][0] * rs, v1 = acc[ai][bj][m][1] * rs;
                    u32x4 w; w.x = cvt_pk_bf16(v0[0], v0[1]); w.y = cvt_pk_bf16(v0[2], v0[3]); w.z = cvt_pk_bf16(v1[0], v1[1]); w.w = cvt_pk_bf16(v1[2], v1[3]);
                    *(u32x4*)(out + r * 512 + c) = w; } }
    }
};
struct EpiSwiGLU {
    static constexpr bool PERM = true, AFTER_DRAIN = false;
    const float* sumsq; bf16_t* out;
    __device__ __forceinline__ void operator()(const f32x4 (&acc)[2][2][4][2], const Unit& u, int wr, int wc, int fr, int fq) const {
        const int row0 = u.pm * BM + wr * 64 + fr, col0 = u.pn * HALF + wc * 32 + 8 * fq;
#pragma unroll
        for (int ai = 0; ai < 2; ++ai)
#pragma unroll
            for (int m = 0; m < 4; ++m) { const size_t r = (size_t)(row0 + ai * HALF + m * 16); const float rs = rsqrtf(sumsq[r] * (1.f / 2048.f) + RMS_EPS_);
                float g[8];
#pragma unroll
                for (int n = 0; n < 2; ++n)
#pragma unroll
                    for (int e = 0; e < 4; ++e) g[4 * n + e] = silu(acc[ai][0][m][n][e] * rs) * (acc[ai][1][m][n][e] * rs);
                u32x4 w; w.x = cvt_pk_bf16(g[0], g[1]); w.y = cvt_pk_bf16(g[2], g[3]); w.z = cvt_pk_bf16(g[4], g[5]); w.w = cvt_pk_bf16(g[6], g[7]);
                *(u32x4*)(out + r * 5632 + col0) = w; }
    }
};
struct Unit2 : Unit { const char* A; const char* B; int nt; int mode, slot, aux, pstr; };
__device__ __forceinline__ void part_store(const f32x4 (&acc)[2][2][4][2], float* part, unsigned* flags, const Unit2& u, int tid, int lane) {
    float* p = part + ((size_t)(u.slot * u.pstr + u.aux) * 32) * 2048 + (size_t)tid * 4;
#pragma unroll
    for (int ai = 0; ai < 2; ++ai)
#pragma unroll
        for (int bj = 0; bj < 2; ++bj)
#pragma unroll
            for (int m = 0; m < 4; ++m)
#pragma unroll
                for (int n = 0; n < 2; ++n) *(f32x4*)(p + (size_t)(((ai * 2 + bj) * 4 + m) * 2 + n) * 2048) = acc[ai][bj][m][n];
    __builtin_amdgcn_fence(__ATOMIC_RELEASE, "agent");
    asm volatile("s_waitcnt vmcnt(0)" ::: "memory");
    if (lane == 0) __hip_atomic_fetch_add(flags + 16 * u.slot, 1u, __ATOMIC_RELAXED, __HIP_MEMORY_SCOPE_AGENT);
}
__device__ __forceinline__ void part_wait_add(f32x4 (&acc)[2][2][4][2], const float* part, unsigned* flags, const Unit2& u, int tid, int lane) {
    const int np = (u.mode == 2) ? u.aux : 0;
    if (np > 0) { const unsigned want = 8u * (unsigned)np; unsigned spins = 0;
        for (;;) { unsigned v = 0; if (lane == 0) v = __hip_atomic_load(flags + 16 * u.slot, __ATOMIC_RELAXED, __HIP_MEMORY_SCOPE_AGENT);
            if ((unsigned)__builtin_amdgcn_readfirstlane(v) >= want) break;
            __builtin_amdgcn_s_sleep(1); if (++spins > (1u << 20)) break; }
        __builtin_amdgcn_fence(__ATOMIC_ACQUIRE, "agent"); }
    for (int pi = 0; pi < np; ++pi) { const float* p = part + ((size_t)(u.slot * u.pstr + pi) * 32) * 2048 + (size_t)tid * 4;
#pragma unroll
        for (int ai = 0; ai < 2; ++ai)
#pragma unroll
            for (int bj = 0; bj < 2; ++bj) {
#pragma unroll
                for (int m = 0; m < 4; ++m)
#pragma unroll
                    for (int n = 0; n < 2; ++n) acc[ai][bj][m][n] += *(const f32x4*)(p + (size_t)(((ai * 2 + bj) * 4 + m) * 2 + n) * 2048);
                asm volatile("" ::: "memory"); } }
}

template <class Epi, class Sched>
__device__ __forceinline__ void gemm_phase2(PG8_LAS unsigned char* lds, const Sched& S, const Epi& E, float* part, unsigned* flags, const unsigned ld2  ) {
    const int tid = threadIdx.x, wid = __builtin_amdgcn_readfirstlane(tid >> 6), lane = tid & 63, wr = wid >> 2, wc = wid & 3, fr = lane & 15, fq = lane >> 4;
    unsigned voffA[2], voffB[2];
#pragma unroll
    for (int i = 0; i < 2; ++i) { int R, C; stage_rc(tid * 16 + i * 8192, R, C); const int Rb = Epi::PERM ? ((R & ~31) + perm32(R & 31)) : R;
        voffA[i] = (unsigned)R * ld2 + (unsigned)C * 2u; voffB[i] = (unsigned)Rb * ld2 + (unsigned)C * 2u; }
    const size_t kstep = (size_t)(BK * 2);
    const size_t hs = (size_t)HALF * ld2;
    const unsigned ldsw = (unsigned)wid * 1024u;
    const int aoff = lds_byte(wr * 64 + fr, fq * 8), boff = lds_byte(wc * 32 + fr, fq * 8);
#define PG8_SA(b, h) (((b) * 2 + (h)) * HTB)
#define PG8_SB(b, h) ((4 + (b) * 2 + (h)) * HTB)
#define PG8_STAGE(bufoff, gbase, voff) do { _Pragma("unroll") for (int _i = 0; _i < 2; ++_i) \
        __builtin_amdgcn_global_load_lds((const unsigned*)((const char*)(gbase) + (voff)[_i]), (PG8_LAS unsigned*)(lds + (bufoff) + ldsw + _i * 8192), 16, 0, 0); } while (0)
#define PG8_LDA(dst, b, h) do { _Pragma("unroll") for (int m = 0; m < 4; ++m) _Pragma("unroll") for (int k = 0; k < 2; ++k) dst[m][k] = *(const PG8_LAS bf16x8*)(lds + PG8_SA(b, h) + aoff + m * 2048 + k * 1024); } while (0)
#define PG8_LDB(dst, b, h) do { _Pragma("unroll") for (int n = 0; n < 2; ++n) _Pragma("unroll") for (int k = 0; k < 2; ++k) dst[n][k] = *(const PG8_LAS bf16x8*)(lds + PG8_SB(b, h) + boff + n * 2048 + k * 1024); } while (0)
#define PG8_MMA(ai, bj, At, Bt) do { __builtin_amdgcn_s_setprio(1); _Pragma("unroll") for (int m = 0; m < 4; ++m) _Pragma("unroll") for (int n = 0; n < 2; ++n) _Pragma("unroll") for (int k = 0; k < 2; ++k) \
        acc[ai][bj][m][n] = __builtin_amdgcn_mfma_f32_16x16x32_bf16(Bt[n][k], At[m][k], acc[ai][bj][m][n], 0, 0, 0); __builtin_amdgcn_s_setprio(0); } while (0)
#define PG8_WAIT_V(n) asm volatile("s_waitcnt vmcnt(" #n ")" ::: "memory")
#define PG8_WAIT_L(n) asm volatile("s_waitcnt lgkmcnt(" #n ")" ::: "memory")
#define PG8_BAR __builtin_amdgcn_s_barrier()
#define PG8_SCHED __builtin_amdgcn_sched_barrier(0)
    Unit2 cur, nxt; int ui = 0;
    if (!S.next(0, cur)) return;
    f32x4 acc[2][2][4][2];
#pragma unroll
    for (int a = 0; a < 2; ++a)
#pragma unroll
        for (int b = 0; b < 2; ++b)
#pragma unroll
            for (int m = 0; m < 4; ++m)
#pragma unroll
                for (int n = 0; n < 2; ++n) acc[a][b][m][n] = (f32x4){0.f, 0.f, 0.f, 0.f};
    bf16x8 At[4][2], B0[2][2], B1[2][2];
    const char* cA = cur.A; const char* cB = cur.B;
    {
        PG8_STAGE(PG8_SB(0, 0), cB, voffB); PG8_STAGE(PG8_SB(0, 1), cB + hs, voffB); PG8_STAGE(PG8_SA(0, 0), cA, voffA); PG8_STAGE(PG8_SA(0, 1), cA + hs, voffA);
        if (wr == 1) PG8_BAR;
        PG8_WAIT_V(2); PG8_BAR;
        PG8_STAGE(PG8_SB(1, 0), cB + kstep, voffB); PG8_STAGE(PG8_SA(1, 0), cA + kstep, voffA); PG8_STAGE(PG8_SB(1, 1), cB + hs + kstep, voffB);
        PG8_WAIT_V(6); PG8_BAR;
    }
    for (;;) {
        const bool has_next = S.next(ui + 1, nxt);
        const char* nA = has_next ? nxt.A : cA; const char* nB = has_next ? nxt.B : cB;
        const int nt = cur.nt;
        for (int t = 0; t < nt; t += 2) {
            const bool last = (t == nt - 2);
            const char* a1 = cA + (size_t)(t + 1) * kstep;
            const char* a2 = last ? nA : cA + (size_t)(t + 2) * kstep; const char* b2 = last ? nB : cB + (size_t)(t + 2) * kstep;
            const char* a3 = a2 + kstep; const char* b3 = b2 + kstep;
            PG8_LDB(B0, 0, 0); PG8_LDB(B1, 0, 1); PG8_SCHED; PG8_LDA(At, 0, 0); PG8_STAGE(PG8_SA(1, 1), a1 + hs, voffA);
            PG8_WAIT_V(8); PG8_WAIT_L(0); PG8_BAR; PG8_MMA(0, 0, At, B0); PG8_MMA(0, 1, At, B1); PG8_BAR; PG8_SCHED;
            PG8_LDA(At, 0, 1); PG8_STAGE(PG8_SB(0, 0), b2, voffB); PG8_STAGE(PG8_SB(0, 1), b2 + hs, voffB); PG8_STAGE(PG8_SA(0, 0), a2, voffA);
            PG8_WAIT_V(8); PG8_WAIT_L(0); PG8_BAR; PG8_MMA(1, 0, At, B0); PG8_MMA(1, 1, At, B1); PG8_BAR; PG8_SCHED;
            PG8_LDB(B0, 1, 0); PG8_LDB(B1, 1, 1); PG8_SCHED; PG8_LDA(At, 1, 0); PG8_STAGE(PG8_SA(0, 1), a2 + hs, voffA);
            PG8_WAIT_V(8); PG8_WAIT_L(0); PG8_BAR; PG8_MMA(0, 0, At, B0); PG8_MMA(0, 1, At, B1); PG8_BAR; PG8_SCHED;
            PG8_LDA(At, 1, 1); PG8_STAGE(PG8_SB(1, 0), b3, voffB); PG8_STAGE(PG8_SB(1, 1), b3 + hs, voffB); PG8_STAGE(PG8_SA(1, 0), a3, voffA);
            PG8_WAIT_V(8); PG8_WAIT_L(0); PG8_BAR; PG8_MMA(1, 0, At, B0); PG8_MMA(1, 1, At, B1); PG8_BAR; PG8_SCHED;
        }
        if (wr == 0) PG8_BAR;
        {
            int tid_ = tid, lane_ = lane, fr_ = fr, fq_ = fq; asm volatile("" : "+v"(tid_), "+v"(lane_), "+v"(fr_), "+v"(fq_));
            E(acc, cur, wr, wc, fr_, fq_); }
        if (!has_next) break;
        if (cur.mode != 3) {
#pragma unroll
            for (int a = 0; a < 2; ++a)
#pragma unroll
                for (int b = 0; b < 2; ++b)
#pragma unroll
                    for (int m = 0; m < 4; ++m)
#pragma unroll
                        for (int n = 0; n < 2; ++n) acc[a][b][m][n] = (f32x4){0.f, 0.f, 0.f, 0.f};
        }
        cur = nxt; cA = nA; cB = nB; ++ui;
        if (wr == 1) PG8_BAR;
    }
    PG8_WAIT_V(0);
    PG8_BAR;
#undef PG8_SA
#undef PG8_SB
#undef PG8_STAGE
#undef PG8_LDA
#undef PG8_LDB
#undef PG8_MMA
#undef PG8_WAIT_V
#undef PG8_WAIT_L
#undef PG8_BAR
#undef PG8_SCHED
}

__device__ __forceinline__ void unit_of(int L, int nM, int nN, int& pm, int& pn) {
    const int nwg = nM * nN;
    if (L >= nwg) { const int e = L - nwg; pm = nM + (e >> 2); pn = nN + (e & 3); return; }
    int wgid = L; { const int q = nwg / NXCD, r = nwg % NXCD, xcd = wgid % NXCD, off = wgid / NXCD; wgid = (xcd < r ? xcd * (q + 1) : r * (q + 1) + (xcd - r) * q) + off; }
    const int nig = WGM * nN, gid = wgid / nig, fm = gid * WGM, gsz = (nM - fm) < WGM ? (nM - fm) : WGM;
    pm = fm + ((wgid % nig) % gsz); pn = (wgid % nig) / gsz;
}
struct SplitOrder {
    const bf16_t* A; const bf16_t* B; int K, nM, nN, U, G, c, nfull, tail, ways;
    __device__ __forceinline__ void init(const bf16_t* A_, const bf16_t* B_, int M, int N, int K_, int nextra, int G_, int c_) {
        A = A_; B = B_; K = K_; nM = M / BM; nN = N / BM; U = nM * nN + nextra; G = G_; c = c_; nfull = U / G; tail = U - nfull * G;
        ways = 1;
    }
    __device__ __forceinline__ bool next(int i, Unit2& u) const {
        int L, kt0 = 0, ntu = K / BK; u.mode = 0; u.slot = 0; u.aux = 0; u.pstr = ways - 1;
        if (i < nfull) L = i * G + c;
        else if (i == nfull && c < tail * ways) { const int j = c % tail, p = c / tail; L = nfull * G + j;
            if (ways > 1) { ntu = (K / BK) / ways; kt0 = p * ntu; u.mode = (p == 0) ? 2 : 1; u.slot = j; u.aux = (p == 0) ? ways - 1 : p - 1; } }
        else return false;
        unit_of(L, nM, nN, u.pm, u.pn);
        u.A = (const char*)(A + (size_t)u.pm * BM * K + (size_t)kt0 * BK); u.B = (const char*)(B + (size_t)u.pn * BM * K + (size_t)kt0 * BK); u.nt = ntu;
        return true;
    }
};
struct DeferOrder {
    const bf16_t* A; const bf16_t* B; int K, d0, d1, step;
    __device__ __forceinline__ bool next(int i, Unit2& u) const {
        const int d = d0 + i * step; if (d >= d1) return false;
        if (d < 64) { u.pm = d >> 1; u.pn = 48 + (d & 1); } else { const int e = d - 64; u.pm = 32 + (e >> 2); u.pn = 50 + (e & 3); }
        u.mode = 0; u.slot = 0; u.aux = 0; u.pstr = 0; u.nt = K / BK;
        u.A = (const char*)(A + (size_t)u.pm * BM * K); u.B = (const char*)(B + (size_t)u.pn * BM * K);
        return true;
    }
};
struct ChainOrder {
    const bf16_t *A, *B; int K, nt1, nM, nN, G, c;
    __device__ __forceinline__ bool next(int i, Unit2& u) const {
        const int L = (i >> 1) * G + c; if (L >= nM * nN) return false;
        unit_of(L, nM, nN, u.pm, u.pn); u.slot = 0; u.aux = 0; u.pstr = 0;
        const int kt0 = (i & 1) ? nt1 : 0; u.nt = (i & 1) ? K / BK - nt1 : nt1; u.mode = (i & 1) ? 0 : 3;
        u.A = (const char*)(A + (size_t)u.pm * BM * K + (size_t)kt0 * BK); u.B = (const char*)(B + (size_t)u.pn * BM * K + (size_t)kt0 * BK);
        return true;
    }
};
struct EpiFinal {
    static constexpr bool PERM = true, AFTER_DRAIN = false;
    const bf16_t* resid; float* out; float* sumsq; const float* wf; unsigned* cnt;
    __device__ __forceinline__ void operator()(f32x4 (&acc)[2][2][4][2], const Unit2& u, int wr, int wc, int fr, int fq) const {
        const int row0 = u.pm * BM + wr * 64 + fr, col0 = u.pn * BM + wc * 32 + 8 * fq;
#pragma unroll
        for (int ai = 0; ai < 2; ++ai)
#pragma unroll
            for (int m = 0; m < 4; ++m) { const size_t r = (size_t)(row0 + ai * HALF + m * 16); float ss = 0.f;
#pragma unroll
                for (int bj = 0; bj < 2; ++bj) { const int c = col0 + bj * HALF; const u32x4 g = *(const u32x4*)(resid + r * 2048 + c);
                    const f32x4 o0 = (f32x4){bflo(g.x), bfhi(g.x), bflo(g.y), bfhi(g.y)} + acc[ai][bj][m][0], o1 = (f32x4){bflo(g.z), bfhi(g.z), bflo(g.w), bfhi(g.w)} + acc[ai][bj][m][1];
                    acc[ai][bj][m][0] = o0; acc[ai][bj][m][1] = o1;
                    ss += (o0[0] * o0[0] + o0[1] * o0[1]) + (o0[2] * o0[2] + o0[3] * o0[3]) + (o1[0] * o1[0] + o1[1] * o1[1]) + (o1[2] * o1[2] + o1[3] * o1[3]); }
                ss += __shfl_xor(ss, 16); ss += __shfl_xor(ss, 32);
                if (fq == 0) atomicAdd(sumsq + r, ss); }
        asm volatile("s_waitcnt vmcnt(0)" ::: "memory");
        const int lane = fq * 16 + fr;
        if (lane == 0) __hip_atomic_fetch_add(cnt + 16 * u.pm, 1u, __ATOMIC_RELAXED, __HIP_MEMORY_SCOPE_AGENT);
        { unsigned spins = 0;
          for (;;) { unsigned v = 0; if (lane == 0) v = __hip_atomic_load(cnt + 16 * u.pm, __ATOMIC_RELAXED, __HIP_MEMORY_SCOPE_AGENT);
              if ((unsigned)__builtin_amdgcn_readfirstlane(v) >= 64u) break;
              __builtin_amdgcn_s_sleep(2); if (++spins > (1u << 20)) break; } }
#pragma unroll
        for (int ai = 0; ai < 2; ++ai)
#pragma unroll
            for (int m = 0; m < 4; ++m) { const size_t r = (size_t)(row0 + ai * HALF + m * 16);
                const float rs = rsqrtf(__hip_atomic_load(sumsq + r, __ATOMIC_RELAXED, __HIP_MEMORY_SCOPE_AGENT) * (1.f / 2048.f) + RMS_EPS_);
#pragma unroll
                for (int bj = 0; bj < 2; ++bj) { const int c = col0 + bj * HALF; const f32x4 w0 = *(const f32x4*)(wf + c), w1 = *(const f32x4*)(wf + c + 4);
                    *(f32x4*)(out + r * 2048 + c) = acc[ai][bj][m][0] * rs * w0; *(f32x4*)(out + r * 2048 + c + 4) = acc[ai][bj][m][1] * rs * w1; } }
    }
};
struct EpiMerge {
    static constexpr bool PERM = true, AFTER_DRAIN = false;
    const bf16_t* gates; bf16_t* out;
    __device__ __forceinline__ void operator()(f32x4 (&acc)[2][2][4][2], const Unit2& u, int wr, int wc, int fr, int fq) const {
        const int row0 = u.pm * BM + wr * 64 + fr, col0 = u.pn * BM + wc * 32 + 8 * fq;
#pragma unroll
        for (int ai = 0; ai < 2; ++ai)
#pragma unroll
            for (int m = 0; m < 4; ++m) { const size_t r = (size_t)(row0 + ai * HALF + m * 16);
#pragma unroll
                for (int bj = 0; bj < 2; ++bj) { const int c = col0 + bj * HALF; const u32x4 gb = *(const u32x4*)(gates + r * 4096 + 2048 + c);
                    float b[8] = {bflo(gb.x), bfhi(gb.x), bflo(gb.y), bfhi(gb.y), bflo(gb.z), bfhi(gb.z), bflo(gb.w), bfhi(gb.w)};
                    if (u.mode == 3) { const u32x4 ga = *(const u32x4*)(gates + r * 4096 + c);
                        const float a[8] = {bflo(ga.x), bfhi(ga.x), bflo(ga.y), bfhi(ga.y), bflo(ga.z), bfhi(ga.z), bflo(ga.w), bfhi(ga.w)};
#pragma unroll
                        for (int e = 0; e < 4; ++e) { acc[ai][bj][m][0][e] *= a[e] * __builtin_amdgcn_rcpf(fmaxf(b[e], 1e-30f)); acc[ai][bj][m][1][e] *= a[4 + e] * __builtin_amdgcn_rcpf(fmaxf(b[4 + e], 1e-30f)); } }
                    else { const f32x4 a0 = acc[ai][bj][m][0], a1 = acc[ai][bj][m][1];
                        u32x4 w; w.x = cvt_pk_bf16(a0[0] * b[0], a0[1] * b[1]); w.y = cvt_pk_bf16(a0[2] * b[2], a0[3] * b[3]); w.z = cvt_pk_bf16(a1[0] * b[4], a1[1] * b[5]); w.w = cvt_pk_bf16(a1[2] * b[6], a1[3] * b[7]);
                        *(u32x4*)(out + r * 2048 + c) = w; } } }
    }
};
}
using pg8::bf16_t; using pg8::bf16x8; using pg8::f32x4; using pg8::u32x4; using pg8::u32x2; using pg8::cvt_pk_bf16; using pg8::sigm; using pg8::bflo; using pg8::bfhi;
#define LAS __attribute__((address_space(3)))
constexpr int NTHR = 512;
constexpr int DMODEL = 2048, MTOK = 8192, SEQL = 2048, MMEM = 1024, DFF_ = 5632;
constexpr float EPS = 1e-6f;
constexpr float ATT_SCALE = 0.08838834764831845f;

constexpr size_t MiB = 1u << 20;
constexpr size_t WS_SUMSQ = 0;
constexpr size_t WS_LB = 128 * 1024;
constexpr size_t WS_BAR = 192 * 1024, BAR_BYTES = 48 * 1024, WS_FLAGS = WS_BAR + 16 * 1024;
constexpr size_t WS_LSE = 256 * 1024;
constexpr size_t WS_DEC = 1 * MiB;
constexpr size_t WS_WIN = 2 * MiB, WS_WKV = 52 * MiB, WS_WA = 56 * MiB, WS_WB = 58 * MiB, WS_WOUT = 62 * MiB, WS_WQ = 70 * MiB, WS_WO = 72 * MiB, WS_W13 = 74 * MiB, WS_W2 = 118 * MiB;
constexpr size_t WS_HN = 140 * MiB;
constexpr size_t WS_OG = 140 * MiB;
constexpr size_t WS_OATT = 164 * MiB;
constexpr size_t WS_QC = 164 * MiB;
constexpr size_t WS_OC = 140 * MiB;
constexpr size_t WS_QKV = 176 * MiB;
constexpr size_t WS_OCAT = 176 * MiB;
constexpr size_t WS_XB = 176 * MiB;
constexpr size_t WS_STB = 208 * MiB;
constexpr size_t WS_HG = 248 * MiB;
constexpr size_t WS_TMP = 248 * MiB;
constexpr size_t WS_G = 248 * MiB;
constexpr size_t WS_GATES = 312 * MiB;
constexpr size_t WS_KVC = 376 * MiB;
constexpr size_t WS_OHG = 378 * MiB;
constexpr size_t WS_END = 394 * MiB;

constexpr int LDS_BYTES = 147456, LDS_MISC = 147392;

__device__ __forceinline__ float wave_sum(float v) {
#pragma unroll
    for (int o = 1; o < 64; o <<= 1) v += __shfl_xor(v, o);
    return v;
}
#define LDS_FENCE() asm volatile("s_waitcnt lgkmcnt(0)" ::: "memory")

__device__ __forceinline__ void transpose_item(const float* __restrict__ W, int K, int N, bf16_t* WT, int dst_row0, const float* kscale, LAS float* scr, int k0, int n0, int lane, int dld = 0, int dcol = 0) {
    if (dld == 0) dld = K;
    const int lr = lane >> 4, lc = lane & 15;
    f32x4 v[16];
#pragma unroll
    for (int it = 0; it < 16; ++it) v[it] = __builtin_nontemporal_load((const f32x4*)(W + (size_t)(k0 + it * 4 + lr) * N + n0 + 4 * lc));
    if (kscale) {
#pragma unroll
        for (int it = 0; it < 16; ++it) v[it] = v[it] * kscale[k0 + it * 4 + lr]; }
#pragma unroll
    for (int it = 0; it < 16; ++it) { LAS float* d = scr + (it * 4 + lr) * 65 + 4 * lc; d[0] = v[it][0]; d[1] = v[it][1]; d[2] = v[it][2]; d[3] = v[it][3]; }
    LDS_FENCE();
    const int c = lane & 7;
#pragma unroll
    for (int j = 0; j < 8; ++j) { const int n = (lane >> 3) + 8 * j; const LAS float* s = scr + (8 * c) * 65 + n;
        u32x4 o; o.x = cvt_pk_bf16(s[0], s[65]); o.y = cvt_pk_bf16(s[130], s[195]); o.z = cvt_pk_bf16(s[260], s[325]); o.w = cvt_pk_bf16(s[390], s[455]);
        *(u32x4*)(WT + (size_t)(dst_row0 + n) * dld + dcol + k0 + 8 * c) = o; }
    LDS_FENCE();
}
__device__ __forceinline__ void rms_row_bf16(const float* xrow, const float* w, bf16_t* orow, int lane) {
    f32x4 v[8]; float s = 0.f;
#pragma unroll
    for (int j = 0; j < 8; ++j) { v[j] = __builtin_nontemporal_load(((const f32x4*)xrow) + lane + 64 * j); s += (v[j][0] * v[j][0] + v[j][1] * v[j][1]) + (v[j][2] * v[j][2] + v[j][3] * v[j][3]); }
    const float rstd = rsqrtf(wave_sum(s) * (1.f / 2048.f) + EPS);
#pragma unroll
    for (int j = 0; j < 8; ++j) { const f32x4 ww = ((const f32x4*)w)[lane + 64 * j]; const f32x4 o = v[j] * rstd * ww;
        u32x2 p; p.x = cvt_pk_bf16(o[0], o[1]); p.y = cvt_pk_bf16(o[2], o[3]); ((u32x2*)orow)[lane + 64 * j] = p; }
}

struct Args { const float* in[19]; float* out; unsigned char* ws; int ph_lo, ph_hi; };

__device__ __forceinline__ void phase_prologue(const Args& a, LAS unsigned char* lds, int tid) {
    const int lane = tid & 63, wave = tid >> 6; const int G = gridDim.x;
    LAS float* scr = (LAS float*)(lds + wave * 16896);
    const int gw = blockIdx.x * 8 + wave, NGW = G * 8;
    unsigned char* ws = a.ws;
    const float *w_in = a.in[3], *w_a = a.in[6], *w_b = a.in[7], *w_out = a.in[8], *wq = a.in[11], *wkv = a.in[12], *wo = a.in[13], *w1 = a.in[15], *w3 = a.in[16], *w2 = a.in[17];
    const float *ln_cross = a.in[9], *ln_ffn = a.in[14];
    constexpr int I_IN = 32 * 200, I_KV = 32 * 16, I_A = 8 * 32, I_B = 16 * 32, I_OUT = 32 * 32, I_Q = 32 * 8, I_O = 8 * 32, I_1 = 32 * 88, I_2 = 88 * 32;
    constexpr int NITEMS = I_IN + I_KV + I_A + I_B + I_OUT + I_Q + I_O + 2 * I_1 + I_2;
    for (int it = gw; it < NITEMS; it += NGW) {
        int r = it;
        if (r < I_IN) { transpose_item(w_in, 2048, 12800, (bf16_t*)(ws + WS_WIN), 64 * (r % 200), nullptr, scr, 64 * (r / 200), 64 * (r % 200), lane); continue; } r -= I_IN;
        if (r < I_KV) { transpose_item(wkv, 2048, 1024, (bf16_t*)(ws + WS_WKV), 64 * (r % 16), nullptr, scr, 64 * (r / 16), 64 * (r % 16), lane); continue; } r -= I_KV;
        if (r < I_A) { transpose_item(w_a, 512, 2048, (bf16_t*)(ws + WS_WA), 64 * (r % 32), nullptr, scr, 64 * (r / 32), 64 * (r % 32), lane, 1536, 0); continue; } r -= I_A;
        if (r < I_B) { transpose_item(w_b, 1024, 2048, (bf16_t*)(ws + WS_WA), 64 * (r % 32), nullptr, scr, 64 * (r / 32), 64 * (r % 32), lane, 1536, 512); continue; } r -= I_B;
        if (r < I_OUT) { transpose_item(w_out, 2048, 2048, (bf16_t*)(ws + WS_WOUT), 64 * (r % 32), nullptr, scr, 64 * (r / 32), 64 * (r % 32), lane); continue; } r -= I_OUT;
        if (r < I_Q) { transpose_item(wq, 2048, 512, (bf16_t*)(ws + WS_WQ), 64 * (r % 8), ln_cross, scr, 64 * (r / 8), 64 * (r % 8), lane); continue; } r -= I_Q;
        if (r < I_O) { transpose_item(wo, 512, 2048, (bf16_t*)(ws + WS_WO), 64 * (r % 32), nullptr, scr, 64 * (r / 32), 64 * (r % 32), lane); continue; } r -= I_O;
        if (r < I_1) { const int n0 = 64 * (r % 88); transpose_item(w1, 2048, 5632, (bf16_t*)(ws + WS_W13), 256 * (n0 >> 7) + (n0 & 127), ln_ffn, scr, 64 * (r / 88), n0, lane); continue; } r -= I_1;
        if (r < I_1) { const int n0 = 64 * (r % 88); transpose_item(w3, 2048, 5632, (bf16_t*)(ws + WS_W13), 256 * (n0 >> 7) + 128 + (n0 & 127), ln_ffn, scr, 64 * (r / 88), n0, lane); continue; } r -= I_1;
        transpose_item(w2, 5632, 2048, (bf16_t*)(ws + WS_W2), 64 * (r % 32), nullptr, scr, 64 * (r / 32), 64 * (r % 32), lane);
    }
    bf16_t* hn = (bf16_t*)(ws + WS_HN);
    for (int m = gw; m < MTOK + MMEM; m += NGW) {
        if (m < MTOK) rms_row_bf16(a.in[0] + (size_t)m * 2048, a.in[2], hn + (size_t)m * 2048, lane);
        else rms_row_bf16(a.in[1] + (size_t)(m - MTOK) * 2048, a.in[10], hn + (size_t)m * 2048, lane);
    }
    const int gt = blockIdx.x * NTHR + tid, NGT = G * NTHR;
    float* sumsq = (float*)(ws + WS_SUMSQ);
    for (int i = gt; i < 3 * 8192; i += NGT) sumsq[i] = 0.f;
    float* lb = (float*)(ws + WS_LB); const float* hlb = a.in[5];
    for (int i = gt; i < 1024; i += NGT) lb[i] = 1.f / (1.f + __expf(hlb[1024 + i] - hlb[i]));
}

constexpr int VTS = 136, KSS = 68;
constexpr int ATT_K_OFF = 128 * VTS * 4;
template <bool MASKED, bool QPRE = false>
__device__ __forceinline__ void attn_unit(LAS unsigned char* lds, const bf16_t* Qb, long qs, const bf16_t* Kown, long ks, const bf16_t* Vown, long vs, bool hasprev,
                                          bf16_t* Ob, long os, float* lsep, long lses, int tid, const bf16x8* qpre = nullptr) {
    const int lane = tid & 63, w = tid >> 6, fr = lane & 15, fq = lane >> 4;
    LAS unsigned* VT = (LAS unsigned*)lds; LAS unsigned* KS = (LAS unsigned*)(lds + ATT_K_OFF);
    const int iq = 16 * w + fr;
    u32x4 kx[8], vx[4], vy[4]; bf16x8 qf[4];
#pragma unroll
    for (int it = 0; it < 8; ++it) { const int id = tid + NTHR * it; long r = (id >> 4) - 128; if (!hasprev && r < 0) r = 0; kx[it] = *(const u32x4*)(Kown + r * ks + 8 * (id & 15)); }
#pragma unroll
    for (int it = 0; it < 4; ++it) { const int task = tid + NTHR * it; const int p = task & 127, c = task >> 7;
        long r0 = 2 * p - 128; if (!hasprev && r0 < 0) r0 = 0;
        const bf16_t* src = Vown + r0 * vs + 8 * c; vx[it] = *(const u32x4*)src; vy[it] = *(const u32x4*)(src + vs); }
#pragma unroll
    for (int k4 = 0; k4 < 4; ++k4) { if (QPRE) qf[k4] = qpre[k4]; else qf[k4] = *(const bf16x8*)(Qb + (long)iq * qs + 32 * k4 + 8 * fq); }
    __syncthreads();
#pragma unroll
    for (int it = 0; it < 8; ++it) { const int id = tid + NTHR * it; *(LAS u32x4*)(KS + (id >> 4) * KSS + 4 * (id & 15)) = kx[it]; }
#pragma unroll
    for (int it = 0; it < 4; ++it) { const int task = tid + NTHR * it; const int p = task & 127, c = task >> 7; const u32x4 x = vx[it], y = vy[it];
        LAS unsigned* d = VT + (8 * c) * VTS + p;
        d[0 * VTS] = (x.x & 0xffffu) | (y.x << 16); d[1 * VTS] = (x.x >> 16) | (y.x & 0xffff0000u);
        d[2 * VTS] = (x.y & 0xffffu) | (y.y << 16); d[3 * VTS] = (x.y >> 16) | (y.y & 0xffff0000u);
        d[4 * VTS] = (x.z & 0xffffu) | (y.z << 16); d[5 * VTS] = (x.z >> 16) | (y.z & 0xffff0000u);
        d[6 * VTS] = (x.w & 0xffffu) | (y.w << 16); d[7 * VTS] = (x.w >> 16) | (y.w & 0xffff0000u); }
    __syncthreads();
    constexpr int NT = MASKED ? 10 : 16; const int t0 = MASKED ? w : 0;
    f32x4 s[NT];
    float mx = -INFINITY;
#pragma unroll
    for (int i = 0; i < NT; ++i) { const int t = t0 + i, tc = t < 15 ? t : 15;
        const LAS unsigned* kp = KS + (16 * tc + fr) * KSS + 4 * fq;
        f32x4 acc = {0.f, 0.f, 0.f, 0.f};
#pragma unroll
        for (int k4 = 0; k4 < 4; ++k4) { const bf16x8 kf = __builtin_bit_cast(bf16x8, *(const LAS u32x4*)(kp + 16 * k4)); acc = __builtin_amdgcn_mfma_f32_16x16x32_bf16(kf, qf[k4], acc, 0, 0, 0); }
#pragma unroll
        for (int j = 0; j < 4; ++j) { const int kk = 16 * t + 4 * fq + j; bool ok = (t <= 15);
            if (MASKED) ok = ok && (kk >= iq) && (kk <= iq + 128);
            ok = ok && (hasprev || kk >= 128);
            const float v = ok ? acc[j] * ATT_SCALE : -INFINITY; acc[j] = v; mx = fmaxf(mx, v); }
        s[i] = acc; }
    mx = fmaxf(mx, __shfl_xor(mx, 16)); mx = fmaxf(mx, __shfl_xor(mx, 32));
    float l = 0.f;
#pragma unroll
    for (int i = 0; i < NT; ++i)
#pragma unroll
        for (int j = 0; j < 4; ++j) { const float p = __expf(s[i][j] - mx); s[i][j] = p; l += p; }
    l += __shfl_xor(l, 16); l += __shfl_xor(l, 32);
    f32x4 o[8];
#pragma unroll
    for (int mt = 0; mt < 8; ++mt) o[mt] = (f32x4){0.f, 0.f, 0.f, 0.f};
#pragma unroll
    for (int sp = 0; sp < NT / 2; ++sp) { const int ta = t0 + 2 * sp, tb = ta + 1; const int tca = ta < 15 ? ta : 15, tcb = tb < 15 ? tb : 15;
        u32x4 pw; pw.x = cvt_pk_bf16(s[2 * sp][0], s[2 * sp][1]); pw.y = cvt_pk_bf16(s[2 * sp][2], s[2 * sp][3]); pw.z = cvt_pk_bf16(s[2 * sp + 1][0], s[2 * sp + 1][1]); pw.w = cvt_pk_bf16(s[2 * sp + 1][2], s[2 * sp + 1][3]);
        const bf16x8 pf = __builtin_bit_cast(bf16x8, pw);
#pragma unroll
        for (int mt = 0; mt < 8; ++mt) { const LAS unsigned* vr = VT + (16 * mt + fr) * VTS + 2 * fq;
            const u32x2 lo = *(const LAS u32x2*)(vr + 8 * tca), hi = *(const LAS u32x2*)(vr + 8 * tcb);
            u32x4 vw; vw.x = lo.x; vw.y = lo.y; vw.z = hi.x; vw.w = hi.y;
            o[mt] = __builtin_amdgcn_mfma_f32_16x16x32_bf16(__builtin_bit_cast(bf16x8, vw), pf, o[mt], 0, 0, 0); } }
    const float il = 1.f / l;
    bf16_t* op = Ob + (long)iq * os + 4 * fq;
#pragma unroll
    for (int mt = 0; mt < 8; ++mt) { u32x2 wv; wv.x = cvt_pk_bf16(o[mt][0] * il, o[mt][1] * il); wv.y = cvt_pk_bf16(o[mt][2] * il, o[mt][3] * il); *(u32x2*)(op + 16 * mt) = wv; }
    if (lsep && fq == 0) lsep[(long)iq * lses] = mx + __logf(l);
}

constexpr int QB_STRIDE = 144, QB_BYTES = 128 * QB_STRIDE, QT_OFF = 2 * QB_BYTES, QT_STRIDE = 272;
__device__ __forceinline__ void cross_q_tile(LAS unsigned char* lds, const bf16_t* XBp, const bf16_t* WQT, const float* ssq, int tid, bf16x8 (&qf)[4]) {
    const int lane = tid & 63, w = tid >> 6, fr = lane & 15, fq = lane >> 4;
    const bf16_t* ap = XBp + (size_t)(16 * w + fr) * 2048 + 8 * fq;
    const int br = tid >> 3, bc = tid & 7;
    const bf16_t* bp = WQT + (size_t)br * 2048 + 8 * bc;
    f32x4 acc[8];
#pragma unroll
    for (int nt = 0; nt < 8; ++nt) acc[nt] = (f32x4){0.f, 0.f, 0.f, 0.f};
    u32x4 b0[4], b1[4]; bf16x8 a0[4], a1[4];
#pragma unroll
    for (int i = 0; i < 4; ++i) { b0[i] = *(const u32x4*)(bp + 64 * i); b1[i] = *(const u32x4*)(bp + (size_t)64 * 2048 + 64 * i); a0[i] = *(const bf16x8*)(ap + 64 * i); a1[i] = *(const bf16x8*)(ap + 64 * i + 32); }
    __syncthreads();
    for (int kq = 0; kq < 8; ++kq) {
#pragma unroll
        for (int i = 0; i < 4; ++i) { const int kc = 4 * kq + i;
            LAS unsigned char* buf = lds + (i & 1) * QB_BYTES;
            *(LAS u32x4*)(buf + br * QB_STRIDE + 16 * bc) = b0[i]; *(LAS u32x4*)(buf + (br + 64) * QB_STRIDE + 16 * bc) = b1[i];
            const bf16x8 c0 = a0[i], c1 = a1[i];
            if (kq < 7) { b0[i] = *(const u32x4*)(bp + 64 * (kc + 4)); b1[i] = *(const u32x4*)(bp + (size_t)64 * 2048 + 64 * (kc + 4)); a0[i] = *(const bf16x8*)(ap + 64 * (kc + 4)); a1[i] = *(const bf16x8*)(ap + 64 * (kc + 4) + 32); }
            __syncthreads();
#pragma unroll
            for (int nt = 0; nt < 8; ++nt) { const LAS unsigned char* rp = buf + (16 * nt + fr) * QB_STRIDE + 16 * fq;
                const bf16x8 f0 = __builtin_bit_cast(bf16x8, *(const LAS u32x4*)rp), f1 = __builtin_bit_cast(bf16x8, *(const LAS u32x4*)(rp + 64));
                acc[nt] = __builtin_amdgcn_mfma_f32_16x16x32_bf16(c0, f0, acc[nt], 0, 0, 0); acc[nt] = __builtin_amdgcn_mfma_f32_16x16x32_bf16(c1, f1, acc[nt], 0, 0, 0); } }
    }
    float rs[4];
#pragma unroll
    for (int j = 0; j < 4; ++j) rs[j] = rsqrtf(ssq[16 * w + 4 * fq + j] * (1.f / 2048.f) + EPS);
    LAS unsigned char* qt = lds + QT_OFF;
#pragma unroll
    for (int nt = 0; nt < 8; ++nt)
#pragma unroll
        for (int j = 0; j < 4; ++j) *(LAS bf16_t*)(qt + (16 * w + 4 * fq + j) * QT_STRIDE + 2 * (16 * nt + fr)) = (bf16_t)(cvt_pk_bf16(acc[nt][j] * rs[j], 0.f) & 0xffffu);
    __syncthreads();
#pragma unroll
    for (int k4 = 0; k4 < 4; ++k4) qf[k4] = __builtin_bit_cast(bf16x8, *(const LAS u32x4*)(qt + (16 * w + fr) * QT_STRIDE + 2 * (32 * k4 + 8 * fq)));
}

__device__ __forceinline__ void hg_gates(const unsigned (&fw)[8], float lb0, float lb1, LAS float* psum, int tid, float (&f)[2][8], float (&b)[2][8], float (&tot)[2]) {
    const int k0 = 2 * (tid & 63), part = tid >> 6;
    float r0 = 0.f, r1 = 0.f;
#pragma unroll
    for (int cc = 0; cc < 8; ++cc) { const float f0 = lb0 + (1.f - lb0) * sigm(bflo(fw[cc])), f1 = lb1 + (1.f - lb1) * sigm(bfhi(fw[cc]));
        f[0][cc] = f0; f[1][cc] = f1; r0 += __logf(f0); r1 += __logf(f1); b[0][cc] = r0; b[1][cc] = r1; }
    psum[part * 128 + k0] = r0; psum[part * 128 + k0 + 1] = r1;
    __syncthreads();
    float off0 = 0.f, off1 = 0.f, t0 = 0.f, t1 = 0.f;
#pragma unroll
    for (int p = 0; p < 8; ++p) { const float a0 = psum[p * 128 + k0], a1 = psum[p * 128 + k0 + 1]; if (p < part) { off0 += a0; off1 += a1; } t0 += a0; t1 += a1; }
#pragma unroll
    for (int cc = 0; cc < 8; ++cc) { b[0][cc] += off0; b[1][cc] += off1; }
    tot[0] = t0; tot[1] = t1;
}
constexpr int HS = 36;
__device__ __forceinline__ void hg_write_vt(const u32x4 x, const u32x4 y, LAS unsigned* VTh, int tid) {
    const int p = tid & 31, ch = tid >> 5;
    LAS unsigned* d = VTh + (8 * ch) * HS + p;
    d[0 * HS] = (x.x & 0xffffu) | (y.x << 16); d[1 * HS] = (x.x >> 16) | (y.x & 0xffff0000u);
    d[2 * HS] = (x.y & 0xffffu) | (y.y << 16); d[3 * HS] = (x.y >> 16) | (y.y & 0xffff0000u);
    d[4 * HS] = (x.z & 0xffffu) | (y.z << 16); d[5 * HS] = (x.z >> 16) | (y.z & 0xffff0000u);
    d[6 * HS] = (x.w & 0xffffu) | (y.w << 16); d[7 * HS] = (x.w >> 16) | (y.w & 0xffff0000u);
}
struct HgIn { unsigned fw[8]; u32x4 x, y; float lb0, lb1; };
__device__ __forceinline__ void hg_load(HgIn& I, const bf16_t* hg, const float* lbp, int hu, int tid) {
    const int bh = hu >> 5, n = hu & 31, b_ = bh >> 3, h = bh & 7, row0 = b_ * 2048 + n * 64; const int k0 = 2 * (tid & 63), part = tid >> 6;
#pragma unroll
    for (int cc = 0; cc < 8; ++cc) I.fw[cc] = *(const unsigned*)(hg + (size_t)(row0 + part * 8 + cc) * 4096 + 1024 + h * 128 + k0);
    const bf16_t* src = hg + (size_t)(row0 + 2 * (tid & 31)) * 4096 + 2048 + h * 128 + 8 * (tid >> 5);
    I.x = *(const u32x4*)src; I.y = *(const u32x4*)(src + 4096);
    I.lb0 = lbp[h * 128 + k0]; I.lb1 = lbp[h * 128 + k0 + 1];
}
__device__ __forceinline__ void hg_kv_phase(LAS unsigned char* lds, const bf16_t* hg, const float* lbp, bf16_t* ST, float* DEC, int tid, int bid, int G) {
    const int lane = tid & 63, w = tid >> 6, fr = lane & 15, fq = lane >> 4;
    LAS unsigned* VTh = (LAS unsigned*)lds;
    LAS unsigned* KDT = (LAS unsigned*)(lds + 18432);
    LAS float* psum = (LAS float*)(lds + 36864);
    const int k0 = 2 * (tid & 63), part = tid >> 6;
    HgIn I; if (bid < 1024) hg_load(I, hg, lbp, bid, tid);
    for (int hu = bid; hu < 1024; hu += G) {
        __syncthreads();
        hg_write_vt(I.x, I.y, VTh, tid);
        float f[2][8], b[2][8], tot[2];
        hg_gates(I.fw, I.lb0, I.lb1, psum, tid, f, b, tot);
        if (hu + G < 1024) hg_load(I, hg, lbp, hu + G, tid);
#pragma unroll
        for (int q = 0; q < 2; ++q) { float kd[8];
#pragma unroll
            for (int cc = 0; cc < 8; ++cc) kd[cc] = (1.f - f[q][cc]) * __expf(tot[q] - b[q][cc]);
            u32x4 wv; wv.x = cvt_pk_bf16(kd[0], kd[1]); wv.y = cvt_pk_bf16(kd[2], kd[3]); wv.z = cvt_pk_bf16(kd[4], kd[5]); wv.w = cvt_pk_bf16(kd[6], kd[7]);
            *(LAS u32x4*)(KDT + (k0 + q) * HS + 4 * part) = wv; }
        if (part == 0) { DEC[(size_t)hu * 128 + k0] = __expf(tot[0]); DEC[(size_t)hu * 128 + k0 + 1] = __expf(tot[1]); }
        __syncthreads();
        bf16x8 af[2];
#pragma unroll
        for (int k2 = 0; k2 < 2; ++k2) af[k2] = __builtin_bit_cast(bf16x8, *(const LAS u32x4*)(VTh + (16 * w + fr) * HS + 16 * k2 + 4 * fq));
        bf16_t* stp = ST + (size_t)hu * 16384 + (size_t)(16 * w + 4 * fq) * 128 + fr;
#pragma unroll
        for (int nt = 0; nt < 8; ++nt) { f32x4 acc = {0.f, 0.f, 0.f, 0.f};
#pragma unroll
            for (int k2 = 0; k2 < 2; ++k2) { const bf16x8 bf = __builtin_bit_cast(bf16x8, *(const LAS u32x4*)(KDT + (16 * nt + fr) * HS + 16 * k2 + 4 * fq)); acc = __builtin_amdgcn_mfma_f32_16x16x32_bf16(af[k2], bf, acc, 0, 0, 0); }
#pragma unroll
            for (int j = 0; j < 4; ++j) { const float nb = __shfl_down(acc[j], 1); if (!(fr & 1)) *(unsigned*)(stp + j * 128 + 16 * nt) = cvt_pk_bf16(acc[j], nb); } }
    }
}
constexpr int QS = 68;
__device__ __forceinline__ void hg_out_phase(LAS unsigned char* lds, const bf16_t* hg, const float* lbp, const float* hg_norm_w, const bf16_t* STB, bf16_t* OHG, int tid, int bid, int G) {
    const int lane = tid & 63, w = tid >> 6, fr = lane & 15, fq = lane >> 4;
    LAS unsigned* VTh = (LAS unsigned*)lds;
    LAS unsigned* QD = (LAS unsigned*)(lds + 18432);
    LAS unsigned* QM = (LAS unsigned*)(lds + 18432 + 17408);
    LAS unsigned* KM = (LAS unsigned*)(lds + 18432 + 2 * 17408);
    LAS float* psum = (LAS float*)(lds + 18432 + 3 * 17408);
    LAS float* bref = psum + 1024;
    LAS float* ssq = bref + 128;
    const int k0 = 2 * (tid & 63), part = tid >> 6, ct = w & 3, vh = w >> 2, c = 16 * ct + fr;
    HgIn I; unsigned qw[8];
    if (bid < 1024) { hg_load(I, hg, lbp, bid, tid); const int bh = bid >> 5, row0 = (bh >> 3) * 2048 + (bid & 31) * 64;
#pragma unroll
        for (int cc = 0; cc < 8; ++cc) qw[cc] = *(const unsigned*)(hg + (size_t)(row0 + part * 8 + cc) * 4096 + (bh & 7) * 128 + k0); }
    for (int hu = bid; hu < 1024; hu += G) {
        const int bh = hu >> 5, n = hu & 31, b_ = bh >> 3, h = bh & 7, row0 = b_ * 2048 + n * 64;
        u32x4 sa[4][4]; u32x2 gw[4]; f32x4 nw[4];
#pragma unroll
        for (int mi = 0; mi < 4; ++mi) { const bf16_t* sp = STB + (size_t)hu * 16384 + (size_t)(16 * (vh * 4 + mi) + fr) * 128 + 8 * fq;
#pragma unroll
            for (int k4 = 0; k4 < 4; ++k4) sa[mi][k4] = *(const u32x4*)(sp + 32 * k4);
            const int v0 = 16 * (vh * 4 + mi) + 4 * fq; gw[mi] = *(const u32x2*)(hg + (size_t)(row0 + c) * 4096 + 3072 + h * 128 + v0); nw[mi] = *(const f32x4*)(hg_norm_w + v0); }
        __syncthreads();
        hg_write_vt(I.x, I.y, VTh, tid);
        float f[2][8], b[2][8], tot[2];
        hg_gates(I.fw, I.lb0, I.lb1, psum, tid, f, b, tot);
        if (part == 4) { bref[k0] = b[0][0]; bref[k0 + 1] = b[1][0]; }
        __syncthreads();
        const float br0 = bref[k0], br1 = bref[k0 + 1];
#pragma unroll
        for (int cc = 0; cc < 8; ++cc) { const int c_ = part * 8 + cc; const float q0 = bflo(qw[cc]), q1 = bfhi(qw[cc]);
            const float e0 = __expf(b[0][cc] - br0), e1 = __expf(b[1][cc] - br1);
            QD[c_ * QS + (k0 >> 1)] = cvt_pk_bf16(q0 * __expf(b[0][cc]), q1 * __expf(b[1][cc]));
            QM[c_ * QS + (k0 >> 1)] = cvt_pk_bf16(q0 * e0, q1 * e1);
            KM[c_ * QS + (k0 >> 1)] = cvt_pk_bf16((1.f - f[0][cc]) * __builtin_amdgcn_rcpf(e0), (1.f - f[1][cc]) * __builtin_amdgcn_rcpf(e1)); }
        if (hu + G < 1024) { const int hn = hu + G; hg_load(I, hg, lbp, hn, tid); const int bhn = hn >> 5, row0n = (bhn >> 3) * 2048 + (hn & 31) * 64;
#pragma unroll
            for (int cc = 0; cc < 8; ++cc) qw[cc] = *(const unsigned*)(hg + (size_t)(row0n + part * 8 + cc) * 4096 + (bhn & 7) * 128 + k0); }
        __syncthreads();
        bf16x8 qmf[4];
#pragma unroll
        for (int k4 = 0; k4 < 4; ++k4) qmf[k4] = __builtin_bit_cast(bf16x8, *(const LAS u32x4*)(QM + (16 * ct + fr) * QS + 16 * k4 + 4 * fq));
        unsigned ap[4][2];
#pragma unroll
        for (int st = 0; st < 4; ++st) { f32x4 acc = {0.f, 0.f, 0.f, 0.f};
#pragma unroll
            for (int k4 = 0; k4 < 4; ++k4) { const bf16x8 kf = __builtin_bit_cast(bf16x8, *(const LAS u32x4*)(KM + (16 * st + fr) * QS + 16 * k4 + 4 * fq)); acc = __builtin_amdgcn_mfma_f32_16x16x32_bf16(kf, qmf[k4], acc, 0, 0, 0); }
#pragma unroll
            for (int j = 0; j < 4; ++j) { const int s_ = 16 * st + 4 * fq + j; if (s_ > c) acc[j] = 0.f; }
            ap[st][0] = cvt_pk_bf16(acc[0], acc[1]); ap[st][1] = cvt_pk_bf16(acc[2], acc[3]); }
        bf16x8 qdf[4];
#pragma unroll
        for (int k4 = 0; k4 < 4; ++k4) qdf[k4] = __builtin_bit_cast(bf16x8, *(const LAS u32x4*)(QD + (16 * ct + fr) * QS + 16 * k4 + 4 * fq));
        f32x4 o[4]; float ss = 0.f;
#pragma unroll
        for (int mi = 0; mi < 4; ++mi) { const int mt = vh * 4 + mi; f32x4 acc = {0.f, 0.f, 0.f, 0.f};
#pragma unroll
            for (int k4 = 0; k4 < 4; ++k4) acc = __builtin_amdgcn_mfma_f32_16x16x32_bf16(__builtin_bit_cast(bf16x8, sa[mi][k4]), qdf[k4], acc, 0, 0, 0);
#pragma unroll
            for (int s2 = 0; s2 < 2; ++s2) { const LAS unsigned* vr = VTh + (16 * mt + fr) * HS + 16 * s2 + 2 * fq;
                const u32x2 lo = *(const LAS u32x2*)vr, hi = *(const LAS u32x2*)(vr + 8);
                u32x4 vw; vw.x = lo.x; vw.y = lo.y; vw.z = hi.x; vw.w = hi.y;
                u32x4 pw; pw.x = ap[2 * s2][0]; pw.y = ap[2 * s2][1]; pw.z = ap[2 * s2 + 1][0]; pw.w = ap[2 * s2 + 1][1];
                acc = __builtin_amdgcn_mfma_f32_16x16x32_bf16(__builtin_bit_cast(bf16x8, vw), __builtin_bit_cast(bf16x8, pw), acc, 0, 0, 0); }
            o[mi] = acc; ss += (acc[0] * acc[0] + acc[1] * acc[1]) + (acc[2] * acc[2] + acc[3] * acc[3]); }
        ss += __shfl_xor(ss, 16); ss += __shfl_xor(ss, 32);
        if (fq == 0) ssq[vh * 64 + c] = ss;
        __syncthreads();
        const float rstd = rsqrtf((ssq[c] + ssq[64 + c]) * (1.f / 128.f) + EPS);
#pragma unroll
        for (int mi = 0; mi < 4; ++mi) { const int v0 = 16 * (vh * 4 + mi) + 4 * fq;
            u32x2 ov; ov.x = cvt_pk_bf16(o[mi][0] * rstd * nw[mi][0] * bflo(gw[mi].x), o[mi][1] * rstd * nw[mi][1] * bfhi(gw[mi].x)); ov.y = cvt_pk_bf16(o[mi][2] * rstd * nw[mi][2] * bflo(gw[mi].y), o[mi][3] * rstd * nw[mi][3] * bfhi(gw[mi].y));
            *(u32x2*)(OHG + (size_t)(row0 + c) * 1536 + 512 + h * 128 + v0) = ov; }
    }
}

#define XB_TMO      128
#define XB_XCNT(j)  (256  + 64 * (j))
#define XB_XSUB(j)  (1280 + 64 * (j))
#define XB_XGEN(j)  (2304 + 64 * (j))
#define XB_TOP      3328
#define XB_TOPGEN   3392
#define XCD_BAR_WORDS 3456
#define XB_SPIN_CAP (1u << 18)

__device__ __forceinline__ unsigned xb_ld(unsigned* p)              { return __hip_atomic_load(p, __ATOMIC_RELAXED, __HIP_MEMORY_SCOPE_AGENT); }
__device__ __forceinline__ unsigned xb_add(unsigned* p, unsigned v) { return __hip_atomic_fetch_add(p, v, __ATOMIC_RELAXED, __HIP_MEMORY_SCOPE_AGENT); }
__device__ __forceinline__ unsigned xb_xcc_id() { return (unsigned)__builtin_amdgcn_s_getreg((3 << 11) | 20) & 0xFu; }
#define XB_SPIN(cond, bar) do { unsigned _sp = 0; while (cond) { __builtin_amdgcn_s_sleep(1); \
    if ((++_sp & 255u) == 0u) { if (xb_ld(&(bar)[XB_TMO])) break; if (_sp > XB_SPIN_CAP) { atomicAdd(&(bar)[XB_TMO], 1u); break; } } } } while (0)

struct XcdBarrier {
    unsigned* bar; unsigned x;
    volatile LAS unsigned* st;
};

__device__ __forceinline__ XcdBarrier xcd_barrier_post(unsigned* bar, volatile LAS unsigned* st) {
    XcdBarrier b; b.bar = bar; b.x = xb_xcc_id(); b.st = st;
    if (threadIdx.x == 0) (void)xb_add(&bar[XB_XCNT(b.x)], 1u);
    return b;
}
__device__ __forceinline__ void xcd_barrier_complete(unsigned* bar, unsigned x, unsigned& nloc, unsigned& nx) {
    const unsigned G = gridDim.x * gridDim.y * gridDim.z;
    unsigned sum, cnt, mine, sp = 0u;
    for (;;) {
        sum = 0u; cnt = 0u; mine = 0u;
#pragma unroll
        for (unsigned j = 0; j < 16; ++j) { const unsigned c = xb_ld(&bar[XB_XCNT(j)]); sum += c; cnt += (c > 0u) ? 1u : 0u; mine = (j == x) ? c : mine; }
        if (sum == G) break;
        __builtin_amdgcn_s_sleep(1);
        if ((++sp & 255u) == 0u) { if (xb_ld(&bar[XB_TMO])) break; if (sp > XB_SPIN_CAP) { atomicAdd(&bar[XB_TMO], 1u); break; } }
    }
    nloc = mine > 0u ? mine : 1u; nx = cnt > 0u ? cnt : 1u;
}

__device__ __forceinline__ void xcd_barrier(const XcdBarrier& b) {
    asm volatile("s_waitcnt vmcnt(0)" ::: "memory");
    __syncthreads();
    if (threadIdx.x == 0) {
        unsigned* bar = b.bar;
        __builtin_amdgcn_s_waitcnt(0);
        unsigned nloc = b.st[0], nx = b.st[1];
        if (nloc == 0u) { xcd_barrier_complete(bar, b.x, nloc, nx); b.st[0] = nloc; b.st[1] = nx; }
        const unsigned old = xb_add(&bar[XB_XSUB(b.x)], 1u);
        const unsigned gen = old / nloc;
        if (old + 1u == (gen + 1u) * nloc) {
            __builtin_amdgcn_fence(__ATOMIC_RELEASE, "agent");
            asm volatile("s_waitcnt vmcnt(0)" ::: "memory");
            const unsigned og = xb_add(&bar[XB_TOP], 1u);
            const unsigned tg = og / nx;
            if (og + 1u == (tg + 1u) * nx) xb_add(&bar[XB_TOPGEN], 1u);
            else XB_SPIN(xb_ld(&bar[XB_TOPGEN]) == tg, bar);
            __builtin_amdgcn_fence(__ATOMIC_ACQUIRE, "agent");
            xb_add(&bar[XB_XGEN(b.x)], 1u);
            asm volatile("s_waitcnt vmcnt(0)" ::: "memory");
        } else {
            XB_SPIN(xb_ld(&bar[XB_XGEN(b.x)]) == gen, bar);
            __builtin_amdgcn_fence(__ATOMIC_ACQUIRE, "agent");
            asm volatile("s_waitcnt vmcnt(0)" ::: "memory");
        }
    }
    __syncthreads();
}

constexpr int NPHASE = 12;
#ifndef REP_PHASE
#define REP_PHASE -1
#endif
#define REPLOOP(k) _Pragma("nounroll") for (int rep_ = 0; rep_ < ((k) == REP_PHASE ? 2 : 1); ++rep_)
__global__ void __launch_bounds__(NTHR, 2) fwd_kernel(Args a) {
    extern __shared__ __attribute__((aligned(16))) unsigned char lds_raw[];
    LAS unsigned char* lds = (LAS unsigned char*)lds_raw;
    cg::grid_group grid = cg::this_grid();
    const int tid = threadIdx.x, G = gridDim.x, bid = blockIdx.x;
    unsigned char* ws = a.ws;
    const int lo = a.ph_lo, hi = a.ph_hi;
#define IN(k) (lo <= (k) && (k) < hi)
#define SEAM(k) do { if (IN(k) && IN((k) + 1)) { if (lo < 0) grid.sync(); else xcd_barrier(bar); } } while (0)
    if (tid < 2) ((volatile LAS unsigned*)(lds + LDS_MISC))[tid] = 0u;
    __syncthreads();
    XcdBarrier bar = xcd_barrier_post((unsigned*)(ws + WS_BAR), (volatile LAS unsigned*)(lds + LDS_MISC));
    float* sumsq = (float*)(ws + WS_SUMSQ);
    bf16_t* QKV = (bf16_t*)(ws + WS_QKV); bf16_t* HGB = (bf16_t*)(ws + WS_HG); bf16_t* GATES = (bf16_t*)(ws + WS_GATES); bf16_t* KVC = (bf16_t*)(ws + WS_KVC);
    bf16_t* OG = (bf16_t*)((unsigned char*)a.out + 32 * MiB);       float* LSE = (float*)(ws + WS_LSE); bf16_t* OCAT = (bf16_t*)(ws + WS_OCAT);
    bf16_t* ST = (bf16_t*)a.out; bf16_t* STB = (bf16_t*)(ws + WS_STB); float* DEC = (float*)(ws + WS_DEC); const float* LB = (const float*)(ws + WS_LB);
    float* PART = a.out; unsigned* FLAGS = (unsigned*)(ws + WS_FLAGS); bf16_t* MERGED = (bf16_t*)a.out; bf16_t* XB = (bf16_t*)(ws + WS_XB);
    bf16_t* QC = (bf16_t*)(ws + WS_QC); bf16_t* OC = (bf16_t*)(ws + WS_OC); bf16_t* GB = (bf16_t*)(ws + WS_G);

    if (IN(0)) REPLOOP(0) { phase_prologue(a, lds, tid); __syncthreads(); }
    SEAM(0);
    if (IN(1)) REPLOOP(1) {
        pg8::SplitOrder S; S.init((const bf16_t*)(ws + WS_HN), (const bf16_t*)(ws + WS_WIN), MTOK, 12288, 2048, 0, G, bid);
        pg8::EpiProj E{QKV, HGB, GATES, KVC};
        pg8::gemm_phase2<pg8::EpiProj, pg8::SplitOrder>(lds, S, E, PART, FLAGS, 2u * 2048u);
    }
    SEAM(1);
    const int NGEM = G >= 160 ? 80 : 0;
    if (IN(2)) REPLOOP(2) {
      { const int bid_ = bid, G_ = G;
        for (int u = bid_; u < 768; u += G_) {
            const int g_ = u >> 8, rem = u & 255; const int dsh = 2 * g_, d = 1 << dsh, nblk = 16 >> dsh;
            const int n = rem & (nblk - 1), r = (rem >> (4 - dsh)) & (d - 1), bhh = rem >> 4, b_ = bhh >> 2, hg_ = bhh & 3;
            const long row0 = (long)b_ * 2048 + (long)(n * 128) * d + r;
            const bf16_t* qb = QKV + row0 * 4608 + (g_ * 4 + hg_) * 128;
            attn_unit<true>(lds, qb, (long)d * 4608, qb + 1536, (long)d * 4608, qb + 3072, (long)d * 4608, n > 0,
                            OG + (size_t)g_ * (8192 * 512) + row0 * 512 + hg_ * 128, (long)d * 512, LSE + (size_t)g_ * (8192 * 4) + row0 * 4 + hg_, (long)d * 4, tid);
        }
        hg_kv_phase(lds, HGB, LB, ST, DEC, tid, bid_, G_);
      }
    }
    SEAM(2);
    if (IN(3)) {
        const int gt = bid * NTHR + tid, NGT = G * NTHR;
        for (int task = gt; task < 8192 * 64; task += NGT) { const int tok = task >> 6, hg_ = (task >> 4) & 3, c = task & 15;
            const float l0 = LSE[(size_t)tok * 4 + hg_], l1 = LSE[(size_t)(8192 + tok) * 4 + hg_], l2 = LSE[(size_t)(16384 + tok) * 4 + hg_];
            const float mx = fmaxf(l0, fmaxf(l1, l2)); float e0 = __expf(l0 - mx), e1 = __expf(l1 - mx), e2 = __expf(l2 - mx); const float inv = 1.f / (e0 + e1 + e2); e0 *= inv; e1 *= inv; e2 *= inv;
            const size_t off = (size_t)tok * 512 + hg_ * 128 + 8 * c;
            const u32x4 x0 = *(const u32x4*)(OG + off), x1 = *(const u32x4*)(OG + (size_t)8192 * 512 + off), x2 = *(const u32x4*)(OG + (size_t)2 * 8192 * 512 + off);
            u32x4 o;
            o.x = cvt_pk_bf16(e0 * bflo(x0.x) + e1 * bflo(x1.x) + e2 * bflo(x2.x), e0 * bfhi(x0.x) + e1 * bfhi(x1.x) + e2 * bfhi(x2.x));
            o.y = cvt_pk_bf16(e0 * bflo(x0.y) + e1 * bflo(x1.y) + e2 * bflo(x2.y), e0 * bfhi(x0.y) + e1 * bfhi(x1.y) + e2 * bfhi(x2.y));
            o.z = cvt_pk_bf16(e0 * bflo(x0.z) + e1 * bflo(x1.z) + e2 * bflo(x2.z), e0 * bfhi(x0.z) + e1 * bfhi(x1.z) + e2 * bfhi(x2.z));
            o.w = cvt_pk_bf16(e0 * bflo(x0.w) + e1 * bflo(x1.w) + e2 * bflo(x2.w), e0 * bfhi(x0.w) + e1 * bfhi(x1.w) + e2 * bfhi(x2.w));
            *(u32x4*)(OCAT + (size_t)tok * 1536 + hg_ * 128 + 8 * c) = o; }
        for (int task = gt; task < 32 * 4096; task += NGT) { const int bh = task >> 12, e4 = task & 4095;
            f32x4 S_ = {0.f, 0.f, 0.f, 0.f};
            const bf16_t* sp = ST + (size_t)bh * 32 * 16384 + 4 * e4; const float* dp = DEC + (size_t)bh * 32 * 128 + ((4 * e4) & 127); bf16_t* op = STB + (size_t)bh * 32 * 16384 + 4 * e4;
#pragma unroll 8
            for (int n = 0; n < 32; ++n) { const u32x2 kw = *(const u32x2*)(sp + (size_t)n * 16384); const f32x4 kv = {bflo(kw.x), bfhi(kw.x), bflo(kw.y), bfhi(kw.y)}; const f32x4 dc = *(const f32x4*)(dp + n * 128);
                u32x2 wv; wv.x = cvt_pk_bf16(S_[0], S_[1]); wv.y = cvt_pk_bf16(S_[2], S_[3]); *(u32x2*)(op + (size_t)n * 16384) = wv; S_ = dc * S_ + kv; } }
    }
    SEAM(3);
    if (IN(4)) REPLOOP(4) {
      if (bid < NGEM || NGEM == 0) {
        pg8::DeferOrder S{(const bf16_t*)(ws + WS_HN), (const bf16_t*)(ws + WS_WIN), 2048, bid, 80, NGEM ? NGEM : G}; pg8::EpiProj E{QKV, HGB, GATES, KVC};
        pg8::gemm_phase2<pg8::EpiProj, pg8::DeferOrder>(lds, S, E, PART, FLAGS, 2u * 2048u); __syncthreads();
      }
      if (bid >= NGEM) hg_out_phase(lds, HGB, LB, a.in[4], STB, OCAT, tid, bid - NGEM, G - NGEM);
    }
    SEAM(4);
    if (IN(5)) REPLOOP(5) {
        pg8::ChainOrder S{OCAT, (const bf16_t*)(ws + WS_WA), 1536, 8, MTOK / 256, 2048 / 256, G, bid};
        pg8::EpiMerge E{GATES, MERGED};
        pg8::gemm_phase2<pg8::EpiMerge, pg8::ChainOrder>(lds, S, E, nullptr, nullptr, 2u * 1536u);
    }
    SEAM(5);
    if (IN(6)) { pg8::SplitOrder S; S.init(MERGED, (const bf16_t*)(ws + WS_WOUT), MTOK, 2048, 2048, 0, G, bid); pg8::EpiRes<false> E{a.in[0], XB, sumsq};
        pg8::gemm_phase2<pg8::EpiRes<false>, pg8::SplitOrder>(lds, S, E, PART, FLAGS, 2u * 2048u); }
    SEAM(6);
    if (IN(8)) REPLOOP(8) {
        for (int u = bid; u < 256; u += G) { const int b_ = u >> 6, h = (u >> 4) & 3, qb = u & 15; const size_t r0 = (size_t)(b_ * 2048 + qb * 128);
            const bf16_t* kb = KVC + (size_t)(b_ * 256 + 128) * 1024 + h * 128;
            bf16x8 qf[4]; cross_q_tile(lds, XB + r0 * 2048, (const bf16_t*)(ws + WS_WQ) + (size_t)(h * 128) * 2048, sumsq + r0, tid, qf);
            attn_unit<false, true>(lds, nullptr, 512, kb, 1024, kb + 512, 1024, true, OC + r0 * 512 + h * 128, 512, nullptr, 0, tid, qf); }
    }
    SEAM(8);
    if (IN(9)) { pg8::SplitOrder S; S.init(OC, (const bf16_t*)(ws + WS_WO), MTOK, 2048, 512, 0, G, bid); pg8::EpiRes<true> E{XB, XB, sumsq + 8192};
        pg8::gemm_phase2<pg8::EpiRes<true>, pg8::SplitOrder>(lds, S, E, PART, FLAGS, 2u * 512u); }
    SEAM(9);
    if (IN(10)) REPLOOP(10) { pg8::SplitOrder S; S.init(XB, (const bf16_t*)(ws + WS_W13), MTOK, 2 * DFF_, 2048, 0, G, bid); pg8::EpiSwiGLU E{sumsq + 8192, GB};
        pg8::gemm_phase2<pg8::EpiSwiGLU, pg8::SplitOrder>(lds, S, E, PART, FLAGS + 4096, 2u * 2048u); }
    SEAM(10);
    if (IN(11)) { pg8::SplitOrder S; S.init(GB, (const bf16_t*)(ws + WS_W2), MTOK, 2048, DFF_, 0, G, bid); pg8::EpiFinal E{XB, a.out, sumsq + 16384, a.in[18], FLAGS};
        pg8::gemm_phase2<pg8::EpiFinal, pg8::SplitOrder>(lds, S, E, PART, FLAGS, 2u * 5632u); }
#undef IN
#undef SEAM
}

#ifndef N_LAUNCH_MODE
#define N_LAUNCH_MODE 1
#endif
extern "C" void kernel_launch(void* const* d_in, const int* in_sizes, int n_in, void* d_out, int out_size, void* d_ws, size_t ws_size, hipStream_t stream) {
    static int grid = 0;
    if (grid == 0) {
        if (n_in != 19 || out_size != MTOK * DMODEL || ws_size < WS_END) { fprintf(stderr, "kernel_launch: unexpected problem (n_in %d out %d ws %zu)\n", n_in, out_size, ws_size); grid = -1; return; }
        int dev = 0, cus = 0, per_cu = 0;
        hipGetDevice(&dev); hipDeviceGetAttribute(&cus, hipDeviceAttributeMultiprocessorCount, dev);
        if (hipFuncSetAttribute((const void*)fwd_kernel, hipFuncAttributeMaxDynamicSharedMemorySize, LDS_BYTES) != hipSuccess) { fprintf(stderr, "kernel_launch: hipFuncSetAttribute failed\n"); grid = -1; return; }
        if (hipOccupancyMaxActiveBlocksPerMultiprocessor(&per_cu, (const void*)fwd_kernel, NTHR, LDS_BYTES) != hipSuccess || per_cu < 1) { fprintf(stderr, "kernel_launch: occupancy query gave %d\n", per_cu); per_cu = 1; }
        (void)hipGetLastError();
        grid = cus * 1;
        fprintf(stderr, "kernel_launch: grid %d (cus %d, per_cu %d)\n", grid, cus, per_cu);
    }
    if (grid < 0) return;
    if (hipMemsetAsync((char*)d_ws + WS_BAR, 0, BAR_BYTES, stream) != hipSuccess) { fprintf(stderr, "kernel_launch: memset failed\n"); return; }
    Args a{};
    for (int i = 0; i < 19; ++i) a.in[i] = (const float*)d_in[i];
    a.out = (float*)d_out; a.ws = (unsigned char*)d_ws;
#if N_LAUNCH_MODE == 1
    a.ph_lo = 0; a.ph_hi = NPHASE;
    void* args[] = {&a};
    hipError_t e = hipLaunchCooperativeKernel((const void*)fwd_kernel, dim3(grid), dim3(NTHR), args, LDS_BYTES, stream);
    if (e != hipSuccess) fprintf(stderr, "kernel_launch: cooperative launch failed: %s (grid %d)\n", hipGetErrorString(e), grid);
#else
    for (int p = 0; p < NPHASE; ++p) { a.ph_lo = p; a.ph_hi = p + 1; hipLaunchKernelGGL(fwd_kernel, dim3(grid), dim3(NTHR), LDS_BYTES, stream, a); }
#endif
}
```

```cpp
#include <hip/hip_runtime.h>
#include <hip/hip_cooperative_groups.h>
#include <cstdio>
#include <cstdint>
#include <cmath>
namespace cg = cooperative_groups;
namespace pg8 {
#define PG8_LAS __attribute__((address_space(3)))
typedef unsigned short bf16_t;
typedef short bf16x8 __attribute__((ext_vector_type(8)));
typedef float f32x4 __attribute__((ext_vector_type(4)));
typedef unsigned u32x4 __attribute__((ext_vector_type(4)));
constexpr int BM = 256, BK = 64, HALF = 128, HTB = HALF * BK * 2  , STAGE_BYTES = 8 * HTB, NXCD = 8, WGM = 8;

__host__ __device__ __forceinline__ int lds_byte(int r, int c) { const int st = (r >> 4) * 2 + (c >> 5), rr = r & 15, cc = c & 31, ob = rr * 64 + cc * 2; return st * 1024 + (ob ^ (((ob >> 9) & 1) << 5)); }
__host__ __device__ __forceinline__ void stage_rc(int b, int& R, int& C) { const int st = b / 1024, sb = b % 1024, swz = sb ^ (((sb >> 9) & 1) << 5); R = (st >> 1) * 16 + swz / 64; C = (st & 1) * 32 + (swz % 64) / 2; }
__host__ __device__ __forceinline__ int perm32(int rho) { const int n = rho >> 4, i = rho & 15; return 8 * (i >> 2) + 4 * n + (i & 3); }

struct Unit { int pm, pn; };
struct Gemm { const bf16_t* A; const bf16_t* Bt; int M, N, K; };

struct StaticOrder {
    int nM, nN, nwg, G, c;
    __host__ __device__ void init(int M, int N, int G_, int c_) { nM = M / BM; nN = N / BM; nwg = nM * nN; G = G_; c = c_; }
    __host__ __device__ bool next(int i, Unit& u) const {
        const long L = (long)i * G + c; if (L >= nwg) return false;
        int wgid = (int)L; { const int q = nwg / NXCD, r = nwg % NXCD, xcd = wgid % NXCD, off = wgid / NXCD; wgid = (xcd < r ? xcd * (q + 1) : r * (q + 1) + (xcd - r) * q) + off; }
        const int nig = WGM * nN, gid = wgid / nig, fm = gid * WGM, gsz = (nM - fm) < WGM ? (nM - fm) : WGM;
        u.pm = fm + ((wgid % nig) % gsz); u.pn = (wgid % nig) / gsz; return true;
    }
    __device__ __forceinline__ void a_ready(const Unit&) const {}
    __device__ __forceinline__ void done(const Unit&) const {}
};

__device__ __forceinline__ unsigned cvt_pk_bf16(float lo, float hi) { unsigned r; asm volatile("v_cvt_pk_bf16_f32 %0, %1, %2" : "=v"(r) : "v"(lo), "v"(hi)); return r; }
typedef float f32x2 __attribute__((ext_vector_type(2)));
typedef unsigned u32x2 __attribute__((ext_vector_type(2)));
__device__ __forceinline__ float sigm(float x) { return __builtin_amdgcn_rcpf(1.f + __expf(-x)); }
__device__ __forceinline__ float silu(float x) { return x * sigm(x); }
__device__ __forceinline__ float bflo(unsigned w) { return __uint_as_float(w << 16); }
__device__ __forceinline__ float bfhi(unsigned w) { return __uint_as_float(w & 0xffff0000u); }
constexpr float RMS_EPS_ = 1e-6f;

struct Order1 {
    StaticOrder so; int nmain;
    __host__ __device__ void init(int G_, int c_) { so.init(8192, 12800, G_, c_); nmain = so.nwg; }
    __host__ __device__ bool next(int i, Unit& u) const {
        const long L = (long)i * so.G + so.c;
        if (L < nmain) return so.next(i, u);
        const int e = (int)(L - nmain); if (e >= 16) return false;
        u.pm = 32 + (e >> 2); u.pn = 50 + (e & 3); return true;
    }
    __device__ __forceinline__ void a_ready(const Unit&) const {}
    __device__ __forceinline__ void done(const Unit&) const {}
};

struct EpiProj {
    static constexpr bool PERM = true, AFTER_DRAIN = false;
    bf16_t* qkv; bf16_t* hg; bf16_t* gates; bf16_t* kvc;
    __device__ __forceinline__ void operator()(const f32x4 (&acc)[2][2][4][2], const Unit& u, int wr, int wc, int fr, int fq) const {
        const int pn = u.pn; bf16_t* base; int ldc, colt, act, rowt = u.pm * BM;
        if (pn < 18) { base = qkv; ldc = 4608; colt = pn * 256; act = 0; }
        else if (pn < 34) { base = hg; ldc = 4096; colt = (pn - 18) * 256; const int s = (pn - 18) >> 2; act = (s == 0 || s == 3) ? 1 : 0; }
        else if (pn < 50) { base = gates; ldc = 4096; colt = (pn - 34) * 256; act = 2; }
        else { base = kvc; ldc = 1024; colt = (pn - 50) * 256; act = 0; rowt -= 8192; }
        const int row0 = rowt + wr * 64 + fr, col0 = colt + wc * 32 + 8 * fq;
#pragma unroll
        for (int ai = 0; ai < 2; ++ai)
#pragma unroll
            for (int m = 0; m < 4; ++m) { bf16_t* rowp = base + (size_t)(row0 + ai * HALF + m * 16) * ldc + col0;
#pragma unroll
                for (int bj = 0; bj < 2; ++bj) { f32x4 v0 = acc[ai][bj][m][0], v1 = acc[ai][bj][m][1];
                    if (act == 1) {
#pragma unroll
                        for (int e = 0; e < 4; ++e) { v0[e] = silu(v0[e]); v1[e] = silu(v1[e]); } }
                    else if (act == 2) {
#pragma unroll
                        for (int e = 0; e < 4; ++e) { v0[e] = sigm(v0[e]); v1[e] = sigm(v1[e]); } }
                    u32x4 w; w.x = cvt_pk_bf16(v0[0], v0[1]); w.y = cvt_pk_bf16(v0[2], v0[3]); w.z = cvt_pk_bf16(v1[0], v1[1]); w.w = cvt_pk_bf16(v1[2], v1[3]);
                    *(u32x4*)(rowp + bj * HALF) = w; } }
    }
};

struct EpiGateA {
    static constexpr bool PERM = true, AFTER_DRAIN = false;
    const bf16_t* gates; float* tmp;
    __device__ __forceinline__ void operator()(const f32x4 (&acc)[2][2][4][2], const Unit& u, int wr, int wc, int fr, int fq) const {
        const int row0 = u.pm * BM + wr * 64 + fr, col0 = u.pn * BM + wc * 32 + 8 * fq;
#pragma unroll
        for (int ai = 0; ai < 2; ++ai)
#pragma unroll
            for (int m = 0; m < 4; ++m) { const size_t r = (size_t)(row0 + ai * HALF + m * 16);
#pragma unroll
                for (int bj = 0; bj < 2; ++bj) { const int c = col0 + bj * HALF; const u32x4 g = *(const u32x4*)(gates + r * 4096 + c);
                    f32x4 o0 = acc[ai][bj][m][0], o1 = acc[ai][bj][m][1];
                    o0[0] *= bflo(g.x); o0[1] *= bfhi(g.x); o0[2] *= bflo(g.y); o0[3] *= bfhi(g.y); o1[0] *= bflo(g.z); o1[1] *= bfhi(g.z); o1[2] *= bflo(g.w); o1[3] *= bfhi(g.w);
                    *(f32x4*)(tmp + r * 2048 + c) = o0; *(f32x4*)(tmp + r * 2048 + c + 4) = o1; } }
    }
};
struct EpiGateB {
    static constexpr bool PERM = true, AFTER_DRAIN = false;
    const bf16_t* gates; const float* tmp; bf16_t* out;
    __device__ __forceinline__ void operator()(const f32x4 (&acc)[2][2][4][2], const Unit& u, int wr, int wc, int fr, int fq) const {
        const int row0 = u.pm * BM + wr * 64 + fr, col0 = u.pn * BM + wc * 32 + 8 * fq;
#pragma unroll
        for (int ai = 0; ai < 2; ++ai)
#pragma unroll
            for (int m = 0; m < 4; ++m) { const size_t r = (size_t)(row0 + ai * HALF + m * 16);
#pragma unroll
                for (int bj = 0; bj < 2; ++bj) { const int c = col0 + bj * HALF; const u32x4 g = *(const u32x4*)(gates + r * 4096 + c);
                    f32x4 o0 = *(const f32x4*)(tmp + r * 2048 + c), o1 = *(const f32x4*)(tmp + r * 2048 + c + 4); const f32x4 a0 = acc[ai][bj][m][0], a1 = acc[ai][bj][m][1];
                    o0[0] += a0[0] * bflo(g.x); o0[1] += a0[1] * bfhi(g.x); o0[2] += a0[2] * bflo(g.y); o0[3] += a0[3] * bfhi(g.y);
                    o1[0] += a1[0] * bflo(g.z); o1[1] += a1[1] * bfhi(g.z); o1[2] += a1[2] * bflo(g.w); o1[3] += a1[3] * bfhi(g.w);
                    u32x4 w; w.x = cvt_pk_bf16(o0[0], o0[1]); w.y = cvt_pk_bf16(o0[2], o0[3]); w.z = cvt_pk_bf16(o1[0], o1[1]); w.w = cvt_pk_bf16(o1[2], o1[3]);
                    *(u32x4*)(out + r * 2048 + c) = w; } }
    }
};
template <bool RES_BF16> struct EpiRes {
    static constexpr bool PERM = true, AFTER_DRAIN = false;
    const void* resid; bf16_t* outb; float* sumsq;
    __device__ __forceinline__ void operator()(const f32x4 (&acc)[2][2][4][2], const Unit& u, int wr, int wc, int fr, int fq) const {
        const int row0 = u.pm * BM + wr * 64 + fr, col0 = u.pn * BM + wc * 32 + 8 * fq;
#pragma unroll
        for (int ai = 0; ai < 2; ++ai)
#pragma unroll
            for (int m = 0; m < 4; ++m) { const size_t r = (size_t)(row0 + ai * HALF + m * 16); float ss = 0.f;
#pragma unroll
                for (int bj = 0; bj < 2; ++bj) { const int c = col0 + bj * HALF; f32x4 o0, o1;
                    if (RES_BF16) { const u32x4 g = *(const u32x4*)((const bf16_t*)resid + r * 2048 + c);
                        o0 = (f32x4){bflo(g.x), bfhi(g.x), bflo(g.y), bfhi(g.y)} + acc[ai][bj][m][0]; o1 = (f32x4){bflo(g.z), bfhi(g.z), bflo(g.w), bfhi(g.w)} + acc[ai][bj][m][1]; }
                    else { o0 = *(const f32x4*)((const float*)resid + r * 2048 + c) + acc[ai][bj][m][0]; o1 = *(const f32x4*)((const float*)resid + r * 2048 + c + 4) + acc[ai][bj][m][1]; }
                    ss += (o0[0] * o0[0] + o0[1] * o0[1]) + (o0[2] * o0[2] + o0[3] * o0[3]) + (o1[0] * o1[0] + o1[1] * o1[1]) + (o1[2] * o1[2] + o1[3] * o1[3]);
                    u32x4 w; w.x = cvt_pk_bf16(o0[0], o0[1]); w.y = cvt_pk_bf16(o0[2], o0[3]); w.z = cvt_pk_bf16(o1[0], o1[1]); w.w = cvt_pk_bf16(o1[2], o1[3]); *(u32x4*)(outb + r * 2048 + c) = w; }
                ss += __shfl_xor(ss, 16); ss += __shfl_xor(ss, 32);
                if (fq == 0) atomicAdd(sumsq + r, ss); }
    }
};
struct EpiQ {
    static constexpr bool PERM = true, AFTER_DRAIN = false;
    const float* sumsq; bf16_t* out; float scale;
    __device__ __forceinline__ void operator()(const f32x4 (&acc)[2][2][4][2], const Unit& u, int wr, int wc, int fr, int fq) const {
        const int row0 = u.pm * BM + wr * 64 + fr, col0 = u.pn * BM + wc * 32 + 8 * fq;
#pragma unroll
        for (int ai = 0; ai < 2; ++ai)
#pragma unroll
            for (int m = 0; m < 4; ++m) { const size_t r = (size_t)(row0 + ai * HALF + m * 16); const float rs = rsqrtf(sumsq[r] * (1.f / 2048.f) + RMS_EPS_) * scale;
#pragma unroll
                for (int bj = 0; bj < 2; ++bj) { const int c = col0 + bj * HALF; const f32x4 v0 = acc[ai][bj][m][0] * rs, v1 = acc[ai][bj][m][1] * rs;
                    u32x4 w; w.x = cvt_pk_bf16(v0[0], v0[1]); w.y = cvt_pk_bf16(v0[2], v0[3]); w.z = cvt_pk_bf16(v1[0], v1[1]); w.w = cvt_pk_bf16(v1[2], v1[3]);
                    *(u32x4*)(out + r * 512 + c) = w; } }
    }
};
struct EpiSwiGLU {
    static constexpr bool PERM = true, AFTER_DRAIN = false;
    const float* sumsq; bf16_t* out;
    __device__ __forceinline__ void operator()(const f32x4 (&acc)[2][2][4][2], const Unit& u, int wr, int wc, int fr, int fq) const {
        const int row0 = u.pm * BM + wr * 64 + fr, col0 = u.pn * HALF + wc * 32 + 8 * fq;
#pragma unroll
        for (int ai = 0; ai < 2; ++ai)
#pragma unroll
            for (int m = 0; m < 4; ++m) { const size_t r = (size_t)(row0 + ai * HALF + m * 16); const float rs = rsqrtf(sumsq[r] * (1.f / 2048.f) + RMS_EPS_);
                float g[8];
#pragma unroll
                for (int n = 0; n < 2; ++n)
#pragma unroll
                    for (int e = 0; e < 4; ++e) g[4 * n + e] = silu(acc[ai][0][m][n][e] * rs) * (acc[ai][1][m][n][e] * rs);
                u32x4 w; w.x = cvt_pk_bf16(g[0], g[1]); w.y = cvt_pk_bf16(g[2], g[3]); w.z = cvt_pk_bf16(g[4], g[5]); w.w = cvt_pk_bf16(g[6], g[7]);
                *(u32x4*)(out + r * 5632 + col0) = w; }
    }
};
struct Unit2 : Unit { const char* A; const char* B; int nt; int mode, slot, aux, pstr; };
__device__ __forceinline__ void part_store(const f32x4 (&acc)[2][2][4][2], float* part, unsigned* flags, const Unit2& u, int tid, int lane) {
    float* p = part + ((size_t)(u.slot * u.pstr + u.aux) * 32) * 2048 + (size_t)tid * 4;
#pragma unroll
    for (int ai = 0; ai < 2; ++ai)
#pragma unroll
        for (int bj = 0; bj < 2; ++bj)
#pragma unroll
            for (int m = 0; m < 4; ++m)
#pragma unroll
                for (int n = 0; n < 2; ++n) *(f32x4*)(p + (size_t)(((ai * 2 + bj) * 4 + m) * 2 + n) * 2048) = acc[ai][bj][m][n];
    __builtin_amdgcn_fence(__ATOMIC_RELEASE, "agent");
    asm volatile("s_waitcnt vmcnt(0)" ::: "memory");
    if (lane == 0) __hip_atomic_fetch_add(flags + 16 * u.slot, 1u, __ATOMIC_RELAXED, __HIP_MEMORY_SCOPE_AGENT);
}
__device__ __forceinline__ void part_wait_add(f32x4 (&acc)[2][2][4][2], const float* part, unsigned* flags, const Unit2& u, int tid, int lane) {
    const int np = (u.mode == 2) ? u.aux : 0;
    if (np > 0) { const unsigned want = 8u * (unsigned)np; unsigned spins = 0;
        for (;;) { unsigned v = 0; if (lane == 0) v = __hip_atomic_load(flags + 16 * u.slot, __ATOMIC_RELAXED, __HIP_MEMORY_SCOPE_AGENT);
            if ((unsigned)__builtin_amdgcn_readfirstlane(v) >= want) break;
            __builtin_amdgcn_s_sleep(1); if (++spins > (1u << 20)) break; }
        __builtin_amdgcn_fence(__ATOMIC_ACQUIRE, "agent"); }
    for (int pi = 0; pi < np; ++pi) { const float* p = part + ((size_t)(u.slot * u.pstr + pi) * 32) * 2048 + (size_t)tid * 4;
#pragma unroll
        for (int ai = 0; ai < 2; ++ai)
#pragma unroll
            for (int bj = 0; bj < 2; ++bj) {
#pragma unroll
                for (int m = 0; m < 4; ++m)
#pragma unroll
                    for (int n = 0; n < 2; ++n) acc[ai][bj][m][n] += *(const f32x4*)(p + (size_t)(((ai * 2 + bj) * 4 + m) * 2 + n) * 2048);
                asm volatile("" ::: "memory"); } }
}

template <class Epi, class Sched>
__device__ __forceinline__ void gemm_phase2(PG8_LAS unsigned char* lds, const Sched& S, const Epi& E, float* part, unsigned* flags, const unsigned ld2  ) {
    const int tid = threadIdx.x, wid = __builtin_amdgcn_readfirstlane(tid >> 6), lane = tid & 63, wr = wid >> 2, wc = wid & 3, fr = lane & 15, fq = lane >> 4;
    unsigned voffA[2], voffB[2];
#pragma unroll
    for (int i = 0; i < 2; ++i) { int R, C; stage_rc(tid * 16 + i * 8192, R, C); const int Rb = Epi::PERM ? ((R & ~31) + perm32(R & 31)) : R;
        voffA[i] = (unsigned)R * ld2 + (unsigned)C * 2u; voffB[i] = (unsigned)Rb * ld2 + (unsigned)C * 2u; }
    const size_t kstep = (size_t)(BK * 2);
    const size_t hs = (size_t)HALF * ld2;
    const unsigned ldsw = (unsigned)wid * 1024u;
    const int aoff = lds_byte(wr * 64 + fr, fq * 8), boff = lds_byte(wc * 32 + fr, fq * 8);
#define PG8_SA(b, h) (((b) * 2 + (h)) * HTB)
#define PG8_SB(b, h) ((4 + (b) * 2 + (h)) * HTB)
#define PG8_STAGE(bufoff, gbase, voff) do { _Pragma("unroll") for (int _i = 0; _i < 2; ++_i) \
        __builtin_amdgcn_global_load_lds((const unsigned*)((const char*)(gbase) + (voff)[_i]), (PG8_LAS unsigned*)(lds + (bufoff) + ldsw + _i * 8192), 16, 0, 0); } while (0)
#define PG8_LDA(dst, b, h) do { _Pragma("unroll") for (int m = 0; m < 4; ++m) _Pragma("unroll") for (int k = 0; k < 2; ++k) dst[m][k] = *(const PG8_LAS bf16x8*)(lds + PG8_SA(b, h) + aoff + m * 2048 + k * 1024); } while (0)
#define PG8_LDB(dst, b, h) do { _Pragma("unroll") for (int n = 0; n < 2; ++n) _Pragma("unroll") for (int k = 0; k < 2; ++k) dst[n][k] = *(const PG8_LAS bf16x8*)(lds + PG8_SB(b, h) + boff + n * 2048 + k * 1024); } while (0)
#define PG8_MMA(ai, bj, At, Bt) do { __builtin_amdgcn_s_setprio(1); _Pragma("unroll") for (int m = 0; m < 4; ++m) _Pragma("unroll") for (int n = 0; n < 2; ++n) _Pragma("unroll") for (int k = 0; k < 2; ++k) \
        acc[ai][bj][m][n] = __builtin_amdgcn_mfma_f32_16x16x32_bf16(Bt[n][k], At[m][k], acc[ai][bj][m][n], 0, 0, 0); __builtin_amdgcn_s_setprio(0); } while (0)
#define PG8_WAIT_V(n) asm volatile("s_waitcnt vmcnt(" #n ")" ::: "memory")
#define PG8_WAIT_L(n) asm volatile("s_waitcnt lgkmcnt(" #n ")" ::: "memory")
#define PG8_BAR __builtin_amdgcn_s_barrier()
#define PG8_SCHED __builtin_amdgcn_sched_barrier(0)
    Unit2 cur, nxt; int ui = 0;
    if (!S.next(0, cur)) return;
    f32x4 acc[2][2][4][2];
#pragma unroll
    for (int a = 0; a < 2; ++a)
#pragma unroll
        for (int b = 0; b < 2; ++b)
#pragma unroll
            for (int m = 0; m < 4; ++m)
#pragma unroll
                for (int n = 0; n < 2; ++n) acc[a][b][m][n] = (f32x4){0.f, 0.f, 0.f, 0.f};
    bf16x8 At[4][2], B0[2][2], B1[2][2];
    const char* cA = cur.A; const char* cB = cur.B;
    {
        PG8_STAGE(PG8_SB(0, 0), cB, voffB); PG8_STAGE(PG8_SB(0, 1), cB + hs, voffB); PG8_STAGE(PG8_SA(0, 0), cA, voffA); PG8_STAGE(PG8_SA(0, 1), cA + hs, voffA);
        if (wr == 1) PG8_BAR;
        PG8_WAIT_V(2); PG8_BAR;
        PG8_STAGE(PG8_SB(1, 0), cB + kstep, voffB); PG8_STAGE(PG8_SA(1, 0), cA + kstep, voffA); PG8_STAGE(PG8_SB(1, 1), cB + hs + kstep, voffB);
        PG8_WAIT_V(6); PG8_BAR;
    }
    for (;;) {
        const bool has_next = S.next(ui + 1, nxt);
        const char* nA = has_next ? nxt.A : cA; const char* nB = has_next ? nxt.B : cB;
        const int nt = cur.nt;
        for (int t = 0; t < nt; t += 2) {
            const bool last = (t == nt - 2);
            const char* a1 = cA + (size_t)(t + 1) * kstep;
            const char* a2 = last ? nA : cA + (size_t)(t + 2) * kstep; const char* b2 = last ? nB : cB + (size_t)(t + 2) * kstep;
            const char* a3 = a2 + kstep; const char* b3 = b2 + kstep;
            PG8_LDB(B0, 0, 0); PG8_LDB(B1, 0, 1); PG8_SCHED; PG8_LDA(At, 0, 0); PG8_STAGE(PG8_SA(1, 1), a1 + hs, voffA);
            PG8_WAIT_V(8); PG8_WAIT_L(0); PG8_BAR; PG8_MMA(0, 0, At, B0); PG8_MMA(0, 1, At, B1); PG8_BAR; PG8_SCHED;
            PG8_LDA(At, 0, 1); PG8_STAGE(PG8_SB(0, 0), b2, voffB); PG8_STAGE(PG8_SB(0, 1), b2 + hs, voffB); PG8_STAGE(PG8_SA(0, 0), a2, voffA);
            PG8_WAIT_V(8); PG8_WAIT_L(0); PG8_BAR; PG8_MMA(1, 0, At, B0); PG8_MMA(1, 1, At, B1); PG8_BAR; PG8_SCHED;
            PG8_LDB(B0, 1, 0); PG8_LDB(B1, 1, 1); PG8_SCHED; PG8_LDA(At, 1, 0); PG8_STAGE(PG8_SA(0, 1), a2 + hs, voffA);
            PG8_WAIT_V(8); PG8_WAIT_L(0); PG8_BAR; PG8_MMA(0, 0, At, B0); PG8_MMA(0, 1, At, B1); PG8_BAR; PG8_SCHED;
            PG8_LDA(At, 1, 1); PG8_STAGE(PG8_SB(1, 0), b3, voffB); PG8_STAGE(PG8_SB(1, 1), b3 + hs, voffB); PG8_STAGE(PG8_SA(1, 0), a3, voffA);
            PG8_WAIT_V(8); PG8_WAIT_L(0); PG8_BAR; PG8_MMA(1, 0, At, B0); PG8_MMA(1, 1, At, B1); PG8_BAR; PG8_SCHED;
        }
        if (wr == 0) PG8_BAR;
        {
            int tid_ = tid, lane_ = lane, fr_ = fr, fq_ = fq; asm volatile("" : "+v"(tid_), "+v"(lane_), "+v"(fr_), "+v"(fq_));
            E(acc, cur, wr, wc, fr_, fq_); }
        if (!has_next) break;
        if (cur.mode != 3) {
#pragma unroll
            for (int a = 0; a < 2; ++a)
#pragma unroll
                for (int b = 0; b < 2; ++b)
#pragma unroll
                    for (int m = 0; m < 4; ++m)
#pragma unroll
                        for (int n = 0; n < 2; ++n) acc[a][b][m][n] = (f32x4){0.f, 0.f, 0.f, 0.f};
        }
        cur = nxt; cA = nA; cB = nB; ++ui;
        if (wr == 1) PG8_BAR;
    }
    PG8_WAIT_V(0);
    PG8_BAR;
#undef PG8_SA
#undef PG8_SB
#undef PG8_STAGE
#undef PG8_LDA
#undef PG8_LDB
#undef PG8_MMA
#undef PG8_WAIT_V
#undef PG8_WAIT_L
#undef PG8_BAR
#undef PG8_SCHED
}

__device__ __forceinline__ void unit_of(int L, int nM, int nN, int& pm, int& pn) {
    const int nwg = nM * nN;
    if (L >= nwg) { const int e = L - nwg; pm = nM + (e >> 2); pn = nN + (e & 3); return; }
    int wgid = L; { const int q = nwg / NXCD, r = nwg % NXCD, xcd = wgid % NXCD, off = wgid / NXCD; wgid = (xcd < r ? xcd * (q + 1) : r * (q + 1) + (xcd - r) * q) + off; }
    const int nig = WGM * nN, gid = wgid / nig, fm = gid * WGM, gsz = (nM - fm) < WGM ? (nM - fm) : WGM;
    pm = fm + ((wgid % nig) % gsz); pn = (wgid % nig) / gsz;
}
struct SplitOrder {
    const bf16_t* A; const bf16_t* B; int K, nM, nN, U, G, c, nfull, tail, ways;
    __device__ __forceinline__ void init(const bf16_t* A_, const bf16_t* B_, int M, int N, int K_, int nextra, int G_, int c_) {
        A = A_; B = B_; K = K_; nM = M / BM; nN = N / BM; U = nM * nN + nextra; G = G_; c = c_; nfull = U / G; tail = U - nfull * G;
        ways = 1;
    }
    __device__ __forceinline__ bool next(int i, Unit2& u) const {
        int L, kt0 = 0, ntu = K / BK; u.mode = 0; u.slot = 0; u.aux = 0; u.pstr = ways - 1;
        if (i < nfull) L = i * G + c;
        else if (i == nfull && c < tail * ways) { const int j = c % tail, p = c / tail; L = nfull * G + j;
            if (ways > 1) { ntu = (K / BK) / ways; kt0 = p * ntu; u.mode = (p == 0) ? 2 : 1; u.slot = j; u.aux = (p == 0) ? ways - 1 : p - 1; } }
        else return false;
        unit_of(L, nM, nN, u.pm, u.pn);
        u.A = (const char*)(A + (size_t)u.pm * BM * K + (size_t)kt0 * BK); u.B = (const char*)(B + (size_t)u.pn * BM * K + (size_t)kt0 * BK); u.nt = ntu;
        return true;
    }
};
struct DeferOrder {
    const bf16_t* A; const bf16_t* B; int K, d0, d1, step;
    __device__ __forceinline__ bool next(int i, Unit2& u) const {
        const int d = d0 + i * step; if (d >= d1) return false;
        if (d < 64) { u.pm = d >> 1; u.pn = 48 + (d & 1); } else { const int e = d - 64; u.pm = 32 + (e >> 2); u.pn = 50 + (e & 3); }
        u.mode = 0; u.slot = 0; u.aux = 0; u.pstr = 0; u.nt = K / BK;
        u.A = (const char*)(A + (size_t)u.pm * BM * K); u.B = (const char*)(B + (size_t)u.pn * BM * K);
        return true;
    }
};
struct ChainOrder {
    const bf16_t *A, *B; int K, nt1, nM, nN, G, c;
    __device__ __forceinline__ bool next(int i, Unit2& u) const {
        const int L = (i >> 1) * G + c; if (L >= nM * nN) return false;
        unit_of(L, nM, nN, u.pm, u.pn); u.slot = 0; u.aux = 0; u.pstr = 0;
        const int kt0 = (i & 1) ? nt1 : 0; u.nt = (i & 1) ? K / BK - nt1 : nt1; u.mode = (i & 1) ? 0 : 3;
        u.A = (const char*)(A + (size_t)u.pm * BM * K + (size_t)kt0 * BK); u.B = (const char*)(B + (size_t)u.pn * BM * K + (size_t)kt0 * BK);
        return true;
    }
};
struct EpiFinal {
    static constexpr bool PERM = true, AFTER_DRAIN = false;
    const bf16_t* resid; float* out; float* sumsq; const float* wf; unsigned* cnt;
    __device__ __forceinline__ void operator()(f32x4 (&acc)[2][2][4][2], const Unit2& u, int wr, int wc, int fr, int fq) const {
        const int row0 = u.pm * BM + wr * 64 + fr, col0 = u.pn * BM + wc * 32 + 8 * fq;
#pragma unroll
        for (int ai = 0; ai < 2; ++ai)
#pragma unroll
            for (int m = 0; m < 4; ++m) { const size_t r = (size_t)(row0 + ai * HALF + m * 16); float ss = 0.f;
#pragma unroll
                for (int bj = 0; bj < 2; ++bj) { const int c = col0 + bj * HALF; const u32x4 g = *(const u32x4*)(resid + r * 2048 + c);
                    const f32x4 o0 = (f32x4){bflo(g.x), bfhi(g.x), bflo(g.y), bfhi(g.y)} + acc[ai][bj][m][0], o1 = (f32x4){bflo(g.z), bfhi(g.z), bflo(g.w), bfhi(g.w)} + acc[ai][bj][m][1];
                    acc[ai][bj][m][0] = o0; acc[ai][bj][m][1] = o1;
                    ss += (o0[0] * o0[0] + o0[1] * o0[1]) + (o0[2] * o0[2] + o0[3] * o0[3]) + (o1[0] * o1[0] + o1[1] * o1[1]) + (o1[2] * o1[2] + o1[3] * o1[3]); }
                ss += __shfl_xor(ss, 16); ss += __shfl_xor(ss, 32);
                if (fq == 0) atomicAdd(sumsq + r, ss); }
        asm volatile("s_waitcnt vmcnt(0)" ::: "memory");
        const int lane = fq * 16 + fr;
        if (lane == 0) __hip_atomic_fetch_add(cnt + 16 * u.pm, 1u, __ATOMIC_RELAXED, __HIP_MEMORY_SCOPE_AGENT);
        { unsigned spins = 0;
          for (;;) { unsigned v = 0; if (lane == 0) v = __hip_atomic_load(cnt + 16 * u.pm, __ATOMIC_RELAXED, __HIP_MEMORY_SCOPE_AGENT);
              if ((unsigned)__builtin_amdgcn_readfirstlane(v) >= 64u) break;
              __builtin_amdgcn_s_sleep(2); if (++spins > (1u << 20)) break; } }
#pragma unroll
        for (int ai = 0; ai < 2; ++ai)
#pragma unroll
            for (int m = 0; m < 4; ++m) { const size_t r = (size_t)(row0 + ai * HALF + m * 16);
                const float rs = rsqrtf(__hip_atomic_load(sumsq + r, __ATOMIC_RELAXED, __HIP_MEMORY_SCOPE_AGENT) * (1.f / 2048.f) + RMS_EPS_);
#pragma unroll
                for (int bj = 0; bj < 2; ++bj) { const int c = col0 + bj * HALF; const f32x4 w0 = *(const f32x4*)(wf + c), w1 = *(const f32x4*)(wf + c + 4);
                    *(f32x4*)(out + r * 2048 + c) = acc[ai][bj][m][0] * rs * w0; *(f32x4*)(out + r * 2048 + c + 4) = acc[ai][bj][m][1] * rs * w1; } }
    }
};
struct EpiMerge {
    static constexpr bool PERM = true, AFTER_DRAIN = false;
    const bf16_t* gates; bf16_t* out;
    __device__ __forceinline__ void operator()(f32x4 (&acc)[2][2][4][2], const Unit2& u, int wr, int wc, int fr, int fq) const {
        const int row0 = u.pm * BM + wr * 64 + fr, col0 = u.pn * BM + wc * 32 + 8 * fq;
#pragma unroll
        for (int ai = 0; ai < 2; ++ai)
#pragma unroll
            for (int m = 0; m < 4; ++m) { const size_t r = (size_t)(row0 + ai * HALF + m * 16);
#pragma unroll
                for (int bj = 0; bj < 2; ++bj) { const int c = col0 + bj * HALF; const u32x4 gb = *(const u32x4*)(gates + r * 4096 + 2048 + c);
                    float b[8] = {bflo(gb.x), bfhi(gb.x), bflo(gb.y), bfhi(gb.y), bflo(gb.z), bfhi(gb.z), bflo(gb.w), bfhi(gb.w)};
                    if (u.mode == 3) { const u32x4 ga = *(const u32x4*)(gates + r * 4096 + c);
                        const float a[8] = {bflo(ga.x), bfhi(ga.x), bflo(ga.y), bfhi(ga.y), bflo(ga.z), bfhi(ga.z), bflo(ga.w), bfhi(ga.w)};
#pragma unroll
                        for (int e = 0; e < 4; ++e) { acc[ai][bj][m][0][e] *= a[e] * __builtin_amdgcn_rcpf(fmaxf(b[e], 1e-30f)); acc[ai][bj][m][1][e] *= a[4 + e] * __builtin_amdgcn_rcpf(fmaxf(b[4 + e], 1e-30f)); } }
                    else { const f32x4 a0 = acc[ai][bj][m][0], a1 = acc[ai][bj][m][1];
                        u32x4 w; w.x = cvt_pk_bf16(a0[0] * b[0], a0[1] * b[1]); w.y = cvt_pk_bf16(a0[2] * b[2], a0[3] * b[3]); w.z = cvt_pk_bf16(a1[0] * b[4], a1[1] * b[5]); w.w = cvt_pk_bf16(a1[2] * b[6], a1[3] * b[7]);
                        *(u32x4*)(out + r * 2048 + c) = w; } } }
    }
};
}
using pg8::bf16_t; using pg8::bf16x8; using pg8::f32x4; using pg8::u32x4; using pg8::u32x2; using pg8::cvt_pk_bf16; using pg8::sigm; using pg8::bflo; using pg8::bfhi;
#define LAS __attribute__((address_space(3)))
constexpr int NTHR = 512;
constexpr int DMODEL = 2048, MTOK = 8192, SEQL = 2048, MMEM = 1024, DFF_ = 5632;
constexpr float EPS = 1e-6f;
constexpr float ATT_SCALE = 0.08838834764831845f;

constexpr size_t MiB = 1u << 20;
constexpr size_t WS_SUMSQ = 0;
constexpr size_t WS_LB = 128 * 1024;
constexpr size_t WS_BAR = 192 * 1024, BAR_BYTES = 48 * 1024, WS_FLAGS = WS_BAR + 16 * 1024;
constexpr size_t WS_LSE = 256 * 1024;
constexpr size_t WS_DEC = 1 * MiB;
constexpr size_t WS_WIN = 2 * MiB, WS_WKV = 52 * MiB, WS_WA = 56 * MiB, WS_WB = 58 * MiB, WS_WOUT = 62 * MiB, WS_WQ = 70 * MiB, WS_WO = 72 * MiB, WS_W13 = 74 * MiB, WS_W2 = 118 * MiB;
constexpr size_t WS_HN = 140 * MiB;
constexpr size_t WS_OG = 140 * MiB;
constexpr size_t WS_OATT = 164 * MiB;
constexpr size_t WS_QC = 164 * MiB;
constexpr size_t WS_OC = 140 * MiB;
constexpr size_t WS_QKV = 176 * MiB;
constexpr size_t WS_OCAT = 176 * MiB;
constexpr size_t WS_XB = 176 * MiB;
constexpr size_t WS_STB = 208 * MiB;
constexpr size_t WS_HG = 248 * MiB;
constexpr size_t WS_TMP = 248 * MiB;
constexpr size_t WS_G = 248 * MiB;
constexpr size_t WS_GATES = 312 * MiB;
constexpr size_t WS_KVC = 376 * MiB;
constexpr size_t WS_OHG = 378 * MiB;
constexpr size_t WS_END = 394 * MiB;

constexpr int LDS_BYTES = 147456, LDS_MISC = 147392;

__device__ __forceinline__ float wave_sum(float v) {
#pragma unroll
    for (int o = 1; o < 64; o <<= 1) v += __shfl_xor(v, o);
    return v;
}
#define LDS_FENCE() asm volatile("s_waitcnt lgkmcnt(0)" ::: "memory")

__device__ __forceinline__ void transpose_item(const float* __restrict__ W, int K, int N, bf16_t* WT, int dst_row0, const float* kscale, LAS float* scr, int k0, int n0, int lane, int dld = 0, int dcol = 0) {
    if (dld == 0) dld = K;
    const int lr = lane >> 4, lc = lane & 15;
    f32x4 v[16];
#pragma unroll
    for (int it = 0; it < 16; ++it) v[it] = __builtin_nontemporal_load((const f32x4*)(W + (size_t)(k0 + it * 4 + lr) * N + n0 + 4 * lc));
    if (kscale) {
#pragma unroll
        for (int it = 0; it < 16; ++it) v[it] = v[it] * kscale[k0 + it * 4 + lr]; }
#pragma unroll
    for (int it = 0; it < 16; ++it) { LAS float* d = scr + (it * 4 + lr) * 65 + 4 * lc; d[0] = v[it][0]; d[1] = v[it][1]; d[2] = v[it][2]; d[3] = v[it][3]; }
    LDS_FENCE();
    const int c = lane & 7;
#pragma unroll
    for (int j = 0; j < 8; ++j) { const int n = (lane >> 3) + 8 * j; const LAS float* s = scr + (8 * c) * 65 + n;
        u32x4 o; o.x = cvt_pk_bf16(s[0], s[65]); o.y = cvt_pk_bf16(s[130], s[195]); o.z = cvt_pk_bf16(s[260], s[325]); o.w = cvt_pk_bf16(s[390], s[455]);
        *(u32x4*)(WT + (size_t)(dst_row0 + n) * dld + dcol + k0 + 8 * c) = o; }
    LDS_FENCE();
}
__device__ __forceinline__ void rms_row_bf16(const float* xrow, const float* w, bf16_t* orow, int lane) {
    f32x4 v[8]; float s = 0.f;
#pragma unroll
    for (int j = 0; j < 8; ++j) { v[j] = __builtin_nontemporal_load(((const f32x4*)xrow) + lane + 64 * j); s += (v[j][0] * v[j][0] + v[j][1] * v[j][1]) + (v[j][2] * v[j][2] + v[j][3] * v[j][3]); }
    const float rstd = rsqrtf(wave_sum(s) * (1.f / 2048.f) + EPS);
#pragma unroll
    for (int j = 0; j < 8; ++j) { const f32x4 ww = ((const f32x4*)w)[lane + 64 * j]; const f32x4 o = v[j] * rstd * ww;
        u32x2 p; p.x = cvt_pk_bf16(o[0], o[1]); p.y = cvt_pk_bf16(o[2], o[3]); ((u32x2*)orow)[lane + 64 * j] = p; }
}

struct Args { const float* in[19]; float* out; unsigned char* ws; int ph_lo, ph_hi; };

__device__ __forceinline__ void phase_prologue(const Args& a, LAS unsigned char* lds, int tid) {
    const int lane = tid & 63, wave = tid >> 6; const int G = gridDim.x;
    LAS float* scr = (LAS float*)(lds + wave * 16896);
    const int gw = blockIdx.x * 8 + wave, NGW = G * 8;
    unsigned char* ws = a.ws;
    const float *w_in = a.in[3], *w_a = a.in[6], *w_b = a.in[7], *w_out = a.in[8], *wq = a.in[11], *wkv = a.in[12], *wo = a.in[13], *w1 = a.in[15], *w3 = a.in[16], *w2 = a.in[17];
    const float *ln_cross = a.in[9], *ln_ffn = a.in[14];
    constexpr int I_IN = 32 * 200, I_KV = 32 * 16, I_A = 8 * 32, I_B = 16 * 32, I_OUT = 32 * 32, I_Q = 32 * 8, I_O = 8 * 32, I_1 = 32 * 88, I_2 = 88 * 32;
    constexpr int NITEMS = I_IN + I_KV + I_A + I_B + I_OUT + I_Q + I_O + 2 * I_1 + I_2;
    for (int it = gw; it < NITEMS; it += NGW) {
        int r = it;
        if (r < I_IN) { transpose_item(w_in, 2048, 12800, (bf16_t*)(ws + WS_WIN), 64 * (r % 200), nullptr, scr, 64 * (r / 200), 64 * (r % 200), lane); continue; } r -= I_IN;
        if (r < I_KV) { transpose_item(wkv, 2048, 1024, (bf16_t*)(ws + WS_WKV), 64 * (r % 16), nullptr, scr, 64 * (r / 16), 64 * (r % 16), lane); continue; } r -= I_KV;
        if (r < I_A) { transpose_item(w_a, 512, 2048, (bf16_t*)(ws + WS_WA), 64 * (r % 32), nullptr, scr, 64 * (r / 32), 64 * (r % 32), lane, 1536, 0); continue; } r -= I_A;
        if (r < I_B) { transpose_item(w_b, 1024, 2048, (bf16_t*)(ws + WS_WA), 64 * (r % 32), nullptr, scr, 64 * (r / 32), 64 * (r % 32), lane, 1536, 512); continue; } r -= I_B;
        if (r < I_OUT) { transpose_item(w_out, 2048, 2048, (bf16_t*)(ws + WS_WOUT), 64 * (r % 32), nullptr, scr, 64 * (r / 32), 64 * (r % 32), lane); continue; } r -= I_OUT;
        if (r < I_Q) { transpose_item(wq, 2048, 512, (bf16_t*)(ws + WS_WQ), 64 * (r % 8), ln_cross, scr, 64 * (r / 8), 64 * (r % 8), lane); continue; } r -= I_Q;
        if (r < I_O) { transpose_item(wo, 512, 2048, (bf16_t*)(ws + WS_WO), 64 * (r % 32), nullptr, scr, 64 * (r / 32), 64 * (r % 32), lane); continue; } r -= I_O;
        if (r < I_1) { const int n0 = 64 * (r % 88); transpose_item(w1, 2048, 5632, (bf16_t*)(ws + WS_W13), 256 * (n0 >> 7) + (n0 & 127), ln_ffn, scr, 64 * (r / 88), n0, lane); continue; } r -= I_1;
        if (r < I_1) { const int n0 = 64 * (r % 88); transpose_item(w3, 2048, 5632, (bf16_t*)(ws + WS_W13), 256 * (n0 >> 7) + 128 + (n0 & 127), ln_ffn, scr, 64 * (r / 88), n0, lane); continue; } r -= I_1;
        transpose_item(w2, 5632, 2048, (bf16_t*)(ws + WS_W2), 64 * (r % 32), nullptr, scr, 64 * (r / 32), 64 * (r % 32), lane);
    }
    bf16_t* hn = (bf16_t*)(ws + WS_HN);
    for (int m = gw; m < MTOK + MMEM; m += NGW) {
        if (m < MTOK) rms_row_bf16(a.in[0] + (size_t)m * 2048, a.in[2], hn + (size_t)m * 2048, lane);
        else rms_row_bf16(a.in[1] + (size_t)(m - MTOK) * 2048, a.in[10], hn + (size_t)m * 2048, lane);
    }
    const int gt = blockIdx.x * NTHR + tid, NGT = G * NTHR;
    float* sumsq = (float*)(ws + WS_SUMSQ);
    for (int i = gt; i < 3 * 8192; i += NGT) sumsq[i] = 0.f;
    float* lb = (float*)(ws + WS_LB); const float* hlb = a.in[5];
    for (int i = gt; i < 1024; i += NGT) lb[i] = 1.f / (1.f + __expf(hlb[1024 + i] - hlb[i]));
}

constexpr int VTS = 132, KSS = 68;
constexpr int ATT_K_OFF = 128 * VTS * 4;
template <bool MASKED, bool QPRE = false>
__device__ __forceinline__ void attn_unit(LAS unsigned char* lds, const bf16_t* Qb, long qs, const bf16_t* Kown, long ks, const bf16_t* Vown, long vs, bool hasprev,
                                          bf16_t* Ob, long os, float* lsep, long lses, int tid, const bf16x8* qpre = nullptr) {
    const int lane = tid & 63, w = tid >> 6, fr = lane & 15, fq = lane >> 4;
    LAS unsigned* VT = (LAS unsigned*)lds; LAS unsigned* KS = (LAS unsigned*)(lds + ATT_K_OFF);
    const int iq = 16 * w + fr;
    u32x4 kx[8], vx[4], vy[4]; bf16x8 qf[4];
#pragma unroll
    for (int it = 0; it < 8; ++it) { const int id = tid + NTHR * it; long r = (id >> 4) - 128; if (!hasprev && r < 0) r = 0; kx[it] = *(const u32x4*)(Kown + r * ks + 8 * (id & 15)); }
#pragma unroll
    for (int it = 0; it < 4; ++it) { const int task = tid + NTHR * it; const int p = task & 127, c = task >> 7;
        long r0 = 2 * p - 128; if (!hasprev && r0 < 0) r0 = 0;
        const bf16_t* src = Vown + r0 * vs + 8 * c; vx[it] = *(const u32x4*)src; vy[it] = *(const u32x4*)(src + vs); }
#pragma unroll
    for (int k4 = 0; k4 < 4; ++k4) { if (QPRE) qf[k4] = qpre[k4]; else qf[k4] = *(const bf16x8*)(Qb + (long)iq * qs + 32 * k4 + 8 * fq); }
    __syncthreads();
#pragma unroll
    for (int it = 0; it < 8; ++it) { const int id = tid + NTHR * it; *(LAS u32x4*)(KS + (id >> 4) * KSS + 4 * (id & 15)) = kx[it]; }
#pragma unroll
    for (int it = 0; it < 4; ++it) { const int task = tid + NTHR * it; const int p = task & 127, c = task >> 7; const u32x4 x = vx[it], y = vy[it];
        LAS unsigned* d = VT + (8 * c) * VTS + p;
        d[0 * VTS] = (x.x & 0xffffu) | (y.x << 16); d[1 * VTS] = (x.x >> 16) | (y.x & 0xffff0000u);
        d[2 * VTS] = (x.y & 0xffffu) | (y.y << 16); d[3 * VTS] = (x.y >> 16) | (y.y & 0xffff0000u);
        d[4 * VTS] = (x.z & 0xffffu) | (y.z << 16); d[5 * VTS] = (x.z >> 16) | (y.z & 0xffff0000u);
        d[6 * VTS] = (x.w & 0xffffu) | (y.w << 16); d[7 * VTS] = (x.w >> 16) | (y.w & 0xffff0000u); }
    __syncthreads();
    constexpr int NT = MASKED ? 10 : 16; const int t0 = MASKED ? w : 0;
    f32x4 s[NT];
    float mx = -INFINITY;
#pragma unroll
    for (int i = 0; i < NT; ++i) { const int t = t0 + i, tc = t < 15 ? t : 15;
        const LAS unsigned* kp = KS + (16 * tc + fr) * KSS + 4 * fq;
        f32x4 acc = {0.f, 0.f, 0.f, 0.f};
#pragma unroll
        for (int k4 = 0; k4 < 4; ++k4) { const bf16x8 kf = __builtin_bit_cast(bf16x8, *(const LAS u32x4*)(kp + 16 * k4)); acc = __builtin_amdgcn_mfma_f32_16x16x32_bf16(kf, qf[k4], acc, 0, 0, 0); }
#pragma unroll
        for (int j = 0; j < 4; ++j) { const int kk = 16 * t + 4 * fq + j; bool ok = (t <= 15);
            if (MASKED) ok = ok && (kk >= iq) && (kk <= iq + 128);
            ok = ok && (hasprev || kk >= 128);
            const float v = ok ? acc[j] * ATT_SCALE : -INFINITY; acc[j] = v; mx = fmaxf(mx, v); }
        s[i] = acc; }
    mx = fmaxf(mx, __shfl_xor(mx, 16)); mx = fmaxf(mx, __shfl_xor(mx, 32));
    float l = 0.f;
#pragma unroll
    for (int i = 0; i < NT; ++i)
#pragma unroll
        for (int j = 0; j < 4; ++j) { const float p = __expf(s[i][j] - mx); s[i][j] = p; l += p; }
    l += __shfl_xor(l, 16); l += __shfl_xor(l, 32);
    f32x4 o[8];
#pragma unroll
    for (int mt = 0; mt < 8; ++mt) o[mt] = (f32x4){0.f, 0.f, 0.f, 0.f};
#pragma unroll
    for (int sp = 0; sp < NT / 2; ++sp) { const int ta = t0 + 2 * sp, tb = ta + 1; const int tca = ta < 15 ? ta : 15, tcb = tb < 15 ? tb : 15;
        u32x4 pw; pw.x = cvt_pk_bf16(s[2 * sp][0], s[2 * sp][1]); pw.y = cvt_pk_bf16(s[2 * sp][2], s[2 * sp][3]); pw.z = cvt_pk_bf16(s[2 * sp + 1][0], s[2 * sp + 1][1]); pw.w = cvt_pk_bf16(s[2 * sp + 1][2], s[2 * sp + 1][3]);
        const bf16x8 pf = __builtin_bit_cast(bf16x8, pw);
#pragma unroll
        for (int mt = 0; mt < 8; ++mt) { const LAS unsigned* vr = VT + (16 * mt + fr) * VTS + 2 * fq;
            const u32x2 lo = *(const LAS u32x2*)(vr + 8 * tca), hi = *(const LAS u32x2*)(vr + 8 * tcb);
            u32x4 vw; vw.x = lo.x; vw.y = lo.y; vw.z = hi.x; vw.w = hi.y;
            o[mt] = __builtin_amdgcn_mfma_f32_16x16x32_bf16(__builtin_bit_cast(bf16x8, vw), pf, o[mt], 0, 0, 0); } }
    const float il = 1.f / l;
    bf16_t* op = Ob + (long)iq * os + 4 * fq;
#pragma unroll
    for (int mt = 0; mt < 8; ++mt) { u32x2 wv; wv.x = cvt_pk_bf16(o[mt][0] * il, o[mt][1] * il); wv.y = cvt_pk_bf16(o[mt][2] * il, o[mt][3] * il); *(u32x2*)(op + 16 * mt) = wv; }
    if (lsep && fq == 0) lsep[(long)iq * lses] = mx + __logf(l);
}

constexpr int QB_STRIDE = 144, QB_BYTES = 128 * QB_STRIDE, QT_OFF = 2 * QB_BYTES, QT_STRIDE = 272;
__device__ __forceinline__ void cross_q_tile(LAS unsigned char* lds, const bf16_t* XBp, const bf16_t* WQT, const float* ssq, int tid, bf16x8 (&qf)[4]) {
    const int lane = tid & 63, w = tid >> 6, fr = lane & 15, fq = lane >> 4;
    const bf16_t* ap = XBp + (size_t)(16 * w + fr) * 2048 + 8 * fq;
    const int br = tid >> 3, bc = tid & 7;
    const bf16_t* bp = WQT + (size_t)br * 2048 + 8 * bc;
    f32x4 acc[8];
#pragma unroll
    for (int nt = 0; nt < 8; ++nt) acc[nt] = (f32x4){0.f, 0.f, 0.f, 0.f};
    u32x4 b0[4], b1[4]; bf16x8 a0[4], a1[4];
#pragma unroll
    for (int i = 0; i < 4; ++i) { b0[i] = *(const u32x4*)(bp + 64 * i); b1[i] = *(const u32x4*)(bp + (size_t)64 * 2048 + 64 * i); a0[i] = *(const bf16x8*)(ap + 64 * i); a1[i] = *(const bf16x8*)(ap + 64 * i + 32); }
    __syncthreads();
    for (int kq = 0; kq < 8; ++kq) {
#pragma unroll
        for (int i = 0; i < 4; ++i) { const int kc = 4 * kq + i;
            LAS unsigned char* buf = lds + (i & 1) * QB_BYTES;
            *(LAS u32x4*)(buf + br * QB_STRIDE + 16 * bc) = b0[i]; *(LAS u32x4*)(buf + (br + 64) * QB_STRIDE + 16 * bc) = b1[i];
            const bf16x8 c0 = a0[i], c1 = a1[i];
            if (kq < 7) { b0[i] = *(const u32x4*)(bp + 64 * (kc + 4)); b1[i] = *(const u32x4*)(bp + (size_t)64 * 2048 + 64 * (kc + 4)); a0[i] = *(const bf16x8*)(ap + 64 * (kc + 4)); a1[i] = *(const bf16x8*)(ap + 64 * (kc + 4) + 32); }
            __syncthreads();
#pragma unroll
            for (int nt = 0; nt < 8; ++nt) { const LAS unsigned char* rp = buf + (16 * nt + fr) * QB_STRIDE + 16 * fq;
                const bf16x8 f0 = __builtin_bit_cast(bf16x8, *(const LAS u32x4*)rp), f1 = __builtin_bit_cast(bf16x8, *(const LAS u32x4*)(rp + 64));
                acc[nt] = __builtin_amdgcn_mfma_f32_16x16x32_bf16(c0, f0, acc[nt], 0, 0, 0); acc[nt] = __builtin_amdgcn_mfma_f32_16x16x32_bf16(c1, f1, acc[nt], 0, 0, 0); } }
    }
    float rs[4];
#pragma unroll
    for (int j = 0; j < 4; ++j) rs[j] = rsqrtf(ssq[16 * w + 4 * fq + j] * (1.f / 2048.f) + EPS);
    LAS unsigned char* qt = lds + QT_OFF;
#pragma unroll
    for (int nt = 0; nt < 8; ++nt)
#pragma unroll
        for (int j = 0; j < 4; ++j) *(LAS bf16_t*)(qt + (16 * w + 4 * fq + j) * QT_STRIDE + 2 * (16 * nt + fr)) = (bf16_t)(cvt_pk_bf16(acc[nt][j] * rs[j], 0.f) & 0xffffu);
    __syncthreads();
#pragma unroll
    for (int k4 = 0; k4 < 4; ++k4) qf[k4] = __builtin_bit_cast(bf16x8, *(const LAS u32x4*)(qt + (16 * w + fr) * QT_STRIDE + 2 * (32 * k4 + 8 * fq)));
}

__device__ __forceinline__ void hg_gates(const unsigned (&fw)[8], float lb0, float lb1, LAS float* psum, int tid, float (&f)[2][8], float (&b)[2][8], float (&tot)[2]) {
    const int k0 = 2 * (tid & 63), part = tid >> 6;
    float r0 = 0.f, r1 = 0.f;
#pragma unroll
    for (int cc = 0; cc < 8; ++cc) { const float f0 = lb0 + (1.f - lb0) * sigm(bflo(fw[cc])), f1 = lb1 + (1.f - lb1) * sigm(bfhi(fw[cc]));
        f[0][cc] = f0; f[1][cc] = f1; r0 += __logf(f0); r1 += __logf(f1); b[0][cc] = r0; b[1][cc] = r1; }
    psum[part * 128 + k0] = r0; psum[part * 128 + k0 + 1] = r1;
    __syncthreads();
    float off0 = 0.f, off1 = 0.f, t0 = 0.f, t1 = 0.f;
#pragma unroll
    for (int p = 0; p < 8; ++p) { const float a0 = psum[p * 128 + k0], a1 = psum[p * 128 + k0 + 1]; if (p < part) { off0 += a0; off1 += a1; } t0 += a0; t1 += a1; }
#pragma unroll
    for (int cc = 0; cc < 8; ++cc) { b[0][cc] += off0; b[1][cc] += off1; }
    tot[0] = t0; tot[1] = t1;
}
constexpr int HS = 36;
__device__ __forceinline__ void hg_write_vt(const u32x4 x, const u32x4 y, LAS unsigned* VTh, int tid) {
    const int p = tid & 31, ch = tid >> 5;
    LAS unsigned* d = VTh + (8 * ch) * HS + p;
    d[0 * HS] = (x.x & 0xffffu) | (y.x << 16); d[1 * HS] = (x.x >> 16) | (y.x & 0xffff0000u);
    d[2 * HS] = (x.y & 0xffffu) | (y.y << 16); d[3 * HS] = (x.y >> 16) | (y.y & 0xffff0000u);
    d[4 * HS] = (x.z & 0xffffu) | (y.z << 16); d[5 * HS] = (x.z >> 16) | (y.z & 0xffff0000u);
    d[6 * HS] = (x.w & 0xffffu) | (y.w << 16); d[7 * HS] = (x.w >> 16) | (y.w & 0xffff0000u);
}
struct HgIn { unsigned fw[8]; u32x4 x, y; float lb0, lb1; };
__device__ __forceinline__ void hg_load(HgIn& I, const bf16_t* hg, const float* lbp, int hu, int tid) {
    const int bh = hu >> 5, n = hu & 31, b_ = bh >> 3, h = bh & 7, row0 = b_ * 2048 + n * 64; const int k0 = 2 * (tid & 63), part = tid >> 6;
#pragma unroll
    for (int cc = 0; cc < 8; ++cc) I.fw[cc] = *(const unsigned*)(hg + (size_t)(row0 + part * 8 + cc) * 4096 + 1024 + h * 128 + k0);
    const bf16_t* src = hg + (size_t)(row0 + 2 * (tid & 31)) * 4096 + 2048 + h * 128 + 8 * (tid >> 5);
    I.x = *(const u32x4*)src; I.y = *(const u32x4*)(src + 4096);
    I.lb0 = lbp[h * 128 + k0]; I.lb1 = lbp[h * 128 + k0 + 1];
}
__device__ __forceinline__ void hg_kv_phase(LAS unsigned char* lds, const bf16_t* hg, const float* lbp, bf16_t* ST, float* DEC, int tid, int bid, int G) {
    const int lane = tid & 63, w = tid >> 6, fr = lane & 15, fq = lane >> 4;
    LAS unsigned* VTh = (LAS unsigned*)lds;
    LAS unsigned* KDT = (LAS unsigned*)(lds + 18432);
    LAS float* psum = (LAS float*)(lds + 36864);
    const int k0 = 2 * (tid & 63), part = tid >> 6;
    HgIn I; if (bid < 1024) hg_load(I, hg, lbp, bid, tid);
    for (int hu = bid; hu < 1024; hu += G) {
        __syncthreads();
        hg_write_vt(I.x, I.y, VTh, tid);
        float f[2][8], b[2][8], tot[2];
        hg_gates(I.fw, I.lb0, I.lb1, psum, tid, f, b, tot);
        if (hu + G < 1024) hg_load(I, hg, lbp, hu + G, tid);
#pragma unroll
        for (int q = 0; q < 2; ++q) { float kd[8];
#pragma unroll
            for (int cc = 0; cc < 8; ++cc) kd[cc] = (1.f - f[q][cc]) * __expf(tot[q] - b[q][cc]);
            u32x4 wv; wv.x = cvt_pk_bf16(kd[0], kd[1]); wv.y = cvt_pk_bf16(kd[2], kd[3]); wv.z = cvt_pk_bf16(kd[4], kd[5]); wv.w = cvt_pk_bf16(kd[6], kd[7]);
            *(LAS u32x4*)(KDT + (k0 + q) * HS + 4 * part) = wv; }
        if (part == 0) { DEC[(size_t)hu * 128 + k0] = __expf(tot[0]); DEC[(size_t)hu * 128 + k0 + 1] = __expf(tot[1]); }
        __syncthreads();
        bf16x8 af[2];
#pragma unroll
        for (int k2 = 0; k2 < 2; ++k2) af[k2] = __builtin_bit_cast(bf16x8, *(const LAS u32x4*)(VTh + (16 * w + fr) * HS + 16 * k2 + 4 * fq));
        bf16_t* stp = ST + (size_t)hu * 16384 + (size_t)(16 * w + 4 * fq) * 128 + fr;
#pragma unroll
        for (int nt = 0; nt < 8; ++nt) { f32x4 acc = {0.f, 0.f, 0.f, 0.f};
#pragma unroll
            for (int k2 = 0; k2 < 2; ++k2) { const bf16x8 bf = __builtin_bit_cast(bf16x8, *(const LAS u32x4*)(KDT + (16 * nt + fr) * HS + 16 * k2 + 4 * fq)); acc = __builtin_amdgcn_mfma_f32_16x16x32_bf16(af[k2], bf, acc, 0, 0, 0); }
#pragma unroll
            for (int j = 0; j < 4; ++j) { const float nb = __shfl_down(acc[j], 1); if (!(fr & 1)) *(unsigned*)(stp + j * 128 + 16 * nt) = cvt_pk_bf16(acc[j], nb); } }
    }
}
constexpr int QS = 68;
__device__ __forceinline__ void hg_out_phase(LAS unsigned char* lds, const bf16_t* hg, const float* lbp, const float* hg_norm_w, const bf16_t* STB, bf16_t* OHG, int tid, int bid, int G) {
    const int lane = tid & 63, w = tid >> 6, fr = lane & 15, fq = lane >> 4;
    LAS unsigned* VTh = (LAS unsigned*)lds;
    LAS unsigned* QD = (LAS unsigned*)(lds + 18432);
    LAS unsigned* QM = (LAS unsigned*)(lds + 18432 + 17408);
    LAS unsigned* KM = (LAS unsigned*)(lds + 18432 + 2 * 17408);
    LAS float* psum = (LAS float*)(lds + 18432 + 3 * 17408);
    LAS float* bref = psum + 1024;
    LAS float* ssq = bref + 128;
    const int k0 = 2 * (tid & 63), part = tid >> 6, ct = w & 3, vh = w >> 2, c = 16 * ct + fr;
    HgIn I; unsigned qw[8];
    if (bid < 1024) { hg_load(I, hg, lbp, bid, tid); const int bh = bid >> 5, row0 = (bh >> 3) * 2048 + (bid & 31) * 64;
#pragma unroll
        for (int cc = 0; cc < 8; ++cc) qw[cc] = *(const unsigned*)(hg + (size_t)(row0 + part * 8 + cc) * 4096 + (bh & 7) * 128 + k0); }
    for (int hu = bid; hu < 1024; hu += G) {
        const int bh = hu >> 5, n = hu & 31, b_ = bh >> 3, h = bh & 7, row0 = b_ * 2048 + n * 64;
        u32x4 sa[4][4]; u32x2 gw[4]; f32x4 nw[4];
#pragma unroll
        for (int mi = 0; mi < 4; ++mi) { const bf16_t* sp = STB + (size_t)hu * 16384 + (size_t)(16 * (vh * 4 + mi) + fr) * 128 + 8 * fq;
#pragma unroll
            for (int k4 = 0; k4 < 4; ++k4) sa[mi][k4] = *(const u32x4*)(sp + 32 * k4);
            const int v0 = 16 * (vh * 4 + mi) + 4 * fq; gw[mi] = *(const u32x2*)(hg + (size_t)(row0 + c) * 4096 + 3072 + h * 128 + v0); nw[mi] = *(const f32x4*)(hg_norm_w + v0); }
        __syncthreads();
        hg_write_vt(I.x, I.y, VTh, tid);
        float f[2][8], b[2][8], tot[2];
        hg_gates(I.fw, I.lb0, I.lb1, psum, tid, f, b, tot);
        if (part == 4) { bref[k0] = b[0][0]; bref[k0 + 1] = b[1][0]; }
        __syncthreads();
        const float br0 = bref[k0], br1 = bref[k0 + 1];
#pragma unroll
        for (int cc = 0; cc < 8; ++cc) { const int c_ = part * 8 + cc; const float q0 = bflo(qw[cc]), q1 = bfhi(qw[cc]);
            const float e0 = __expf(b[0][cc] - br0), e1 = __expf(b[1][cc] - br1);
            QD[c_ * QS + (k0 >> 1)] = cvt_pk_bf16(q0 * __expf(b[0][cc]), q1 * __expf(b[1][cc]));
            QM[c_ * QS + (k0 >> 1)] = cvt_pk_bf16(q0 * e0, q1 * e1);
            KM[c_ * QS + (k0 >> 1)] = cvt_pk_bf16((1.f - f[0][cc]) * __builtin_amdgcn_rcpf(e0), (1.f - f[1][cc]) * __builtin_amdgcn_rcpf(e1)); }
        if (hu + G < 1024) { const int hn = hu + G; hg_load(I, hg, lbp, hn, tid); const int bhn = hn >> 5, row0n = (bhn >> 3) * 2048 + (hn & 31) * 64;
#pragma unroll
            for (int cc = 0; cc < 8; ++cc) qw[cc] = *(const unsigned*)(hg + (size_t)(row0n + part * 8 + cc) * 4096 + (bhn & 7) * 128 + k0); }
        __syncthreads();
        bf16x8 qmf[4];
#pragma unroll
        for (int k4 = 0; k4 < 4; ++k4) qmf[k4] = __builtin_bit_cast(bf16x8, *(const LAS u32x4*)(QM + (16 * ct + fr) * QS + 16 * k4 + 4 * fq));
        unsigned ap[4][2];
#pragma unroll
        for (int st = 0; st < 4; ++st) { f32x4 acc = {0.f, 0.f, 0.f, 0.f};
#pragma unroll
            for (int k4 = 0; k4 < 4; ++k4) { const bf16x8 kf = __builtin_bit_cast(bf16x8, *(const LAS u32x4*)(KM + (16 * st + fr) * QS + 16 * k4 + 4 * fq)); acc = __builtin_amdgcn_mfma_f32_16x16x32_bf16(kf, qmf[k4], acc, 0, 0, 0); }
#pragma unroll
            for (int j = 0; j < 4; ++j) { const int s_ = 16 * st + 4 * fq + j; if (s_ > c) acc[j] = 0.f; }
            ap[st][0] = cvt_pk_bf16(acc[0], acc[1]); ap[st][1] = cvt_pk_bf16(acc[2], acc[3]); }
        bf16x8 qdf[4];
#pragma unroll
        for (int k4 = 0; k4 < 4; ++k4) qdf[k4] = __builtin_bit_cast(bf16x8, *(const LAS u32x4*)(QD + (16 * ct + fr) * QS + 16 * k4 + 4 * fq));
        f32x4 o[4]; float ss = 0.f;
#pragma unroll
        for (int mi = 0; mi < 4; ++mi) { const int mt = vh * 4 + mi; f32x4 acc = {0.f, 0.f, 0.f, 0.f};
#pragma unroll
            for (int k4 = 0; k4 < 4; ++k4) acc = __builtin_amdgcn_mfma_f32_16x16x32_bf16(__builtin_bit_cast(bf16x8, sa[mi][k4]), qdf[k4], acc, 0, 0, 0);
#pragma unroll
            for (int s2 = 0; s2 < 2; ++s2) { const LAS unsigned* vr = VTh + (16 * mt + fr) * HS + 16 * s2 + 2 * fq;
                const u32x2 lo = *(const LAS u32x2*)vr, hi = *(const LAS u32x2*)(vr + 8);
                u32x4 vw; vw.x = lo.x; vw.y = lo.y; vw.z = hi.x; vw.w = hi.y;
                u32x4 pw; pw.x = ap[2 * s2][0]; pw.y = ap[2 * s2][1]; pw.z = ap[2 * s2 + 1][0]; pw.w = ap[2 * s2 + 1][1];
                acc = __builtin_amdgcn_mfma_f32_16x16x32_bf16(__builtin_bit_cast(bf16x8, vw), __builtin_bit_cast(bf16x8, pw), acc, 0, 0, 0); }
            o[mi] = acc; ss += (acc[0] * acc[0] + acc[1] * acc[1]) + (acc[2] * acc[2] + acc[3] * acc[3]); }
        ss += __shfl_xor(ss, 16); ss += __shfl_xor(ss, 32);
        if (fq == 0) ssq[vh * 64 + c] = ss;
        __syncthreads();
        const float rstd = rsqrtf((ssq[c] + ssq[64 + c]) * (1.f / 128.f) + EPS);
#pragma unroll
        for (int mi = 0; mi < 4; ++mi) { const int v0 = 16 * (vh * 4 + mi) + 4 * fq;
            u32x2 ov; ov.x = cvt_pk_bf16(o[mi][0] * rstd * nw[mi][0] * bflo(gw[mi].x), o[mi][1] * rstd * nw[mi][1] * bfhi(gw[mi].x)); ov.y = cvt_pk_bf16(o[mi][2] * rstd * nw[mi][2] * bflo(gw[mi].y), o[mi][3] * rstd * nw[mi][3] * bfhi(gw[mi].y));
            *(u32x2*)(OHG + (size_t)(row0 + c) * 1536 + 512 + h * 128 + v0) = ov; }
    }
}

#define XB_TMO      128
#define XB_XCNT(j)  (256  + 64 * (j))
#define XB_XSUB(j)  (1280 + 64 * (j))
#define XB_XGEN(j)  (2304 + 64 * (j))
#define XB_TOP      3328
#define XB_TOPGEN   3392
#define XCD_BAR_WORDS 3456
#define XB_SPIN_CAP (1u << 18)

__device__ __forceinline__ unsigned xb_ld(unsigned* p)              { return __hip_atomic_load(p, __ATOMIC_RELAXED, __HIP_MEMORY_SCOPE_AGENT); }
__device__ __forceinline__ unsigned xb_add(unsigned* p, unsigned v) { return __hip_atomic_fetch_add(p, v, __ATOMIC_RELAXED, __HIP_MEMORY_SCOPE_AGENT); }
__device__ __forceinline__ unsigned xb_xcc_id() { return (unsigned)__builtin_amdgcn_s_getreg((3 << 11) | 20) & 0xFu; }
#define XB_SPIN(cond, bar) do { unsigned _sp = 0; while (cond) { __builtin_amdgcn_s_sleep(1); \
    if ((++_sp & 255u) == 0u) { if (xb_ld(&(bar)[XB_TMO])) break; if (_sp > XB_SPIN_CAP) { atomicAdd(&(bar)[XB_TMO], 1u); break; } } } } while (0)

struct XcdBarrier {
    unsigned* bar; unsigned x;
    volatile LAS unsigned* st;
};

__device__ __forceinline__ XcdBarrier xcd_barrier_post(unsigned* bar, volatile LAS unsigned* st) {
    XcdBarrier b; b.bar = bar; b.x = xb_xcc_id(); b.st = st;
    if (threadIdx.x == 0) (void)xb_add(&bar[XB_XCNT(b.x)], 1u);
    return b;
}
__device__ __forceinline__ void xcd_barrier_complete(unsigned* bar, unsigned x, unsigned& nloc, unsigned& nx) {
    const unsigned G = gridDim.x * gridDim.y * gridDim.z;
    unsigned sum, cnt, mine, sp = 0u;
    for (;;) {
        sum = 0u; cnt = 0u; mine = 0u;
#pragma unroll
        for (unsigned j = 0; j < 16; ++j) { const unsigned c = xb_ld(&bar[XB_XCNT(j)]); sum += c; cnt += (c > 0u) ? 1u : 0u; mine = (j == x) ? c : mine; }
        if (sum == G) break;
        __builtin_amdgcn_s_sleep(1);
        if ((++sp & 255u) == 0u) { if (xb_ld(&bar[XB_TMO])) break; if (sp > XB_SPIN_CAP) { atomicAdd(&bar[XB_TMO], 1u); break; } }
    }
    nloc = mine > 0u ? mine : 1u; nx = cnt > 0u ? cnt : 1u;
}

__device__ __forceinline__ void xcd_barrier(const XcdBarrier& b) {
    asm volatile("s_waitcnt vmcnt(0)" ::: "memory");
    __syncthreads();
    if (threadIdx.x == 0) {
        unsigned* bar = b.bar;
        __builtin_amdgcn_s_waitcnt(0);
        unsigned nloc = b.st[0], nx = b.st[1];
        if (nloc == 0u) { xcd_barrier_complete(bar, b.x, nloc, nx); b.st[0] = nloc; b.st[1] = nx; }
        const unsigned old = xb_add(&bar[XB_XSUB(b.x)], 1u);
        const unsigned gen = old / nloc;
        if (old + 1u == (gen + 1u) * nloc) {
            __builtin_amdgcn_fence(__ATOMIC_RELEASE, "agent");
            asm volatile("s_waitcnt vmcnt(0)" ::: "memory");
            const unsigned og = xb_add(&bar[XB_TOP], 1u);
            const unsigned tg = og / nx;
            if (og + 1u == (tg + 1u) * nx) xb_add(&bar[XB_TOPGEN], 1u);
            else XB_SPIN(xb_ld(&bar[XB_TOPGEN]) == tg, bar);
            __builtin_amdgcn_fence(__ATOMIC_ACQUIRE, "agent");
            xb_add(&bar[XB_XGEN(b.x)], 1u);
            asm volatile("s_waitcnt vmcnt(0)" ::: "memory");
        } else {
            XB_SPIN(xb_ld(&bar[XB_XGEN(b.x)]) == gen, bar);
            __builtin_amdgcn_fence(__ATOMIC_ACQUIRE, "agent");
            asm volatile("s_waitcnt vmcnt(0)" ::: "memory");
        }
    }
    __syncthreads();
}

constexpr int NPHASE = 12;
#ifndef REP_PHASE
#define REP_PHASE -1
#endif
#define REPLOOP(k) _Pragma("nounroll") for (int rep_ = 0; rep_ < ((k) == REP_PHASE ? 2 : 1); ++rep_)
__global__ void __launch_bounds__(NTHR, 2) fwd_kernel(Args a) {
    extern __shared__ __attribute__((aligned(16))) unsigned char lds_raw[];
    LAS unsigned char* lds = (LAS unsigned char*)lds_raw;
    cg::grid_group grid = cg::this_grid();
    const int tid = threadIdx.x, G = gridDim.x, bid = blockIdx.x;
    unsigned char* ws = a.ws;
    const int lo = a.ph_lo, hi = a.ph_hi;
#define IN(k) (lo <= (k) && (k) < hi)
#define SEAM(k) do { if (IN(k) && IN((k) + 1)) { if (lo < 0) grid.sync(); else xcd_barrier(bar); } } while (0)
    if (tid < 2) ((volatile LAS unsigned*)(lds + LDS_MISC))[tid] = 0u;
    __syncthreads();
    XcdBarrier bar = xcd_barrier_post((unsigned*)(ws + WS_BAR), (volatile LAS unsigned*)(lds + LDS_MISC));
    float* sumsq = (float*)(ws + WS_SUMSQ);
    bf16_t* QKV = (bf16_t*)(ws + WS_QKV); bf16_t* HGB = (bf16_t*)(ws + WS_HG); bf16_t* GATES = (bf16_t*)(ws + WS_GATES); bf16_t* KVC = (bf16_t*)(ws + WS_KVC);
    bf16_t* OG = (bf16_t*)((unsigned char*)a.out + 32 * MiB);       float* LSE = (float*)(ws + WS_LSE); bf16_t* OCAT = (bf16_t*)(ws + WS_OCAT);
    bf16_t* ST = (bf16_t*)a.out; bf16_t* STB = (bf16_t*)(ws + WS_STB); float* DEC = (float*)(ws + WS_DEC); const float* LB = (const float*)(ws + WS_LB);
    float* PART = a.out; unsigned* FLAGS = (unsigned*)(ws + WS_FLAGS); bf16_t* MERGED = (bf16_t*)a.out; bf16_t* XB = (bf16_t*)(ws + WS_XB);
    bf16_t* QC = (bf16_t*)(ws + WS_QC); bf16_t* OC = (bf16_t*)(ws + WS_OC); bf16_t* GB = (bf16_t*)(ws + WS_G);

    if (IN(0)) REPLOOP(0) { phase_prologue(a, lds, tid); __syncthreads(); }
    SEAM(0);
    if (IN(1)) REPLOOP(1) {
        pg8::SplitOrder S; S.init((const bf16_t*)(ws + WS_HN), (const bf16_t*)(ws + WS_WIN), MTOK, 12288, 2048, 0, G, bid);
        pg8::EpiProj E{QKV, HGB, GATES, KVC};
        pg8::gemm_phase2<pg8::EpiProj, pg8::SplitOrder>(lds, S, E, PART, FLAGS, 2u * 2048u);
    }
    SEAM(1);
    const int NGEM = G >= 160 ? 80 : 0;
    if (IN(2)) REPLOOP(2) {
      { const int bid_ = bid, G_ = G;
        for (int u = bid_; u < 768; u += G_) {
            const int g_ = u >> 8, rem = u & 255; const int dsh = 2 * g_, d = 1 << dsh, nblk = 16 >> dsh;
            const int n = rem & (nblk - 1), r = (rem >> (4 - dsh)) & (d - 1), bhh = rem >> 4, b_ = bhh >> 2, hg_ = bhh & 3;
            const long row0 = (long)b_ * 2048 + (long)(n * 128) * d + r;
            const bf16_t* qb = QKV + row0 * 4608 + (g_ * 4 + hg_) * 128;
            attn_unit<true>(lds, qb, (long)d * 4608, qb + 1536, (long)d * 4608, qb + 3072, (long)d * 4608, n > 0,
                            OG + (size_t)g_ * (8192 * 512) + row0 * 512 + hg_ * 128, (long)d * 512, LSE + (size_t)g_ * (8192 * 4) + row0 * 4 + hg_, (long)d * 4, tid);
        }
        hg_kv_phase(lds, HGB, LB, ST, DEC, tid, bid_, G_);
      }
    }
    SEAM(2);
    if (IN(3)) {
        const int gt = bid * NTHR + tid, NGT = G * NTHR;
        for (int task = gt; task < 8192 * 64; task += NGT) { const int tok = task >> 6, hg_ = (task >> 4) & 3, c = task & 15;
            const float l0 = LSE[(size_t)tok * 4 + hg_], l1 = LSE[(size_t)(8192 + tok) * 4 + hg_], l2 = LSE[(size_t)(16384 + tok) * 4 + hg_];
            const float mx = fmaxf(l0, fmaxf(l1, l2)); float e0 = __expf(l0 - mx), e1 = __expf(l1 - mx), e2 = __expf(l2 - mx); const float inv = 1.f / (e0 + e1 + e2); e0 *= inv; e1 *= inv; e2 *= inv;
            const size_t off = (size_t)tok * 512 + hg_ * 128 + 8 * c;
            const u32x4 x0 = *(const u32x4*)(OG + off), x1 = *(const u32x4*)(OG + (size_t)8192 * 512 + off), x2 = *(const u32x4*)(OG + (size_t)2 * 8192 * 512 + off);
            u32x4 o;
            o.x = cvt_pk_bf16(e0 * bflo(x0.x) + e1 * bflo(x1.x) + e2 * bflo(x2.x), e0 * bfhi(x0.x) + e1 * bfhi(x1.x) + e2 * bfhi(x2.x));
            o.y = cvt_pk_bf16(e0 * bflo(x0.y) + e1 * bflo(x1.y) + e2 * bflo(x2.y), e0 * bfhi(x0.y) + e1 * bfhi(x1.y) + e2 * bfhi(x2.y));
            o.z = cvt_pk_bf16(e0 * bflo(x0.z) + e1 * bflo(x1.z) + e2 * bflo(x2.z), e0 * bfhi(x0.z) + e1 * bfhi(x1.z) + e2 * bfhi(x2.z));
            o.w = cvt_pk_bf16(e0 * bflo(x0.w) + e1 * bflo(x1.w) + e2 * bflo(x2.w), e0 * bfhi(x0.w) + e1 * bfhi(x1.w) + e2 * bfhi(x2.w));
            *(u32x4*)(OCAT + (size_t)tok * 1536 + hg_ * 128 + 8 * c) = o; }
        for (int task = gt; task < 32 * 4096; task += NGT) { const int bh = task >> 12, e4 = task & 4095;
            f32x4 S_ = {0.f, 0.f, 0.f, 0.f};
            const bf16_t* sp = ST + (size_t)bh * 32 * 16384 + 4 * e4; const float* dp = DEC + (size_t)bh * 32 * 128 + ((4 * e4) & 127); bf16_t* op = STB + (size_t)bh * 32 * 16384 + 4 * e4;
#pragma unroll 8
            for (int n = 0; n < 32; ++n) { const u32x2 kw = *(const u32x2*)(sp + (size_t)n * 16384); const f32x4 kv = {bflo(kw.x), bfhi(kw.x), bflo(kw.y), bfhi(kw.y)}; const f32x4 dc = *(const f32x4*)(dp + n * 128);
                u32x2 wv; wv.x = cvt_pk_bf16(S_[0], S_[1]); wv.y = cvt_pk_bf16(S_[2], S_[3]); *(u32x2*)(op + (size_t)n * 16384) = wv; S_ = dc * S_ + kv; } }
    }
    SEAM(3);
    if (IN(4)) REPLOOP(4) {
      if (bid < NGEM || NGEM == 0) {
        pg8::DeferOrder S{(const bf16_t*)(ws + WS_HN), (const bf16_t*)(ws + WS_WIN), 2048, bid, 80, NGEM ? NGEM : G}; pg8::EpiProj E{QKV, HGB, GATES, KVC};
        pg8::gemm_phase2<pg8::EpiProj, pg8::DeferOrder>(lds, S, E, PART, FLAGS, 2u * 2048u); __syncthreads();
      }
      if (bid >= NGEM) hg_out_phase(lds, HGB, LB, a.in[4], STB, OCAT, tid, bid - NGEM, G - NGEM);
    }
    SEAM(4);
    if (IN(5)) REPLOOP(5) {
        pg8::ChainOrder S{OCAT, (const bf16_t*)(ws + WS_WA), 1536, 8, MTOK / 256, 2048 / 256, G, bid};
        pg8::EpiMerge E{GATES, MERGED};
        pg8::gemm_phase2<pg8::EpiMerge, pg8::ChainOrder>(lds, S, E, nullptr, nullptr, 2u * 1536u);
    }
    SEAM(5);
    if (IN(6)) { pg8::SplitOrder S; S.init(MERGED, (const bf16_t*)(ws + WS_WOUT), MTOK, 2048, 2048, 0, G, bid); pg8::EpiRes<false> E{a.in[0], XB, sumsq};
        pg8::gemm_phase2<pg8::EpiRes<false>, pg8::SplitOrder>(lds, S, E, PART, FLAGS, 2u * 2048u); }
    SEAM(6);
    if (IN(8)) REPLOOP(8) {
        for (int u = bid; u < 256; u += G) { const int b_ = u >> 6, h = (u >> 4) & 3, qb = u & 15; const size_t r0 = (size_t)(b_ * 2048 + qb * 128);
            const bf16_t* kb = KVC + (size_t)(b_ * 256 + 128) * 1024 + h * 128;
            bf16x8 qf[4]; cross_q_tile(lds, XB + r0 * 2048, (const bf16_t*)(ws + WS_WQ) + (size_t)(h * 128) * 2048, sumsq + r0, tid, qf);
            attn_unit<false, true>(lds, nullptr, 512, kb, 1024, kb + 512, 1024, true, OC + r0 * 512 + h * 128, 512, nullptr, 0, tid, qf); }
    }
    SEAM(8);
    if (IN(9)) { pg8::SplitOrder S; S.init(OC, (const bf16_t*)(ws + WS_WO), MTOK, 2048, 512, 0, G, bid); pg8::EpiRes<true> E{XB, XB, sumsq + 8192};
        pg8::gemm_phase2<pg8::EpiRes<true>, pg8::SplitOrder>(lds, S, E, PART, FLAGS, 2u * 512u); }
    SEAM(9);
    if (IN(10)) REPLOOP(10) { pg8::SplitOrder S; S.init(XB, (const bf16_t*)(ws + WS_W13), MTOK, 2 * DFF_, 2048, 0, G, bid); pg8::EpiSwiGLU E{sumsq + 8192, GB};
        pg8::gemm_phase2<pg8::EpiSwiGLU, pg8::SplitOrder>(lds, S, E, PART, FLAGS + 4096, 2u * 2048u); }
    SEAM(10);
    if (IN(11)) { pg8::SplitOrder S; S.init(GB, (const bf16_t*)(ws + WS_W2), MTOK, 2048, DFF_, 0, G, bid); pg8::EpiFinal E{XB, a.out, sumsq + 16384, a.in[18], FLAGS};
        pg8::gemm_phase2<pg8::EpiFinal, pg8::SplitOrder>(lds, S, E, PART, FLAGS, 2u * 5632u); }
#undef IN
#undef SEAM
}

#ifndef N_LAUNCH_MODE
#define N_LAUNCH_MODE 1
#endif
extern "C" void kernel_launch(void* const* d_in, const int* in_sizes, int n_in, void* d_out, int out_size, void* d_ws, size_t ws_size, hipStream_t stream) {
    static int grid = 0;
    if (grid == 0) {
        if (n_in != 19 || out_size != MTOK * DMODEL || ws_size < WS_END) { fprintf(stderr, "kernel_launch: unexpected problem (n_in %d out %d ws %zu)\n", n_in, out_size, ws_size); grid = -1; return; }
        int dev = 0, cus = 0, per_cu = 0;
        hipGetDevice(&dev); hipDeviceGetAttribute(&cus, hipDeviceAttributeMultiprocessorCount, dev);
        if (hipFuncSetAttribute((const void*)fwd_kernel, hipFuncAttributeMaxDynamicSharedMemorySize, LDS_BYTES) != hipSuccess) { fprintf(stderr, "kernel_launch: hipFuncSetAttribute failed\n"); grid = -1; return; }
        if (hipOccupancyMaxActiveBlocksPerMultiprocessor(&per_cu, (const void*)fwd_kernel, NTHR, LDS_BYTES) != hipSuccess || per_cu < 1) { fprintf(stderr, "kernel_launch: occupancy query gave %d\n", per_cu); per_cu = 1; }
        (void)hipGetLastError();
        grid = cus * 1;
        fprintf(stderr, "kernel_launch: grid %d (cus %d, per_cu %d)\n", grid, cus, per_cu);
    }
    if (grid < 0) return;
    if (hipMemsetAsync((char*)d_ws + WS_BAR, 0, BAR_BYTES, stream) != hipSuccess) { fprintf(stderr, "kernel_launch: memset failed\n"); return; }
    Args a{};
    for (int i = 0; i < 19; ++i) a.in[i] = (const float*)d_in[i];
    a.out = (float*)d_out; a.ws = (unsigned char*)d_ws;
#if N_LAUNCH_MODE == 1
    a.ph_lo = 0; a.ph_hi = NPHASE;
    void* args[] = {&a};
    hipError_t e = hipLaunchCooperativeKernel((const void*)fwd_kernel, dim3(grid), dim3(NTHR), args, LDS_BYTES, stream);
    if (e != hipSuccess) fprintf(stderr, "kernel_launch: cooperative launch failed: %s (grid %d)\n", hipGetErrorString(e), grid);
#else
    for (int p = 0; p < NPHASE; ++p) { a.ph_lo = p; a.ph_hi = p + 1; hipLaunchKernelGGL(fwd_kernel, dim3(grid), dim3(NTHR), LDS_BYTES, stream, a); }
#endif
}
```

```cpp
#include <hip/hip_runtime.h>
#include <hip/hip_cooperative_groups.h>
#include <cstdio>
#include <cstdint>
#include <cmath>
namespace cg = cooperative_groups;
namespace pg8 {
#define PG8_LAS __attribute__((address_space(3)))
typedef unsigned short bf16_t;
typedef short bf16x8 __attribute__((ext_vector_type(8)));
typedef float f32x4 __attribute__((ext_vector_type(4)));
typedef unsigned u32x4 __attribute__((ext_vector_type(4)));
constexpr int BM = 256, BK = 64, HALF = 128, HTB = HALF * BK * 2  , STAGE_BYTES = 8 * HTB, NXCD = 8, WGM = 8;

__host__ __device__ __forceinline__ int lds_byte(int r, int c) { const int st = (r >> 4) * 2 + (c >> 5), rr = r & 15, cc = c & 31, ob = rr * 64 + cc * 2; return st * 1024 + (ob ^ (((ob >> 9) & 1) << 5)); }
__host__ __device__ __forceinline__ void stage_rc(int b, int& R, int& C) { const int st = b / 1024, sb = b % 1024, swz = sb ^ (((sb >> 9) & 1) << 5); R = (st >> 1) * 16 + swz / 64; C = (st & 1) * 32 + (swz % 64) / 2; }
__host__ __device__ __forceinline__ int perm32(int rho) { const int n = rho >> 4, i = rho & 15; return 8 * (i >> 2) + 4 * n + (i & 3); }

struct Unit { int pm, pn; };
struct Gemm { const bf16_t* A; const bf16_t* Bt; int M, N, K; };

struct StaticOrder {
    int nM, nN, nwg, G, c;
    __host__ __device__ void init(int M, int N, int G_, int c_) { nM = M / BM; nN = N / BM; nwg = nM * nN; G = G_; c = c_; }
    __host__ __device__ bool next(int i, Unit& u) const {
        const long L = (long)i * G + c; if (L >= nwg) return false;
        int wgid = (int)L; { const int q = nwg / NXCD, r = nwg % NXCD, xcd = wgid % NXCD, off = wgid / NXCD; wgid = (xcd < r ? xcd * (q + 1) : r * (q + 1) + (xcd - r) * q) + off; }
        const int nig = WGM * nN, gid = wgid / nig, fm = gid * WGM, gsz = (nM - fm) < WGM ? (nM - fm) : WGM;
        u.pm = fm + ((wgid % nig) % gsz); u.pn = (wgid % nig) / gsz; return true;
    }
    __device__ __forceinline__ void a_ready(const Unit&) const {}
    __device__ __forceinline__ void done(const Unit&) const {}
};

__device__ __forceinline__ unsigned cvt_pk_bf16(float lo, float hi) { unsigned r; asm volatile("v_cvt_pk_bf16_f32 %0, %1, %2" : "=v"(r) : "v"(lo), "v"(hi)); return r; }
typedef float f32x2 __attribute__((ext_vector_type(2)));
typedef unsigned u32x2 __attribute__((ext_vector_type(2)));
__device__ __forceinline__ float sigm(float x) { return __builtin_amdgcn_rcpf(1.f + __expf(-x)); }
__device__ __forceinline__ float silu(float x) { return x * sigm(x); }
__device__ __forceinline__ float bflo(unsigned w) { return __uint_as_float(w << 16); }
__device__ __forceinline__ float bfhi(unsigned w) { return __uint_as_float(w & 0xffff0000u); }
constexpr float RMS_EPS_ = 1e-6f;

struct Order1 {
    StaticOrder so; int nmain;
    __host__ __device__ void init(int G_, int c_) { so.init(8192, 12800, G_, c_); nmain = so.nwg; }
    __host__ __device__ bool next(int i, Unit& u) const {
        const long L = (long)i * so.G + so.c;
        if (L < nmain) return so.next(i, u);
        const int e = (int)(L - nmain); if (e >= 16) return false;
        u.pm = 32 + (e >> 2); u.pn = 50 + (e & 3); return true;
    }
    __device__ __forceinline__ void a_ready(const Unit&) const {}
    __device__ __forceinline__ void done(const Unit&) const {}
};

struct EpiProj {
    static constexpr bool PERM = true, AFTER_DRAIN = false;
    bf16_t* qkv; bf16_t* hg; bf16_t* gates; bf16_t* kvc;
    __device__ __forceinline__ void operator()(const f32x4 (&acc)[2][2][4][2], const Unit& u, int wr, int wc, int fr, int fq) const {
        const int pn = u.pn; bf16_t* base; int ldc, colt, act, rowt = u.pm * BM;
        if (pn < 18) { base = qkv; ldc = 4608; colt = pn * 256; act = 0; }
        else if (pn < 34) { base = hg; ldc = 4096; colt = (pn - 18) * 256; const int s = (pn - 18) >> 2; act = (s == 0 || s == 3) ? 1 : 0; }
        else if (pn < 50) { base = gates; ldc = 4096; colt = (pn - 34) * 256; act = 2; }
        else { base = kvc; ldc = 1024; colt = (pn - 50) * 256; act = 0; rowt -= 8192; }
        const int row0 = rowt + wr * 64 + fr, col0 = colt + wc * 32 + 8 * fq;
#pragma unroll
        for (int ai = 0; ai < 2; ++ai)
#pragma unroll
            for (int m = 0; m < 4; ++m) { bf16_t* rowp = base + (size_t)(row0 + ai * HALF + m * 16) * ldc + col0;
#pragma unroll
                for (int bj = 0; bj < 2; ++bj) { f32x4 v0 = acc[ai][bj][m][0], v1 = acc[ai][bj][m][1];
                    if (act == 1) {
#pragma unroll
                        for (int e = 0; e < 4; ++e) { v0[e] = silu(v0[e]); v1[e] = silu(v1[e]); } }
                    else if (act == 2) {
#pragma unroll
                        for (int e = 0; e < 4; ++e) { v0[e] = sigm(v0[e]); v1[e] = sigm(v1[e]); } }
                    u32x4 w; w.x = cvt_pk_bf16(v0[0], v0[1]); w.y = cvt_pk_bf16(v0[2], v0[3]); w.z = cvt_pk_bf16(v1[0], v1[1]); w.w = cvt_pk_bf16(v1[2], v1[3]);
                    *(u32x4*)(rowp + bj * HALF) = w; } }
    }
};

struct EpiGateA {
    static constexpr bool PERM = true, AFTER_DRAIN = false;
    const bf16_t* gates; float* tmp;
    __device__ __forceinline__ void operator()(const f32x4 (&acc)[2][2][4][2], const Unit& u, int wr, int wc, int fr, int fq) const {
        const int row0 = u.pm * BM + wr * 64 + fr, col0 = u.pn * BM + wc * 32 + 8 * fq;
#pragma unroll
        for (int ai = 0; ai < 2; ++ai)
#pragma unroll
            for (int m = 0; m < 4; ++m) { const size_t r = (size_t)(row0 + ai * HALF + m * 16);
#pragma unroll
                for (int bj = 0; bj < 2; ++bj) { const int c = col0 + bj * HALF; const u32x4 g = *(const u32x4*)(gates + r * 4096 + c);
                    f32x4 o0 = acc[ai][bj][m][0], o1 = acc[ai][bj][m][1];
                    o0[0] *= bflo(g.x); o0[1] *= bfhi(g.x); o0[2] *= bflo(g.y); o0[3] *= bfhi(g.y); o1[0] *= bflo(g.z); o1[1] *= bfhi(g.z); o1[2] *= bflo(g.w); o1[3] *= bfhi(g.w);
                    *(f32x4*)(tmp + r * 2048 + c) = o0; *(f32x4*)(tmp + r * 2048 + c + 4) = o1; } }
    }
};
struct EpiGateB {
    static constexpr bool PERM = true, AFTER_DRAIN = false;
    const bf16_t* gates; const float* tmp; bf16_t* out;
    __device__ __forceinline__ void operator()(const f32x4 (&acc)[2][2][4][2], const Unit& u, int wr, int wc, int fr, int fq) const {
        const int row0 = u.pm * BM + wr * 64 + fr, col0 = u.pn * BM + wc * 32 + 8 * fq;
#pragma unroll
        for (int ai = 0; ai < 2; ++ai)
#pragma unroll
            for (int m = 0; m < 4; ++m) { const size_t r = (size_t)(row0 + ai * HALF + m * 16);
#pragma unroll
                for (int bj = 0; bj < 2; ++bj) { const int c = col0 + bj * HALF; const u32x4 g = *(const u32x4*)(gates + r * 4096 + c);
                    f32x4 o0 = *(const f32x4*)(tmp + r * 2048 + c), o1 = *(const f32x4*)(tmp + r * 2048 + c + 4); const f32x4 a0 = acc[ai][bj][m][0], a1 = acc[ai][bj][m][1];
                    o0[0] += a0[0] * bflo(g.x); o0[1] += a0[1] * bfhi(g.x); o0[2] += a0[2] * bflo(g.y); o0[3] += a0[3] * bfhi(g.y);
                    o1[0] += a1[0] * bflo(g.z); o1[1] += a1[1] * bfhi(g.z); o1[2] += a1[2] * bflo(g.w); o1[3] += a1[3] * bfhi(g.w);
                    u32x4 w; w.x = cvt_pk_bf16(o0[0], o0[1]); w.y = cvt_pk_bf16(o0[2], o0[3]); w.z = cvt_pk_bf16(o1[0], o1[1]); w.w = cvt_pk_bf16(o1[2], o1[3]);
                    *(u32x4*)(out + r * 2048 + c) = w; } }
    }
};
template <bool RES_BF16> struct EpiRes {
    static constexpr bool PERM = true, AFTER_DRAIN = false;
    const void* resid; bf16_t* outb; float* sumsq;
    __device__ __forceinline__ void operator()(const f32x4 (&acc)[2][2][4][2], const Unit& u, int wr, int wc, int fr, int fq) const {
        const int row0 = u.pm * BM + wr * 64 + fr, col0 = u.pn * BM + wc * 32 + 8 * fq;
#pragma unroll
        for (int ai = 0; ai < 2; ++ai)
#pragma unroll
            for (int m = 0; m < 4; ++m) { const size_t r = (size_t)(row0 + ai * HALF + m * 16); float ss = 0.f;
#pragma unroll
                for (int bj = 0; bj < 2; ++bj) { const int c = col0 + bj * HALF; f32x4 o0, o1;
                    if (RES_BF16) { const u32x4 g = *(const u32x4*)((const bf16_t*)resid + r * 2048 + c);
                        o0 = (f32x4){bflo(g.x), bfhi(g.x), bflo(g.y), bfhi(g.y)} + acc[ai][bj][m][0]; o1 = (f32x4){bflo(g.z), bfhi(g.z), bflo(g.w), bfhi(g.w)} + acc[ai][bj][m][1]; }
                    else { o0 = *(const f32x4*)((const float*)resid + r * 2048 + c) + acc[ai][bj][m][0]; o1 = *(const f32x4*)((const float*)resid + r * 2048 + c + 4) + acc[ai][bj][m][1]; }
                    ss += (o0[0] * o0[0] + o0[1] * o0[1]) + (o0[2] * o0[2] + o0[3] * o0[3]) + (o1[0] * o1[0] + o1[1] * o1[1]) + (o1[2] * o1[2] + o1[3] * o1[3]);
                    u32x4 w; w.x = cvt_pk_bf16(o0[0], o0[1]); w.y = cvt_pk_bf16(o0[2], o0[3]); w.z = cvt_pk_bf16(o1[0], o1[1]); w.w = cvt_pk_bf16(o1[2], o1[3]); *(u32x4*)(outb + r * 2048 + c) = w; }
                ss += __shfl_xor(ss, 16); ss += __shfl_xor(ss, 32);
                if (fq == 0) atomicAdd(sumsq + r, ss); }
    }
};
struct EpiQ {
    static constexpr bool PERM = true, AFTER_DRAIN = false;
    const float* sumsq; bf16_t* out; float scale;
    __device__ __forceinline__ void operator()(const f32x4 (&acc)[2][2][4][2], const Unit& u, int wr, int wc, int fr, int fq) const {
        const int row0 = u.pm * BM + wr * 64 + fr, col0 = u.pn * BM + wc * 32 + 8 * fq;
#pragma unroll
        for (int ai = 0; ai < 2; ++ai)
#pragma unroll
            for (int m = 0; m < 4; ++m) { const size_t r = (size_t)(row0 + ai * HALF + m * 16); const float rs = rsqrtf(sumsq[r] * (1.f / 2048.f) + RMS_EPS_) * scale;
#pragma unroll
                for (int bj = 0; bj < 2; ++bj) { const int c = col0 + bj * HALF; const f32x4 v0 = acc[ai][bj][m][0] * rs, v1 = acc[ai][bj][m][1] * rs;
                    u32x4 w; w.x = cvt_pk_bf16(v0[0], v0[1]); w.y = cvt_pk_bf16(v0[2], v0[3]); w.z = cvt_pk_bf16(v1[0], v1[1]); w.w = cvt_pk_bf16(v1[2], v1[3]);
                    *(u32x4*)(out + r * 512 + c) = w; } }
    }
};
struct EpiSwiGLU {
    static constexpr bool PERM = true, AFTER_DRAIN = false;
    const float* sumsq; bf16_t* out;
    __device__ __forceinline__ void operator()(const f32x4 (&acc)[2][2][4][2], const Unit& u, int wr, int wc, int fr, int fq) const {
        const int row0 = u.pm * BM + wr * 64 + fr, col0 = u.pn * HALF + wc * 32 + 8 * fq;
#pragma unroll
        for (int ai = 0; ai < 2; ++ai)
#pragma unroll
            for (int m = 0; m < 4; ++m) { const size_t r = (size_t)(row0 + ai * HALF + m * 16); const float rs = rsqrtf(sumsq[r] * (1.f / 2048.f) + RMS_EPS_);
                float g[8];
#pragma unroll
                for (int n = 0; n < 2; ++n)
#pragma unroll
                    for (int e = 0; e < 4; ++e) g[4 * n + e] = silu(acc[ai][0][m][n][e] * rs) * (acc[ai][1][m][n][e] * rs);
                u32x4 w; w.x = cvt_pk_bf16(g[0], g[1]); w.y = cvt_pk_bf16(g[2], g[3]); w.z = cvt_pk_bf16(g[4], g[5]); w.w = cvt_pk_bf16(g[6], g[7]);
                *(u32x4*)(out + r * 5632 + col0) = w; }
    }
};
struct Unit2 : Unit { const char* A; const char* B; int nt; int mode, slot, aux, pstr; };
__device__ __forceinline__ void part_store(const f32x4 (&acc)[2][2][4][2], float* part, unsigned* flags, const Unit2& u, int tid, int lane) {
    float* p = part + ((size_t)(u.slot * u.pstr + u.aux) * 32) * 2048 + (size_t)tid * 4;
#pragma unroll
    for (int ai = 0; ai < 2; ++ai)
#pragma unroll
        for (int bj = 0; bj < 2; ++bj)
#pragma unroll
            for (int m = 0; m < 4; ++m)
#pragma unroll
                for (int n = 0; n < 2; ++n) *(f32x4*)(p + (size_t)(((ai * 2 + bj) * 4 + m) * 2 + n) * 2048) = acc[ai][bj][m][n];
    __builtin_amdgcn_fence(__ATOMIC_RELEASE, "agent");
    asm volatile("s_waitcnt vmcnt(0)" ::: "memory");
    if (lane == 0) __hip_atomic_fetch_add(flags + 16 * u.slot, 1u, __ATOMIC_RELAXED, __HIP_MEMORY_SCOPE_AGENT);
}
__device__ __forceinline__ void part_wait_add(f32x4 (&acc)[2][2][4][2], const float* part, unsigned* flags, const Unit2& u, int tid, int lane) {
    const int np = (u.mode == 2) ? u.aux : 0;
    if (np > 0) { const unsigned want = 8u * (unsigned)np; unsigned spins = 0;
        for (;;) { unsigned v = 0; if (lane == 0) v = __hip_atomic_load(flags + 16 * u.slot, __ATOMIC_RELAXED, __HIP_MEMORY_SCOPE_AGENT);
            if ((unsigned)__builtin_amdgcn_readfirstlane(v) >= want) break;
            __builtin_amdgcn_s_sleep(1); if (++spins > (1u << 20)) break; }
        __builtin_amdgcn_fence(__ATOMIC_ACQUIRE, "agent"); }
    for (int pi = 0; pi < np; ++pi) { const float* p = part + ((size_t)(u.slot * u.pstr + pi) * 32) * 2048 + (size_t)tid * 4;
#pragma unroll
        for (int ai = 0; ai < 2; ++ai)
#pragma unroll
            for (int bj = 0; bj < 2; ++bj) {
#pragma unroll
                for (int m = 0; m < 4; ++m)
#pragma unroll
                    for (int n = 0; n < 2; ++n) acc[ai][bj][m][n] += *(const f32x4*)(p + (size_t)(((ai * 2 + bj) * 4 + m) * 2 + n) * 2048);
                asm volatile("" ::: "memory"); } }
}

template <class Epi, class Sched>
__device__ __forceinline__ void gemm_phase2(PG8_LAS unsigned char* lds, const Sched& S, const Epi& E, float* part, unsigned* flags, const unsigned ld2  ) {
    const int tid = threadIdx.x, wid = __builtin_amdgcn_readfirstlane(tid >> 6), lane = tid & 63, wr = wid >> 2, wc = wid & 3, fr = lane & 15, fq = lane >> 4;
    unsigned voffA[2], voffB[2];
#pragma unroll
    for (int i = 0; i < 2; ++i) { int R, C; stage_rc(tid * 16 + i * 8192, R, C); const int Rb = Epi::PERM ? ((R & ~31) + perm32(R & 31)) : R;
        voffA[i] = (unsigned)R * ld2 + (unsigned)C * 2u; voffB[i] = (unsigned)Rb * ld2 + (unsigned)C * 2u; }
    const size_t kstep = (size_t)(BK * 2);
    const size_t hs = (size_t)HALF * ld2;
    const unsigned ldsw = (unsigned)wid * 1024u;
    const int aoff = lds_byte(wr * 64 + fr, fq * 8), boff = lds_byte(wc * 32 + fr, fq * 8);
#define PG8_SA(b, h) (((b) * 2 + (h)) * HTB)
#define PG8_SB(b, h) ((4 + (b) * 2 + (h)) * HTB)
#define PG8_STAGE(bufoff, gbase, voff) do { _Pragma("unroll") for (int _i = 0; _i < 2; ++_i) \
        __builtin_amdgcn_global_load_lds((const unsigned*)((const char*)(gbase) + (voff)[_i]), (PG8_LAS unsigned*)(lds + (bufoff) + ldsw + _i * 8192), 16, 0, 0); } while (0)
#define PG8_LDA(dst, b, h) do { _Pragma("unroll") for (int m = 0; m < 4; ++m) _Pragma("unroll") for (int k = 0; k < 2; ++k) dst[m][k] = *(const PG8_LAS bf16x8*)(lds + PG8_SA(b, h) + aoff + m * 2048 + k * 1024); } while (0)
#define PG8_LDB(dst, b, h) do { _Pragma("unroll") for (int n = 0; n < 2; ++n) _Pragma("unroll") for (int k = 0; k < 2; ++k) dst[n][k] = *(const PG8_LAS bf16x8*)(lds + PG8_SB(b, h) + boff + n * 2048 + k * 1024); } while (0)
#define PG8_MMA(ai, bj, At, Bt) do { __builtin_amdgcn_s_setprio(1); _Pragma("unroll") for (int m = 0; m < 4; ++m) _Pragma("unroll") for (int n = 0; n < 2; ++n) _Pragma("unroll") for (int k = 0; k < 2; ++k) \
        acc[ai][bj][m][n] = __builtin_amdgcn_mfma_f32_16x16x32_bf16(Bt[n][k], At[m][k], acc[ai][bj][m][n], 0, 0, 0); __builtin_amdgcn_s_setprio(0); } while (0)
#define PG8_WAIT_V(n) asm volatile("s_waitcnt vmcnt(" #n ")" ::: "memory")
#define PG8_WAIT_L(n) asm volatile("s_waitcnt lgkmcnt(" #n ")" ::: "memory")
#define PG8_BAR __builtin_amdgcn_s_barrier()
#define PG8_SCHED __builtin_amdgcn_sched_barrier(0)
    Unit2 cur, nxt; int ui = 0;
    if (!S.next(0, cur)) return;
    f32x4 acc[2][2][4][2];
#pragma unroll
    for (int a = 0; a < 2; ++a)
#pragma unroll
        for (int b = 0; b < 2; ++b)
#pragma unroll
            for (int m = 0; m < 4; ++m)
#pragma unroll
                for (int n = 0; n < 2; ++n) acc[a][b][m][n] = (f32x4){0.f, 0.f, 0.f, 0.f};
    bf16x8 At[4][2], B0[2][2], B1[2][2];
    const char* cA = cur.A; const char* cB = cur.B;
    {
        PG8_STAGE(PG8_SB(0, 0), cB, voffB); PG8_STAGE(PG8_SB(0, 1), cB + hs, voffB); PG8_STAGE(PG8_SA(0, 0), cA, voffA); PG8_STAGE(PG8_SA(0, 1), cA + hs, voffA);
        if (wr == 1) PG8_BAR;
        PG8_WAIT_V(2); PG8_BAR;
        PG8_STAGE(PG8_SB(1, 0), cB + kstep, voffB); PG8_STAGE(PG8_SA(1, 0), cA + kstep, voffA); PG8_STAGE(PG8_SB(1, 1), cB + hs + kstep, voffB);
        PG8_WAIT_V(6); PG8_BAR;
    }
    for (;;) {
        const bool has_next = S.next(ui + 1, nxt);
        const char* nA = has_next ? nxt.A : cA; const char* nB = has_next ? nxt.B : cB;
        const int nt = cur.nt;
        for (int t = 0; t < nt; t += 2) {
            const bool last = (t == nt - 2);
            const char* a1 = cA + (size_t)(t + 1) * kstep;
            const char* a2 = last ? nA : cA + (size_t)(t + 2) * kstep; const char* b2 = last ? nB : cB + (size_t)(t + 2) * kstep;
            const char* a3 = a2 + kstep; const char* b3 = b2 + kstep;
            PG8_LDB(B0, 0, 0); PG8_LDB(B1, 0, 1); PG8_SCHED; PG8_LDA(At, 0, 0); PG8_STAGE(PG8_SA(1, 1), a1 + hs, voffA);
            PG8_WAIT_V(8); PG8_WAIT_L(0); PG8_BAR; PG8_MMA(0, 0, At, B0); PG8_MMA(0, 1, At, B1); PG8_BAR; PG8_SCHED;
            PG8_LDA(At, 0, 1); PG8_STAGE(PG8_SB(0, 0), b2, voffB); PG8_STAGE(PG8_SB(0, 1), b2 + hs, voffB); PG8_STAGE(PG8_SA(0, 0), a2, voffA);
            PG8_WAIT_V(8); PG8_WAIT_L(0); PG8_BAR; PG8_MMA(1, 0, At, B0); PG8_MMA(1, 1, At, B1); PG8_BAR; PG8_SCHED;
            PG8_LDB(B0, 1, 0); PG8_LDB(B1, 1, 1); PG8_SCHED; PG8_LDA(At, 1, 0); PG8_STAGE(PG8_SA(0, 1), a2 + hs, voffA);
            PG8_WAIT_V(8); PG8_WAIT_L(0); PG8_BAR; PG8_MMA(0, 0, At, B0); PG8_MMA(0, 1, At, B1); PG8_BAR; PG8_SCHED;
            PG8_LDA(At, 1, 1); PG8_STAGE(PG8_SB(1, 0), b3, voffB); PG8_STAGE(PG8_SB(1, 1), b3 + hs, voffB); PG8_STAGE(PG8_SA(1, 0), a3, voffA);
            PG8_WAIT_V(8); PG8_WAIT_L(0); PG8_BAR; PG8_MMA(1, 0, At, B0); PG8_MMA(1, 1, At, B1); PG8_BAR; PG8_SCHED;
        }
        if (wr == 0) PG8_BAR;
        {
            int tid_ = tid, lane_ = lane, fr_ = fr, fq_ = fq; asm volatile("" : "+v"(tid_), "+v"(lane_), "+v"(fr_), "+v"(fq_));
            E(acc, cur, wr, wc, fr_, fq_); }
        if (!has_next) break;
        if (cur.mode != 3) {
#pragma unroll
            for (int a = 0; a < 2; ++a)
#pragma unroll
                for (int b = 0; b < 2; ++b)
#pragma unroll
                    for (int m = 0; m < 4; ++m)
#pragma unroll
                        for (int n = 0; n < 2; ++n) acc[a][b][m][n] = (f32x4){0.f, 0.f, 0.f, 0.f};
        }
        cur = nxt; cA = nA; cB = nB; ++ui;
        if (wr == 1) PG8_BAR;
    }
    PG8_WAIT_V(0);
    PG8_BAR;
#undef PG8_SA
#undef PG8_SB
#undef PG8_STAGE
#undef PG8_LDA
#undef PG8_LDB
#undef PG8_MMA
#undef PG8_WAIT_V
#undef PG8_WAIT_L
#undef PG8_BAR
#undef PG8_SCHED
}

__device__ __forceinline__ void unit_of(int L, int nM, int nN, int& pm, int& pn) {
    const int nwg = nM * nN;
    if (L >= nwg) { const int e = L - nwg; pm = nM + (e >> 2); pn = nN + (e & 3); return; }
    int wgid = L; { const int q = nwg / NXCD, r = nwg % NXCD, xcd = wgid % NXCD, off = wgid / NXCD; wgid = (xcd < r ? xcd * (q + 1) : r * (q + 1) + (xcd - r) * q) + off; }
    const int nig = WGM * nN, gid = wgid / nig, fm = gid * WGM, gsz = (nM - fm) < WGM ? (nM - fm) : WGM;
    pm = fm + ((wgid % nig) % gsz); pn = (wgid % nig) / gsz;
}
struct SplitOrder {
    const bf16_t* A; const bf16_t* B; int K, nM, nN, U, G, c, nfull, tail, ways;
    __device__ __forceinline__ void init(const bf16_t* A_, const bf16_t* B_, int M, int N, int K_, int nextra, int G_, int c_) {
        A = A_; B = B_; K = K_; nM = M / BM; nN = N / BM; U = nM * nN + nextra; G = G_; c = c_; nfull = U / G; tail = U - nfull * G;
        ways = 1;
    }
    __device__ __forceinline__ bool next(int i, Unit2& u) const {
        int L, kt0 = 0, ntu = K / BK; u.mode = 0; u.slot = 0; u.aux = 0; u.pstr = ways - 1;
        if (i < nfull) L = i * G + c;
        else if (i == nfull && c < tail * ways) { const int j = c % tail, p = c / tail; L = nfull * G + j;
            if (ways > 1) { ntu = (K / BK) / ways; kt0 = p * ntu; u.mode = (p == 0) ? 2 : 1; u.slot = j; u.aux = (p == 0) ? ways - 1 : p - 1; } }
        else return false;
        unit_of(L, nM, nN, u.pm, u.pn);
        u.A = (const char*)(A + (size_t)u.pm * BM * K + (size_t)kt0 * BK); u.B = (const char*)(B + (size_t)u.pn * BM * K + (size_t)kt0 * BK); u.nt = ntu;
        return true;
    }
};
struct DeferOrder {
    const bf16_t* A; const bf16_t* B; int K, d0, d1, step;
    __device__ __forceinline__ bool next(int i, Unit2& u) const {
        const int d = d0 + i * step; if (d >= d1) return false;
        if (d < 64) { u.pm = d >> 1; u.pn = 48 + (d & 1); } else { const int e = d - 64; u.pm = 32 + (e >> 2); u.pn = 50 + (e & 3); }
        u.mode = 0; u.slot = 0; u.aux = 0; u.pstr = 0; u.nt = K / BK;
        u.A = (const char*)(A + (size_t)u.pm * BM * K); u.B = (const char*)(B + (size_t)u.pn * BM * K);
        return true;
    }
};
struct ChainOrder {
    const bf16_t *A, *B; int K, nt1, nM, nN, G, c;
    __device__ __forceinline__ bool next(int i, Unit2& u) const {
        const int L = (i >> 1) * G + c; if (L >= nM * nN) return false;
        unit_of(L, nM, nN, u.pm, u.pn); u.slot = 0; u.aux = 0; u.pstr = 0;
        const int kt0 = (i & 1) ? nt1 : 0; u.nt = (i & 1) ? K / BK - nt1 : nt1; u.mode = (i & 1) ? 0 : 3;
        u.A = (const char*)(A + (size_t)u.pm * BM * K + (size_t)kt0 * BK); u.B = (const char*)(B + (size_t)u.pn * BM * K + (size_t)kt0 * BK);
        return true;
    }
};
struct EpiFinal {
    static constexpr bool PERM = true, AFTER_DRAIN = false;
    const bf16_t* resid; float* out; float* sumsq; const float* wf; unsigned* cnt;
    __device__ __forceinline__ void operator()(f32x4 (&acc)[2][2][4][2], const Unit2& u, int wr, int wc, int fr, int fq) const {
        const int row0 = u.pm * BM + wr * 64 + fr, col0 = u.pn * BM + wc * 32 + 8 * fq;
#pragma unroll
        for (int ai = 0; ai < 2; ++ai)
#pragma unroll
            for (int m = 0; m < 4; ++m) { const size_t r = (size_t)(row0 + ai * HALF + m * 16); float ss = 0.f;
#pragma unroll
                for (int bj = 0; bj < 2; ++bj) { const int c = col0 + bj * HALF; const u32x4 g = *(const u32x4*)(resid + r * 2048 + c);
                    const f32x4 o0 = (f32x4){bflo(g.x), bfhi(g.x), bflo(g.y), bfhi(g.y)} + acc[ai][bj][m][0], o1 = (f32x4){bflo(g.z), bfhi(g.z), bflo(g.w), bfhi(g.w)} + acc[ai][bj][m][1];
                    acc[ai][bj][m][0] = o0; acc[ai][bj][m][1] = o1;
                    ss += (o0[0] * o0[0] + o0[1] * o0[1]) + (o0[2] * o0[2] + o0[3] * o0[3]) + (o1[0] * o1[0] + o1[1] * o1[1]) + (o1[2] * o1[2] + o1[3] * o1[3]); }
                ss += __shfl_xor(ss, 16); ss += __shfl_xor(ss, 32);
                if (fq == 0) atomicAdd(sumsq + r, ss); }
        asm volatile("s_waitcnt vmcnt(0)" ::: "memory");
        const int lane = fq * 16 + fr;
        if (lane == 0) __hip_atomic_fetch_add(cnt + 16 * u.pm, 1u, __ATOMIC_RELAXED, __HIP_MEMORY_SCOPE_AGENT);
        { unsigned spins = 0;
          for (;;) { unsigned v = 0; if (lane == 0) v = __hip_atomic_load(cnt + 16 * u.pm, __ATOMIC_RELAXED, __HIP_MEMORY_SCOPE_AGENT);
              if ((unsigned)__builtin_amdgcn_readfirstlane(v) >= 64u) break;
              __builtin_amdgcn_s_sleep(2); if (++spins > (1u << 20)) break; } }
#pragma unroll
        for (int ai = 0; ai < 2; ++ai)
#pragma unroll
            for (int m = 0; m < 4; ++m) { const size_t r = (size_t)(row0 + ai * HALF + m * 16);
                const float rs = rsqrtf(__hip_atomic_load(sumsq + r, __ATOMIC_RELAXED, __HIP_MEMORY_SCOPE_AGENT) * (1.f / 2048.f) + RMS_EPS_);
#pragma unroll
                for (int bj = 0; bj < 2; ++bj) { const int c = col0 + bj * HALF; const f32x4 w0 = *(const f32x4*)(wf + c), w1 = *(const f32x4*)(wf + c + 4);
                    *(f32x4*)(out + r * 2048 + c) = acc[ai][bj][m][0] * rs * w0; *(f32x4*)(out + r * 2048 + c + 4) = acc[ai][bj][m][1] * rs * w1; } }
    }
};
struct EpiMerge {
    static constexpr bool PERM = true, AFTER_DRAIN = false;
    const bf16_t* gates; bf16_t* out;
    __device__ __forceinline__ void operator()(f32x4 (&acc)[2][2][4][2], const Unit2& u, int wr, int wc, int fr, int fq) const {
        const int row0 = u.pm * BM + wr * 64 + fr, col0 = u.pn * BM + wc * 32 + 8 * fq;
#pragma unroll
        for (int ai = 0; ai < 2; ++ai)
#pragma unroll
            for (int m = 0; m < 4; ++m) { const size_t r = (size_t)(row0 + ai * HALF + m * 16);
#pragma unroll
                for (int bj = 0; bj < 2; ++bj) { const int c = col0 + bj * HALF; const u32x4 gb = *(const u32x4*)(gates + r * 4096 + 2048 + c);
                    float b[8] = {bflo(gb.x), bfhi(gb.x), bflo(gb.y), bfhi(gb.y), bflo(gb.z), bfhi(gb.z), bflo(gb.w), bfhi(gb.w)};
                    if (u.mode == 3) { const u32x4 ga = *(const u32x4*)(gates + r * 4096 + c);
                        const float a[8] = {bflo(ga.x), bfhi(ga.x), bflo(ga.y), bfhi(ga.y), bflo(ga.z), bfhi(ga.z), bflo(ga.w), bfhi(ga.w)};
#pragma unroll
                        for (int e = 0; e < 4; ++e) { acc[ai][bj][m][0][e] *= a[e] * __builtin_amdgcn_rcpf(fmaxf(b[e], 1e-30f)); acc[ai][bj][m][1][e] *= a[4 + e] * __builtin_amdgcn_rcpf(fmaxf(b[4 + e], 1e-30f)); } }
                    else { const f32x4 a0 = acc[ai][bj][m][0], a1 = acc[ai][bj][m][1];
                        u32x4 w; w.x = cvt_pk_bf16(a0[0] * b[0], a0[1] * b[1]); w.y = cvt_pk_bf16(a0[2] * b[2], a0[3] * b[3]); w.z = cvt_pk_bf16(a1[0] * b[4], a1[1] * b[5]); w.w = cvt_pk_bf16(a1[2] * b[6], a1[3] * b[7]);
                        *(u32x4*)(out + r * 2048 + c) = w; } } }
    }
};
}
using pg8::bf16_t; using pg8::bf16x8; using pg8::f32x4; using pg8::u32x4; using pg8::u32x2; using pg8::cvt_pk_bf16; using pg8::sigm; using pg8::bflo; using pg8::bfhi;
#define LAS __attribute__((address_space(3)))
constexpr int NTHR = 512;
constexpr int DMODEL = 2048, MTOK = 8192, SEQL = 2048, MMEM = 1024, DFF_ = 5632;
constexpr float EPS = 1e-6f;
constexpr float ATT_SCALE = 0.08838834764831845f;

constexpr size_t MiB = 1u << 20;
constexpr size_t WS_SUMSQ = 0;
constexpr size_t WS_LB = 128 * 1024;
constexpr size_t WS_BAR = 192 * 1024, BAR_BYTES = 48 * 1024, WS_FLAGS = WS_BAR + 16 * 1024;
constexpr size_t WS_LSE = 256 * 1024;
constexpr size_t WS_DEC = 1 * MiB;
constexpr size_t WS_WIN = 2 * MiB, WS_WKV = 52 * MiB, WS_WA = 56 * MiB, WS_WB = 58 * MiB, WS_WOUT = 62 * MiB, WS_WQ = 70 * MiB, WS_WO = 72 * MiB, WS_W13 = 74 * MiB, WS_W2 = 118 * MiB;
constexpr size_t WS_HN = 140 * MiB;
constexpr size_t WS_OG = 140 * MiB;
constexpr size_t WS_OATT = 164 * MiB;
constexpr size_t WS_QC = 164 * MiB;
constexpr size_t WS_OC = 140 * MiB;
constexpr size_t WS_QKV = 176 * MiB;
constexpr size_t WS_OCAT = 176 * MiB;
constexpr size_t WS_XB = 176 * MiB;
constexpr size_t WS_STB = 208 * MiB;
constexpr size_t WS_HG = 248 * MiB;
constexpr size_t WS_TMP = 248 * MiB;
constexpr size_t WS_G = 248 * MiB;
constexpr size_t WS_GATES = 312 * MiB;
constexpr size_t WS_KVC = 376 * MiB;
constexpr size_t WS_OHG = 378 * MiB;
constexpr size_t WS_END = 394 * MiB;

constexpr int LDS_BYTES = 147456, LDS_MISC = 147392;

__device__ __forceinline__ float wave_sum(float v) {
#pragma unroll
    for (int o = 1; o < 64; o <<= 1) v += __shfl_xor(v, o);
    return v;
}
#define LDS_FENCE() asm volatile("s_waitcnt lgkmcnt(0)" ::: "memory")

__device__ __forceinline__ void transpose_item(const float* __restrict__ W, int K, int N, bf16_t* WT, int dst_row0, const float* kscale, LAS float* scr, int k0, int n0, int lane, int dld = 0, int dcol = 0) {
    if (dld == 0) dld = K;
    const int lr = lane >> 4, lc = lane & 15;
    f32x4 v[16];
#pragma unroll
    for (int it = 0; it < 16; ++it) v[it] = __builtin_nontemporal_load((const f32x4*)(W + (size_t)(k0 + it * 4 + lr) * N + n0 + 4 * lc));
    if (kscale) {
#pragma unroll
        for (int it = 0; it < 16; ++it) v[it] = v[it] * kscale[k0 + it * 4 + lr]; }
#pragma unroll
    for (int it = 0; it < 16; ++it) { LAS float* d = scr + (it * 4 + lr) * 65 + 4 * lc; d[0] = v[it][0]; d[1] = v[it][1]; d[2] = v[it][2]; d[3] = v[it][3]; }
    LDS_FENCE();
    const int c = lane & 7;
#pragma unroll
    for (int j = 0; j < 8; ++j) { const int n = (lane >> 3) + 8 * j; const LAS float* s = scr + (8 * c) * 65 + n;
        u32x4 o; o.x = cvt_pk_bf16(s[0], s[65]); o.y = cvt_pk_bf16(s[130], s[195]); o.z = cvt_pk_bf16(s[260], s[325]); o.w = cvt_pk_bf16(s[390], s[455]);
        *(u32x4*)(WT + (size_t)(dst_row0 + n) * dld + dcol + k0 + 8 * c) = o; }
    LDS_FENCE();
}
__device__ __forceinline__ void rms_row_bf16(const float* xrow, const float* w, bf16_t* orow, int lane) {
    f32x4 v[8]; float s = 0.f;
#pragma unroll
    for (int j = 0; j < 8; ++j) { v[j] = __builtin_nontemporal_load(((const f32x4*)xrow) + lane + 64 * j); s += (v[j][0] * v[j][0] + v[j][1] * v[j][1]) + (v[j][2] * v[j][2] + v[j][3] * v[j][3]); }
    const float rstd = rsqrtf(wave_sum(s) * (1.f / 2048.f) + EPS);
#pragma unroll
    for (int j = 0; j < 8; ++j) { const f32x4 ww = ((const f32x4*)w)[lane + 64 * j]; const f32x4 o = v[j] * rstd * ww;
        u32x2 p; p.x = cvt_pk_bf16(o[0], o[1]); p.y = cvt_pk_bf16(o[2], o[3]); ((u32x2*)orow)[lane + 64 * j] = p; }
}

struct Args { const float* in[19]; float* out; unsigned char* ws; int ph_lo, ph_hi; };

__device__ __forceinline__ void phase_prologue(const Args& a, LAS unsigned char* lds, int tid) {
    const int lane = tid & 63, wave = tid >> 6; const int G = gridDim.x;
    LAS float* scr = (LAS float*)(lds + wave * 16896);
    const int gw = blockIdx.x * 8 + wave, NGW = G * 8;
    unsigned char* ws = a.ws;
    const float *w_in = a.in[3], *w_a = a.in[6], *w_b = a.in[7], *w_out = a.in[8], *wq = a.in[11], *wkv = a.in[12], *wo = a.in[13], *w1 = a.in[15], *w3 = a.in[16], *w2 = a.in[17];
    const float *ln_cross = a.in[9], *ln_ffn = a.in[14];
    constexpr int I_IN = 32 * 200, I_KV = 32 * 16, I_A = 8 * 32, I_B = 16 * 32, I_OUT = 32 * 32, I_Q = 32 * 8, I_O = 8 * 32, I_1 = 32 * 88, I_2 = 88 * 32;
    constexpr int NITEMS = I_IN + I_KV + I_A + I_B + I_OUT + I_Q + I_O + 2 * I_1 + I_2;
    for (int it = gw; it < NITEMS; it += NGW) {
        int r = it;
        if (r < I_IN) { transpose_item(w_in, 2048, 12800, (bf16_t*)(ws + WS_WIN), 64 * (r % 200), nullptr, scr, 64 * (r / 200), 64 * (r % 200), lane); continue; } r -= I_IN;
        if (r < I_KV) { transpose_item(wkv, 2048, 1024, (bf16_t*)(ws + WS_WKV), 64 * (r % 16), nullptr, scr, 64 * (r / 16), 64 * (r % 16), lane); continue; } r -= I_KV;
        if (r < I_A) { transpose_item(w_a, 512, 2048, (bf16_t*)(ws + WS_WA), 64 * (r % 32), nullptr, scr, 64 * (r / 32), 64 * (r % 32), lane, 1536, 0); continue; } r -= I_A;
        if (r < I_B) { transpose_item(w_b, 1024, 2048, (bf16_t*)(ws + WS_WA), 64 * (r % 32), nullptr, scr, 64 * (r / 32), 64 * (r % 32), lane, 1536, 512); continue; } r -= I_B;
        if (r < I_OUT) { transpose_item(w_out, 2048, 2048, (bf16_t*)(ws + WS_WOUT), 64 * (r % 32), nullptr, scr, 64 * (r / 32), 64 * (r % 32), lane); continue; } r -= I_OUT;
        if (r < I_Q) { transpose_item(wq, 2048, 512, (bf16_t*)(ws + WS_WQ), 64 * (r % 8), ln_cross, scr, 64 * (r / 8), 64 * (r % 8), lane); continue; } r -= I_Q;
        if (r < I_O) { transpose_item(wo, 512, 2048, (bf16_t*)(ws + WS_WO), 64 * (r % 32), nullptr, scr, 64 * (r / 32), 64 * (r % 32), lane); continue; } r -= I_O;
        if (r < I_1) { const int n0 = 64 * (r % 88); transpose_item(w1, 2048, 5632, (bf16_t*)(ws + WS_W13), 256 * (n0 >> 7) + (n0 & 127), ln_ffn, scr, 64 * (r / 88), n0, lane); continue; } r -= I_1;
        if (r < I_1) { const int n0 = 64 * (r % 88); transpose_item(w3, 2048, 5632, (bf16_t*)(ws + WS_W13), 256 * (n0 >> 7) + 128 + (n0 & 127), ln_ffn, scr, 64 * (r / 88), n0, lane); continue; } r -= I_1;
        transpose_item(w2, 5632, 2048, (bf16_t*)(ws + WS_W2), 64 * (r % 32), nullptr, scr, 64 * (r / 32), 64 * (r % 32), lane);
    }
    bf16_t* hn = (bf16_t*)(ws + WS_HN);
    for (int m = gw; m < MTOK + MMEM; m += NGW) {
        if (m < MTOK) rms_row_bf16(a.in[0] + (size_t)m * 2048, a.in[2], hn + (size_t)m * 2048, lane);
        else rms_row_bf16(a.in[1] + (size_t)(m - MTOK) * 2048, a.in[10], hn + (size_t)m * 2048, lane);
    }
    const int gt = blockIdx.x * NTHR + tid, NGT = G * NTHR;
    float* sumsq = (float*)(ws + WS_SUMSQ);
    for (int i = gt; i < 3 * 8192; i += NGT) sumsq[i] = 0.f;
    float* lb = (float*)(ws + WS_LB); const float* hlb = a.in[5];
    for (int i = gt; i < 1024; i += NGT) lb[i] = 1.f / (1.f + __expf(hlb[1024 + i] - hlb[i]));
}

constexpr int VTS = 132, KSS = 68;
constexpr int ATT_K_OFF = 128 * VTS * 4;
template <bool MASKED, bool QPRE = false>
__device__ __forceinline__ void attn_unit(LAS unsigned char* lds, const bf16_t* Qb, long qs, const bf16_t* Kown, long ks, const bf16_t* Vown, long vs, bool hasprev,
                                          bf16_t* Ob, long os, float* lsep, long lses, int tid, const bf16x8* qpre = nullptr) {
    const int lane = tid & 63, w = tid >> 6, fr = lane & 15, fq = lane >> 4;
    LAS unsigned* VT = (LAS unsigned*)lds; LAS unsigned* KS = (LAS unsigned*)(lds + ATT_K_OFF);
    const int iq = 16 * w + fr;
    u32x4 kx[8], vx[4], vy[4]; bf16x8 qf[4];
#pragma unroll
    for (int it = 0; it < 8; ++it) { const int id = tid + NTHR * it; long r = (id >> 4) - 128; if (!hasprev && r < 0) r = 0; kx[it] = *(const u32x4*)(Kown + r * ks + 8 * (id & 15)); }
#pragma unroll
    for (int it = 0; it < 4; ++it) { const int task = tid + NTHR * it; const int c = task & 15, p = task >> 4;
        long r0 = 2 * p - 128; if (!hasprev && r0 < 0) r0 = 0;
        const bf16_t* src = Vown + r0 * vs + 8 * c; vx[it] = *(const u32x4*)src; vy[it] = *(const u32x4*)(src + vs); }
#pragma unroll
    for (int k4 = 0; k4 < 4; ++k4) { if (QPRE) qf[k4] = qpre[k4]; else qf[k4] = *(const bf16x8*)(Qb + (long)iq * qs + 32 * k4 + 8 * fq); }
    __syncthreads();
#pragma unroll
    for (int it = 0; it < 8; ++it) { const int id = tid + NTHR * it; *(LAS u32x4*)(KS + (id >> 4) * KSS + 4 * (id & 15)) = kx[it]; }
#pragma unroll
    for (int it = 0; it < 4; ++it) { const int task = tid + NTHR * it; const int c = task & 15, p = task >> 4; const u32x4 x = vx[it], y = vy[it];
        LAS unsigned* d = VT + (8 * c) * VTS + ((p + 2 * c) & 127);
        d[0 * VTS] = (x.x & 0xffffu) | (y.x << 16); d[1 * VTS] = (x.x >> 16) | (y.x & 0xffff0000u);
        d[2 * VTS] = (x.y & 0xffffu) | (y.y << 16); d[3 * VTS] = (x.y >> 16) | (y.y & 0xffff0000u);
        d[4 * VTS] = (x.z & 0xffffu) | (y.z << 16); d[5 * VTS] = (x.z >> 16) | (y.z & 0xffff0000u);
        d[6 * VTS] = (x.w & 0xffffu) | (y.w << 16); d[7 * VTS] = (x.w >> 16) | (y.w & 0xffff0000u); }
    __syncthreads();
    constexpr int NT = MASKED ? 10 : 16; const int t0 = MASKED ? w : 0;
    f32x4 s[NT];
    float mx = -INFINITY;
#pragma unroll
    for (int i = 0; i < NT; ++i) { const int t = t0 + i, tc = t < 15 ? t : 15;
        const LAS unsigned* kp = KS + (16 * tc + fr) * KSS + 4 * fq;
        f32x4 acc = {0.f, 0.f, 0.f, 0.f};
#pragma unroll
        for (int k4 = 0; k4 < 4; ++k4) { const bf16x8 kf = __builtin_bit_cast(bf16x8, *(const LAS u32x4*)(kp + 16 * k4)); acc = __builtin_amdgcn_mfma_f32_16x16x32_bf16(kf, qf[k4], acc, 0, 0, 0); }
#pragma unroll
        for (int j = 0; j < 4; ++j) { const int kk = 16 * t + 4 * fq + j; bool ok = (t <= 15);
            if (MASKED) ok = ok && (kk >= iq) && (kk <= iq + 128);
            ok = ok && (hasprev || kk >= 128);
            const float v = ok ? acc[j] * ATT_SCALE : -INFINITY; acc[j] = v; mx = fmaxf(mx, v); }
        s[i] = acc; }
    mx = fmaxf(mx, __shfl_xor(mx, 16)); mx = fmaxf(mx, __shfl_xor(mx, 32));
    float l = 0.f;
#pragma unroll
    for (int i = 0; i < NT; ++i)
#pragma unroll
        for (int j = 0; j < 4; ++j) { const float p = __expf(s[i][j] - mx); s[i][j] = p; l += p; }
    l += __shfl_xor(l, 16); l += __shfl_xor(l, 32);
    f32x4 o[8];
#pragma unroll
    for (int mt = 0; mt < 8; ++mt) o[mt] = (f32x4){0.f, 0.f, 0.f, 0.f};
#pragma unroll
    for (int sp = 0; sp < NT / 2; ++sp) { const int ta = t0 + 2 * sp, tb = ta + 1; const int tca = ta < 15 ? ta : 15, tcb = tb < 15 ? tb : 15;
        u32x4 pw; pw.x = cvt_pk_bf16(s[2 * sp][0], s[2 * sp][1]); pw.y = cvt_pk_bf16(s[2 * sp][2], s[2 * sp][3]); pw.z = cvt_pk_bf16(s[2 * sp + 1][0], s[2 * sp + 1][1]); pw.w = cvt_pk_bf16(s[2 * sp + 1][2], s[2 * sp + 1][3]);
        const bf16x8 pf = __builtin_bit_cast(bf16x8, pw);
#pragma unroll
        for (int mt = 0; mt < 8; ++mt) { const LAS unsigned* vr = VT + (16 * mt + fr) * VTS; const int rot = 2 * fq + 2 * (2 * mt + (fr >> 3));
            const u32x2 lo = *(const LAS u32x2*)(vr + ((8 * tca + rot) & 127)), hi = *(const LAS u32x2*)(vr + ((8 * tcb + rot) & 127));
            u32x4 vw; vw.x = lo.x; vw.y = lo.y; vw.z = hi.x; vw.w = hi.y;
            o[mt] = __builtin_amdgcn_mfma_f32_16x16x32_bf16(__builtin_bit_cast(bf16x8, vw), pf, o[mt], 0, 0, 0); } }
    const float il = 1.f / l;
    bf16_t* op = Ob + (long)iq * os + 4 * fq;
#pragma unroll
    for (int mt = 0; mt < 8; ++mt) { u32x2 wv; wv.x = cvt_pk_bf16(o[mt][0] * il, o[mt][1] * il); wv.y = cvt_pk_bf16(o[mt][2] * il, o[mt][3] * il); *(u32x2*)(op + 16 * mt) = wv; }
    if (lsep && fq == 0) lsep[(long)iq * lses] = mx + __logf(l);
}

constexpr int QB_STRIDE = 144, QB_BYTES = 128 * QB_STRIDE, QT_OFF = 2 * QB_BYTES, QT_STRIDE = 272;
__device__ __forceinline__ void cross_q_tile(LAS unsigned char* lds, const bf16_t* XBp, const bf16_t* WQT, const float* ssq, int tid, bf16x8 (&qf)[4]) {
    const int lane = tid & 63, w = tid >> 6, fr = lane & 15, fq = lane >> 4;
    const bf16_t* ap = XBp + (size_t)(16 * w + fr) * 2048 + 8 * fq;
    const int br = tid >> 3, bc = tid & 7;
    const bf16_t* bp = WQT + (size_t)br * 2048 + 8 * bc;
    f32x4 acc[8];
#pragma unroll
    for (int nt = 0; nt < 8; ++nt) acc[nt] = (f32x4){0.f, 0.f, 0.f, 0.f};
    u32x4 b0[4], b1[4]; bf16x8 a0[4], a1[4];
#pragma unroll
    for (int i = 0; i < 4; ++i) { b0[i] = *(const u32x4*)(bp + 64 * i); b1[i] = *(const u32x4*)(bp + (size_t)64 * 2048 + 64 * i); a0[i] = *(const bf16x8*)(ap + 64 * i); a1[i] = *(const bf16x8*)(ap + 64 * i + 32); }
    __syncthreads();
    for (int kq = 0; kq < 8; ++kq) {
#pragma unroll
        for (int i = 0; i < 4; ++i) { const int kc = 4 * kq + i;
            LAS unsigned char* buf = lds + (i & 1) * QB_BYTES;
            *(LAS u32x4*)(buf + br * QB_STRIDE + 16 * bc) = b0[i]; *(LAS u32x4*)(buf + (br + 64) * QB_STRIDE + 16 * bc) = b1[i];
            const bf16x8 c0 = a0[i], c1 = a1[i];
            if (kq < 7) { b0[i] = *(const u32x4*)(bp + 64 * (kc + 4)); b1[i] = *(const u32x4*)(bp + (size_t)64 * 2048 + 64 * (kc + 4)); a0[i] = *(const bf16x8*)(ap + 64 * (kc + 4)); a1[i] = *(const bf16x8*)(ap + 64 * (kc + 4) + 32); }
            __syncthreads();
#pragma unroll
            for (int nt = 0; nt < 8; ++nt) { const LAS unsigned char* rp = buf + (16 * nt + fr) * QB_STRIDE + 16 * fq;
                const bf16x8 f0 = __builtin_bit_cast(bf16x8, *(const LAS u32x4*)rp), f1 = __builtin_bit_cast(bf16x8, *(const LAS u32x4*)(rp + 64));
                acc[nt] = __builtin_amdgcn_mfma_f32_16x16x32_bf16(c0, f0, acc[nt], 0, 0, 0); acc[nt] = __builtin_amdgcn_mfma_f32_16x16x32_bf16(c1, f1, acc[nt], 0, 0, 0); } }
    }
    float rs[4];
#pragma unroll
    for (int j = 0; j < 4; ++j) rs[j] = rsqrtf(ssq[16 * w + 4 * fq + j] * (1.f / 2048.f) + EPS);
    LAS unsigned char* qt = lds + QT_OFF;
#pragma unroll
    for (int nt = 0; nt < 8; ++nt)
#pragma unroll
        for (int j = 0; j < 4; ++j) *(LAS bf16_t*)(qt + (16 * w + 4 * fq + j) * QT_STRIDE + 2 * (16 * nt + fr)) = (bf16_t)(cvt_pk_bf16(acc[nt][j] * rs[j], 0.f) & 0xffffu);
    __syncthreads();
#pragma unroll
    for (int k4 = 0; k4 < 4; ++k4) qf[k4] = __builtin_bit_cast(bf16x8, *(const LAS u32x4*)(qt + (16 * w + fr) * QT_STRIDE + 2 * (32 * k4 + 8 * fq)));
}

__device__ __forceinline__ void hg_gates(const unsigned (&fw)[8], float lb0, float lb1, LAS float* psum, int tid, float (&f)[2][8], float (&b)[2][8], float (&tot)[2]) {
    const int k0 = 2 * (tid & 63), part = tid >> 6;
    float r0 = 0.f, r1 = 0.f;
#pragma unroll
    for (int cc = 0; cc < 8; ++cc) { const float f0 = lb0 + (1.f - lb0) * sigm(bflo(fw[cc])), f1 = lb1 + (1.f - lb1) * sigm(bfhi(fw[cc]));
        f[0][cc] = f0; f[1][cc] = f1; r0 += __logf(f0); r1 += __logf(f1); b[0][cc] = r0; b[1][cc] = r1; }
    psum[part * 128 + k0] = r0; psum[part * 128 + k0 + 1] = r1;
    __syncthreads();
    float off0 = 0.f, off1 = 0.f, t0 = 0.f, t1 = 0.f;
#pragma unroll
    for (int p = 0; p < 8; ++p) { const float a0 = psum[p * 128 + k0], a1 = psum[p * 128 + k0 + 1]; if (p < part) { off0 += a0; off1 += a1; } t0 += a0; t1 += a1; }
#pragma unroll
    for (int cc = 0; cc < 8; ++cc) { b[0][cc] += off0; b[1][cc] += off1; }
    tot[0] = t0; tot[1] = t1;
}
constexpr int HS = 36;
__device__ __forceinline__ void hg_write_vt(const u32x4 x, const u32x4 y, LAS unsigned* VTh, int tid) {
    const int p = tid & 31, ch = tid >> 5;
    LAS unsigned* d = VTh + (8 * ch) * HS + p;
    d[0 * HS] = (x.x & 0xffffu) | (y.x << 16); d[1 * HS] = (x.x >> 16) | (y.x & 0xffff0000u);
    d[2 * HS] = (x.y & 0xffffu) | (y.y << 16); d[3 * HS] = (x.y >> 16) | (y.y & 0xffff0000u);
    d[4 * HS] = (x.z & 0xffffu) | (y.z << 16); d[5 * HS] = (x.z >> 16) | (y.z & 0xffff0000u);
    d[6 * HS] = (x.w & 0xffffu) | (y.w << 16); d[7 * HS] = (x.w >> 16) | (y.w & 0xffff0000u);
}
struct HgIn { unsigned fw[8]; u32x4 x, y; float lb0, lb1; };
__device__ __forceinline__ void hg_load(HgIn& I, const bf16_t* hg, const float* lbp, int hu, int tid) {
    const int bh = hu >> 5, n = hu & 31, b_ = bh >> 3, h = bh & 7, row0 = b_ * 2048 + n * 64; const int k0 = 2 * (tid & 63), part = tid >> 6;
#pragma unroll
    for (int cc = 0; cc < 8; ++cc) I.fw[cc] = *(const unsigned*)(hg + (size_t)(row0 + part * 8 + cc) * 4096 + 1024 + h * 128 + k0);
    const bf16_t* src = hg + (size_t)(row0 + 2 * (tid & 31)) * 4096 + 2048 + h * 128 + 8 * (tid >> 5);
    I.x = *(const u32x4*)src; I.y = *(const u32x4*)(src + 4096);
    I.lb0 = lbp[h * 128 + k0]; I.lb1 = lbp[h * 128 + k0 + 1];
}
__device__ __forceinline__ void hg_kv_phase(LAS unsigned char* lds, const bf16_t* hg, const float* lbp, bf16_t* ST, float* DEC, int tid, int bid, int G) {
    const int lane = tid & 63, w = tid >> 6, fr = lane & 15, fq = lane >> 4;
    LAS unsigned* VTh = (LAS unsigned*)lds;
    LAS unsigned* KDT = (LAS unsigned*)(lds + 18432);
    LAS float* psum = (LAS float*)(lds + 36864);
    const int k0 = 2 * (tid & 63), part = tid >> 6;
    HgIn I; if (bid < 1024) hg_load(I, hg, lbp, bid, tid);
    for (int hu = bid; hu < 1024; hu += G) {
        __syncthreads();
        hg_write_vt(I.x, I.y, VTh, tid);
        float f[2][8], b[2][8], tot[2];
        hg_gates(I.fw, I.lb0, I.lb1, psum, tid, f, b, tot);
        if (hu + G < 1024) hg_load(I, hg, lbp, hu + G, tid);
#pragma unroll
        for (int q = 0; q < 2; ++q) { float kd[8];
#pragma unroll
            for (int cc = 0; cc < 8; ++cc) kd[cc] = (1.f - f[q][cc]) * __expf(tot[q] - b[q][cc]);
            u32x4 wv; wv.x = cvt_pk_bf16(kd[0], kd[1]); wv.y = cvt_pk_bf16(kd[2], kd[3]); wv.z = cvt_pk_bf16(kd[4], kd[5]); wv.w = cvt_pk_bf16(kd[6], kd[7]);
            *(LAS u32x4*)(KDT + (k0 + q) * HS + 4 * part) = wv; }
        if (part == 0) { DEC[(size_t)hu * 128 + k0] = __expf(tot[0]); DEC[(size_t)hu * 128 + k0 + 1] = __expf(tot[1]); }
        __syncthreads();
        bf16x8 af[2];
#pragma unroll
        for (int k2 = 0; k2 < 2; ++k2) af[k2] = __builtin_bit_cast(bf16x8, *(const LAS u32x4*)(VTh + (16 * w + fr) * HS + 16 * k2 + 4 * fq));
        bf16_t* stp = ST + (size_t)hu * 16384 + (size_t)(16 * w + 4 * fq) * 128 + fr;
#pragma unroll
        for (int nt = 0; nt < 8; ++nt) { f32x4 acc = {0.f, 0.f, 0.f, 0.f};
#pragma unroll
            for (int k2 = 0; k2 < 2; ++k2) { const bf16x8 bf = __builtin_bit_cast(bf16x8, *(const LAS u32x4*)(KDT + (16 * nt + fr) * HS + 16 * k2 + 4 * fq)); acc = __builtin_amdgcn_mfma_f32_16x16x32_bf16(af[k2], bf, acc, 0, 0, 0); }
#pragma unroll
            for (int j = 0; j < 4; ++j) { const float nb = __shfl_down(acc[j], 1); if (!(fr & 1)) *(unsigned*)(stp + j * 128 + 16 * nt) = cvt_pk_bf16(acc[j], nb); } }
    }
}
constexpr int QS = 68;
__device__ __forceinline__ void hg_out_phase(LAS unsigned char* lds, const bf16_t* hg, const float* lbp, const float* hg_norm_w, const bf16_t* STB, bf16_t* OHG, int tid, int bid, int G) {
    const int lane = tid & 63, w = tid >> 6, fr = lane & 15, fq = lane >> 4;
    LAS unsigned* VTh = (LAS unsigned*)lds;
    LAS unsigned* QD = (LAS unsigned*)(lds + 18432);
    LAS unsigned* QM = (LAS unsigned*)(lds + 18432 + 17408);
    LAS unsigned* KM = (LAS unsigned*)(lds + 18432 + 2 * 17408);
    LAS float* psum = (LAS float*)(lds + 18432 + 3 * 17408);
    LAS float* bref = psum + 1024;
    LAS float* ssq = bref + 128;
    const int k0 = 2 * (tid & 63), part = tid >> 6, ct = w & 3, vh = w >> 2, c = 16 * ct + fr;
    HgIn I; unsigned qw[8];
    if (bid < 1024) { hg_load(I, hg, lbp, bid, tid); const int bh = bid >> 5, row0 = (bh >> 3) * 2048 + (bid & 31) * 64;
#pragma unroll
        for (int cc = 0; cc < 8; ++cc) qw[cc] = *(const unsigned*)(hg + (size_t)(row0 + part * 8 + cc) * 4096 + (bh & 7) * 128 + k0); }
    for (int hu = bid; hu < 1024; hu += G) {
        const int bh = hu >> 5, n = hu & 31, b_ = bh >> 3, h = bh & 7, row0 = b_ * 2048 + n * 64;
        u32x4 sa[4][4]; u32x2 gw[4]; f32x4 nw[4];
#pragma unroll
        for (int mi = 0; mi < 4; ++mi) { const bf16_t* sp = STB + (size_t)hu * 16384 + (size_t)(16 * (vh * 4 + mi) + fr) * 128 + 8 * fq;
#pragma unroll
            for (int k4 = 0; k4 < 4; ++k4) sa[mi][k4] = *(const u32x4*)(sp + 32 * k4);
            const int v0 = 16 * (vh * 4 + mi) + 4 * fq; gw[mi] = *(const u32x2*)(hg + (size_t)(row0 + c) * 4096 + 3072 + h * 128 + v0); nw[mi] = *(const f32x4*)(hg_norm_w + v0); }
        __syncthreads();
        hg_write_vt(I.x, I.y, VTh, tid);
        float f[2][8], b[2][8], tot[2];
        hg_gates(I.fw, I.lb0, I.lb1, psum, tid, f, b, tot);
        if (part == 4) { bref[k0] = b[0][0]; bref[k0 + 1] = b[1][0]; }
        __syncthreads();
        const float br0 = bref[k0], br1 = bref[k0 + 1];
#pragma unroll
        for (int cc = 0; cc < 8; ++cc) { const int c_ = part * 8 + cc; const float q0 = bflo(qw[cc]), q1 = bfhi(qw[cc]);
            const float e0 = __expf(b[0][cc] - br0), e1 = __expf(b[1][cc] - br1);
            QD[c_ * QS + (k0 >> 1)] = cvt_pk_bf16(q0 * __expf(b[0][cc]), q1 * __expf(b[1][cc]));
            QM[c_ * QS + (k0 >> 1)] = cvt_pk_bf16(q0 * e0, q1 * e1);
            KM[c_ * QS + (k0 >> 1)] = cvt_pk_bf16((1.f - f[0][cc]) * __builtin_amdgcn_rcpf(e0), (1.f - f[1][cc]) * __builtin_amdgcn_rcpf(e1)); }
        if (hu + G < 1024) { const int hn = hu + G; hg_load(I, hg, lbp, hn, tid); const int bhn = hn >> 5, row0n = (bhn >> 3) * 2048 + (hn & 31) * 64;
#pragma unroll
            for (int cc = 0; cc < 8; ++cc) qw[cc] = *(const unsigned*)(hg + (size_t)(row0n + part * 8 + cc) * 4096 + (bhn & 7) * 128 + k0); }
        __syncthreads();
        bf16x8 qmf[4];
#pragma unroll
        for (int k4 = 0; k4 < 4; ++k4) qmf[k4] = __builtin_bit_cast(bf16x8, *(const LAS u32x4*)(QM + (16 * ct + fr) * QS + 16 * k4 + 4 * fq));
        unsigned ap[4][2];
#pragma unroll
        for (int st = 0; st < 4; ++st) { f32x4 acc = {0.f, 0.f, 0.f, 0.f};
#pragma unroll
            for (int k4 = 0; k4 < 4; ++k4) { const bf16x8 kf = __builtin_bit_cast(bf16x8, *(const LAS u32x4*)(KM + (16 * st + fr) * QS + 16 * k4 + 4 * fq)); acc = __builtin_amdgcn_mfma_f32_16x16x32_bf16(kf, qmf[k4], acc, 0, 0, 0); }
#pragma unroll
            for (int j = 0; j < 4; ++j) { const int s_ = 16 * st + 4 * fq + j; if (s_ > c) acc[j] = 0.f; }
            ap[st][0] = cvt_pk_bf16(acc[0], acc[1]); ap[st][1] = cvt_pk_bf16(acc[2], acc[3]); }
        bf16x8 qdf[4];
#pragma unroll
        for (int k4 = 0; k4 < 4; ++k4) qdf[k4] = __builtin_bit_cast(bf16x8, *(const LAS u32x4*)(QD + (16 * ct + fr) * QS + 16 * k4 + 4 * fq));
        f32x4 o[4]; float ss = 0.f;
#pragma unroll
        for (int mi = 0; mi < 4; ++mi) { const int mt = vh * 4 + mi; f32x4 acc = {0.f, 0.f, 0.f, 0.f};
#pragma unroll
            for (int k4 = 0; k4 < 4; ++k4) acc = __builtin_amdgcn_mfma_f32_16x16x32_bf16(__builtin_bit_cast(bf16x8, sa[mi][k4]), qdf[k4], acc, 0, 0, 0);
#pragma unroll
            for (int s2 = 0; s2 < 2; ++s2) { const LAS unsigned* vr = VTh + (16 * mt + fr) * HS + 16 * s2 + 2 * fq;
                const u32x2 lo = *(const LAS u32x2*)vr, hi = *(const LAS u32x2*)(vr + 8);
                u32x4 vw; vw.x = lo.x; vw.y = lo.y; vw.z = hi.x; vw.w = hi.y;
                u32x4 pw; pw.x = ap[2 * s2][0]; pw.y = ap[2 * s2][1]; pw.z = ap[2 * s2 + 1][0]; pw.w = ap[2 * s2 + 1][1];
                acc = __builtin_amdgcn_mfma_f32_16x16x32_bf16(__builtin_bit_cast(bf16x8, vw), __builtin_bit_cast(bf16x8, pw), acc, 0, 0, 0); }
            o[mi] = acc; ss += (acc[0] * acc[0] + acc[1] * acc[1]) + (acc[2] * acc[2] + acc[3] * acc[3]); }
        ss += __shfl_xor(ss, 16); ss += __shfl_xor(ss, 32);
        if (fq == 0) ssq[vh * 64 + c] = ss;
        __syncthreads();
        const float rstd = rsqrtf((ssq[c] + ssq[64 + c]) * (1.f / 128.f) + EPS);
#pragma unroll
        for (int mi = 0; mi < 4; ++mi) { const int v0 = 16 * (vh * 4 + mi) + 4 * fq;
            u32x2 ov; ov.x = cvt_pk_bf16(o[mi][0] * rstd * nw[mi][0] * bflo(gw[mi].x), o[mi][1] * rstd * nw[mi][1] * bfhi(gw[mi].x)); ov.y = cvt_pk_bf16(o[mi][2] * rstd * nw[mi][2] * bflo(gw[mi].y), o[mi][3] * rstd * nw[mi][3] * bfhi(gw[mi].y));
            *(u32x2*)(OHG + (size_t)(row0 + c) * 1536 + 512 + h * 128 + v0) = ov; }
    }
}

#define XB_TMO      128
#define XB_XCNT(j)  (256  + 64 * (j))
#define XB_XSUB(j)  (1280 + 64 * (j))
#define XB_XGEN(j)  (2304 + 64 * (j))
#define XB_TOP      3328
#define XB_TOPGEN   3392
#define XCD_BAR_WORDS 3456
#define XB_SPIN_CAP (1u << 18)

__device__ __forceinline__ unsigned xb_ld(unsigned* p)              { return __hip_atomic_load(p, __ATOMIC_RELAXED, __HIP_MEMORY_SCOPE_AGENT); }
__device__ __forceinline__ unsigned xb_add(unsigned* p, unsigned v) { return __hip_atomic_fetch_add(p, v, __ATOMIC_RELAXED, __HIP_MEMORY_SCOPE_AGENT); }
__device__ __forceinline__ unsigned xb_xcc_id() { return (unsigned)__builtin_amdgcn_s_getreg((3 << 11) | 20) & 0xFu; }
#define XB_SPIN(cond, bar) do { unsigned _sp = 0; while (cond) { __builtin_amdgcn_s_sleep(1); \
    if ((++_sp & 255u) == 0u) { if (xb_ld(&(bar)[XB_TMO])) break; if (_sp > XB_SPIN_CAP) { atomicAdd(&(bar)[XB_TMO], 1u); break; } } } } while (0)

struct XcdBarrier {
    unsigned* bar; unsigned x;
    volatile LAS unsigned* st;
};

__device__ __forceinline__ XcdBarrier xcd_barrier_post(unsigned* bar, volatile LAS unsigned* st) {
    XcdBarrier b; b.bar = bar; b.x = xb_xcc_id(); b.st = st;
    if (threadIdx.x == 0) (void)xb_add(&bar[XB_XCNT(b.x)], 1u);
    return b;
}
__device__ __forceinline__ void xcd_barrier_complete(unsigned* bar, unsigned x, unsigned& nloc, unsigned& nx) {
    const unsigned G = gridDim.x * gridDim.y * gridDim.z;
    unsigned sum, cnt, mine, sp = 0u;
    for (;;) {
        sum = 0u; cnt = 0u; mine = 0u;
#pragma unroll
        for (unsigned j = 0; j < 16; ++j) { const unsigned c = xb_ld(&bar[XB_XCNT(j)]); sum += c; cnt += (c > 0u) ? 1u : 0u; mine = (j == x) ? c : mine; }
        if (sum == G) break;
        __builtin_amdgcn_s_sleep(1);
        if ((++sp & 255u) == 0u) { if (xb_ld(&bar[XB_TMO])) break; if (sp > XB_SPIN_CAP) { atomicAdd(&bar[XB_TMO], 1u); break; } }
    }
    nloc = mine > 0u ? mine : 1u; nx = cnt > 0u ? cnt : 1u;
}

__device__ __forceinline__ void xcd_barrier(const XcdBarrier& b) {
    asm volatile("s_waitcnt vmcnt(0)" ::: "memory");
    __syncthreads();
    if (threadIdx.x == 0) {
        unsigned* bar = b.bar;
        __builtin_amdgcn_s_waitcnt(0);
        unsigned nloc = b.st[0], nx = b.st[1];
        if (nloc == 0u) { xcd_barrier_complete(bar, b.x, nloc, nx); b.st[0] = nloc; b.st[1] = nx; }
        const unsigned old = xb_add(&bar[XB_XSUB(b.x)], 1u);
        const unsigned gen = old / nloc;
        if (old + 1u == (gen + 1u) * nloc) {
            __builtin_amdgcn_fence(__ATOMIC_RELEASE, "agent");
            asm volatile("s_waitcnt vmcnt(0)" ::: "memory");
            const unsigned og = xb_add(&bar[XB_TOP], 1u);
            const unsigned tg = og / nx;
            if (og + 1u == (tg + 1u) * nx) xb_add(&bar[XB_TOPGEN], 1u);
            else XB_SPIN(xb_ld(&bar[XB_TOPGEN]) == tg, bar);
            __builtin_amdgcn_fence(__ATOMIC_ACQUIRE, "agent");
            xb_add(&bar[XB_XGEN(b.x)], 1u);
            asm volatile("s_waitcnt vmcnt(0)" ::: "memory");
        } else {
            XB_SPIN(xb_ld(&bar[XB_XGEN(b.x)]) == gen, bar);
            __builtin_amdgcn_fence(__ATOMIC_ACQUIRE, "agent");
            asm volatile("s_waitcnt vmcnt(0)" ::: "memory");
        }
    }
    __syncthreads();
}

constexpr int NPHASE = 12;
#ifndef REP_PHASE
#define REP_PHASE -1
#endif
#define REPLOOP(k) _Pragma("nounroll") for (int rep_ = 0; rep_ < ((k) == REP_PHASE ? 2 : 1); ++rep_)
__global__ void __launch_bounds__(NTHR, 2) fwd_kernel(Args a) {
    extern __shared__ __attribute__((aligned(16))) unsigned char lds_raw[];
    LAS unsigned char* lds = (LAS unsigned char*)lds_raw;
    cg::grid_group grid = cg::this_grid();
    const int tid = threadIdx.x, G = gridDim.x, bid = blockIdx.x;
    unsigned char* ws = a.ws;
    const int lo = a.ph_lo, hi = a.ph_hi;
#define IN(k) (lo <= (k) && (k) < hi)
#define SEAM(k) do { if (IN(k) && IN((k) + 1)) { if (lo < 0) grid.sync(); else xcd_barrier(bar); } } while (0)
    if (tid < 2) ((volatile LAS unsigned*)(lds + LDS_MISC))[tid] = 0u;
    __syncthreads();
    XcdBarrier bar = xcd_barrier_post((unsigned*)(ws + WS_BAR), (volatile LAS unsigned*)(lds + LDS_MISC));
    float* sumsq = (float*)(ws + WS_SUMSQ);
    bf16_t* QKV = (bf16_t*)(ws + WS_QKV); bf16_t* HGB = (bf16_t*)(ws + WS_HG); bf16_t* GATES = (bf16_t*)(ws + WS_GATES); bf16_t* KVC = (bf16_t*)(ws + WS_KVC);
    bf16_t* OG = (bf16_t*)((unsigned char*)a.out + 32 * MiB);       float* LSE = (float*)(ws + WS_LSE); bf16_t* OCAT = (bf16_t*)(ws + WS_OCAT);
    bf16_t* ST = (bf16_t*)a.out; bf16_t* STB = (bf16_t*)(ws + WS_STB); float* DEC = (float*)(ws + WS_DEC); const float* LB = (const float*)(ws + WS_LB);
    float* PART = a.out; unsigned* FLAGS = (unsigned*)(ws + WS_FLAGS); bf16_t* MERGED = (bf16_t*)a.out; bf16_t* XB = (bf16_t*)(ws + WS_XB);
    bf16_t* QC = (bf16_t*)(ws + WS_QC); bf16_t* OC = (bf16_t*)(ws + WS_OC); bf16_t* GB = (bf16_t*)(ws + WS_G);

    if (IN(0)) REPLOOP(0) { phase_prologue(a, lds, tid); __syncthreads(); }
    SEAM(0);
    if (IN(1)) REPLOOP(1) {
        pg8::SplitOrder S; S.init((const bf16_t*)(ws + WS_HN), (const bf16_t*)(ws + WS_WIN), MTOK, 12288, 2048, 0, G, bid);
        pg8::EpiProj E{QKV, HGB, GATES, KVC};
        pg8::gemm_phase2<pg8::EpiProj, pg8::SplitOrder>(lds, S, E, PART, FLAGS, 2u * 2048u);
    }
    SEAM(1);
    const int NGEM = G >= 160 ? 80 : 0;
    if (IN(2)) REPLOOP(2) {
      { const int bid_ = bid, G_ = G;
        for (int u = bid_; u < 768; u += G_) {
            const int g_ = u >> 8, rem = u & 255; const int dsh = 2 * g_, d = 1 << dsh, nblk = 16 >> dsh;
            const int n = rem & (nblk - 1), r = (rem >> (4 - dsh)) & (d - 1), bhh = rem >> 4, b_ = bhh >> 2, hg_ = bhh & 3;
            const long row0 = (long)b_ * 2048 + (long)(n * 128) * d + r;
            const bf16_t* qb = QKV + row0 * 4608 + (g_ * 4 + hg_) * 128;
            attn_unit<true>(lds, qb, (long)d * 4608, qb + 1536, (long)d * 4608, qb + 3072, (long)d * 4608, n > 0,
                            OG + (size_t)g_ * (8192 * 512) + row0 * 512 + hg_ * 128, (long)d * 512, LSE + (size_t)g_ * (8192 * 4) + row0 * 4 + hg_, (long)d * 4, tid);
        }
        hg_kv_phase(lds, HGB, LB, ST, DEC, tid, bid_, G_);
      }
    }
    SEAM(2);
    if (IN(3)) {
        const int gt = bid * NTHR + tid, NGT = G * NTHR;
        for (int task = gt; task < 8192 * 64; task += NGT) { const int tok = task >> 6, hg_ = (task >> 4) & 3, c = task & 15;
            const float l0 = LSE[(size_t)tok * 4 + hg_], l1 = LSE[(size_t)(8192 + tok) * 4 + hg_], l2 = LSE[(size_t)(16384 + tok) * 4 + hg_];
            const float mx = fmaxf(l0, fmaxf(l1, l2)); float e0 = __expf(l0 - mx), e1 = __expf(l1 - mx), e2 = __expf(l2 - mx); const float inv = 1.f / (e0 + e1 + e2); e0 *= inv; e1 *= inv; e2 *= inv;
            const size_t off = (size_t)tok * 512 + hg_ * 128 + 8 * c;
            const u32x4 x0 = *(const u32x4*)(OG + off), x1 = *(const u32x4*)(OG + (size_t)8192 * 512 + off), x2 = *(const u32x4*)(OG + (size_t)2 * 8192 * 512 + off);
            u32x4 o;
            o.x = cvt_pk_bf16(e0 * bflo(x0.x) + e1 * bflo(x1.x) + e2 * bflo(x2.x), e0 * bfhi(x0.x) + e1 * bfhi(x1.x) + e2 * bfhi(x2.x));
            o.y = cvt_pk_bf16(e0 * bflo(x0.y) + e1 * bflo(x1.y) + e2 * bflo(x2.y), e0 * bfhi(x0.y) + e1 * bfhi(x1.y) + e2 * bfhi(x2.y));
            o.z = cvt_pk_bf16(e0 * bflo(x0.z) + e1 * bflo(x1.z) + e2 * bflo(x2.z), e0 * bfhi(x0.z) + e1 * bfhi(x1.z) + e2 * bfhi(x2.z));
            o.w = cvt_pk_bf16(e0 * bflo(x0.w) + e1 * bflo(x1.w) + e2 * bflo(x2.w), e0 * bfhi(x0.w) + e1 * bfhi(x1.w) + e2 * bfhi(x2.w));
            *(u32x4*)(OCAT + (size_t)tok * 1536 + hg_ * 128 + 8 * c) = o; }
        for (int task = gt; task < 32 * 4096; task += NGT) { const int bh = task >> 12, e4 = task & 4095;
            f32x4 S_ = {0.f, 0.f, 0.f, 0.f};
            const bf16_t* sp = ST + (size_t)bh * 32 * 16384 + 4 * e4; const float* dp = DEC + (size_t)bh * 32 * 128 + ((4 * e4) & 127); bf16_t* op = STB + (size_t)bh * 32 * 16384 + 4 * e4;
#pragma unroll 8
            for (int n = 0; n < 32; ++n) { const u32x2 kw = *(const u32x2*)(sp + (size_t)n * 16384); const f32x4 kv = {bflo(kw.x), bfhi(kw.x), bflo(kw.y), bfhi(kw.y)}; const f32x4 dc = *(const f32x4*)(dp + n * 128);
                u32x2 wv; wv.x = cvt_pk_bf16(S_[0], S_[1]); wv.y = cvt_pk_bf16(S_[2], S_[3]); *(u32x2*)(op + (size_t)n * 16384) = wv; S_ = dc * S_ + kv; } }
    }
    SEAM(3);
    if (IN(4)) REPLOOP(4) {
      if (bid < NGEM || NGEM == 0) {
        pg8::DeferOrder S{(const bf16_t*)(ws + WS_HN), (const bf16_t*)(ws + WS_WIN), 2048, bid, 80, NGEM ? NGEM : G}; pg8::EpiProj E{QKV, HGB, GATES, KVC};
        pg8::gemm_phase2<pg8::EpiProj, pg8::DeferOrder>(lds, S, E, PART, FLAGS, 2u * 2048u); __syncthreads();
      }
      if (bid >= NGEM) hg_out_phase(lds, HGB, LB, a.in[4], STB, OCAT, tid, bid - NGEM, G - NGEM);
    }
    SEAM(4);
    if (IN(5)) REPLOOP(5) {
        pg8::ChainOrder S{OCAT, (const bf16_t*)(ws + WS_WA), 1536, 8, MTOK / 256, 2048 / 256, G, bid};
        pg8::EpiMerge E{GATES, MERGED};
        pg8::gemm_phase2<pg8::EpiMerge, pg8::ChainOrder>(lds, S, E, nullptr, nullptr, 2u * 1536u);
    }
    SEAM(5);
    if (IN(6)) { pg8::SplitOrder S; S.init(MERGED, (const bf16_t*)(ws + WS_WOUT), MTOK, 2048, 2048, 0, G, bid); pg8::EpiRes<false> E{a.in[0], XB, sumsq};
        pg8::gemm_phase2<pg8::EpiRes<false>, pg8::SplitOrder>(lds, S, E, PART, FLAGS, 2u * 2048u); }
    SEAM(6);
    if (IN(8)) REPLOOP(8) {
        for (int u = bid; u < 256; u += G) { const int b_ = u >> 6, h = (u >> 4) & 3, qb = u & 15; const size_t r0 = (size_t)(b_ * 2048 + qb * 128);
            const bf16_t* kb = KVC + (size_t)(b_ * 256 + 128) * 1024 + h * 128;
            bf16x8 qf[4]; cross_q_tile(lds, XB + r0 * 2048, (const bf16_t*)(ws + WS_WQ) + (size_t)(h * 128) * 2048, sumsq + r0, tid, qf);
            attn_unit<false, true>(lds, nullptr, 512, kb, 1024, kb + 512, 1024, true, OC + r0 * 512 + h * 128, 512, nullptr, 0, tid, qf); }
    }
    SEAM(8);
    if (IN(9)) { pg8::SplitOrder S; S.init(OC, (const bf16_t*)(ws + WS_WO), MTOK, 2048, 512, 0, G, bid); pg8::EpiRes<true> E{XB, XB, sumsq + 8192};
        pg8::gemm_phase2<pg8::EpiRes<true>, pg8::SplitOrder>(lds, S, E, PART, FLAGS, 2u * 512u); }
    SEAM(9);
    if (IN(10)) REPLOOP(10) { pg8::SplitOrder S; S.init(XB, (const bf16_t*)(ws + WS_W13), MTOK, 2 * DFF_, 2048, 0, G, bid); pg8::EpiSwiGLU E{sumsq + 8192, GB};
        pg8::gemm_phase2<pg8::EpiSwiGLU, pg8::SplitOrder>(lds, S, E, PART, FLAGS + 4096, 2u * 2048u); }
    SEAM(10);
    if (IN(11)) { pg8::SplitOrder S; S.init(GB, (const bf16_t*)(ws + WS_W2), MTOK, 2048, DFF_, 0, G, bid); pg8::EpiFinal E{XB, a.out, sumsq + 16384, a.in[18], FLAGS};
        pg8::gemm_phase2<pg8::EpiFinal, pg8::SplitOrder>(lds, S, E, PART, FLAGS, 2u * 5632u); }
#undef IN
#undef SEAM
}

#ifndef N_LAUNCH_MODE
#define N_LAUNCH_MODE 1
#endif
extern "C" void kernel_launch(void* const* d_in, const int* in_sizes, int n_in, void* d_out, int out_size, void* d_ws, size_t ws_size, hipStream_t stream) {
    static int grid = 0;
    if (grid == 0) {
        if (n_in != 19 || out_size != MTOK * DMODEL || ws_size < WS_END) { fprintf(stderr, "kernel_launch: unexpected problem (n_in %d out %d ws %zu)\n", n_in, out_size, ws_size); grid = -1; return; }
        int dev = 0, cus = 0, per_cu = 0;
        hipGetDevice(&dev); hipDeviceGetAttribute(&cus, hipDeviceAttributeMultiprocessorCount, dev);
        if (hipFuncSetAttribute((const void*)fwd_kernel, hipFuncAttributeMaxDynamicSharedMemorySize, LDS_BYTES) != hipSuccess) { fprintf(stderr, "kernel_launch: hipFuncSetAttribute failed\n"); grid = -1; return; }
        if (hipOccupancyMaxActiveBlocksPerMultiprocessor(&per_cu, (const void*)fwd_kernel, NTHR, LDS_BYTES) != hipSuccess || per_cu < 1) { fprintf(stderr, "kernel_launch: occupancy query gave %d\n", per_cu); per_cu = 1; }
        (void)hipGetLastError();
        grid = cus * 1;
        fprintf(stderr, "kernel_launch: grid %d (cus %d, per_cu %d)\n", grid, cus, per_cu);
    }
    if (grid < 0) return;
    if (hipMemsetAsync((char*)d_ws + WS_BAR, 0, BAR_BYTES, stream) != hipSuccess) { fprintf(stderr, "kernel_launch: memset failed\n"); return; }
    Args a{};
    for (int i = 0; i < 19; ++i) a.in[i] = (const float*)d_in[i];
    a.out = (float*)d_out; a.ws = (unsigned char*)d_ws;
#if N_LAUNCH_MODE == 1
    a.ph_lo = 0; a.ph_hi = NPHASE;
    void* args[] = {&a};
    hipError_t e = hipLaunchCooperativeKernel((const void*)fwd_kernel, dim3(grid), dim3(NTHR), args, LDS_BYTES, stream);
    if (e != hipSuccess) fprintf(stderr, "kernel_launch: cooperative launch failed: %s (grid %d)\n", hipGetErrorString(e), grid);
#else
    for (int p = 0; p < NPHASE; ++p) { a.ph_lo = p; a.ph_hi = p + 1; hipLaunchKernelGGL(fwd_kernel, dim3(grid), dim3(NTHR), LDS_BYTES, stream, a); }
#endif
}
```

```cpp
#include <hip/hip_runtime.h>
#include <hip/hip_cooperative_groups.h>
#include <cstdio>
#include <cstdint>
#include <cmath>
namespace cg = cooperative_groups;
namespace pg8 {
#define PG8_LAS __attribute__((address_space(3)))
typedef unsigned short bf16_t;
typedef short bf16x8 __attribute__((ext_vector_type(8)));
typedef float f32x4 __attribute__((ext_vector_type(4)));
typedef unsigned u32x4 __attribute__((ext_vector_type(4)));
constexpr int BM = 256, BK = 64, HALF = 128, HTB = HALF * BK * 2  , STAGE_BYTES = 8 * HTB, NXCD = 8, WGM = 8;

__host__ __device__ __forceinline__ int lds_byte(int r, int c) { const int st = (r >> 4) * 2 + (c >> 5), rr = r & 15, cc = c & 31, ob = rr * 64 + cc * 2; return st * 1024 + (ob ^ (((ob >> 9) & 1) << 5)); }
__host__ __device__ __forceinline__ void stage_rc(int b, int& R, int& C) { const int st = b / 1024, sb = b % 1024, swz = sb ^ (((sb >> 9) & 1) << 5); R = (st >> 1) * 16 + swz / 64; C = (st & 1) * 32 + (swz % 64) / 2; }
__host__ __device__ __forceinline__ int perm32(int rho) { const int n = rho >> 4, i = rho & 15; return 8 * (i >> 2) + 4 * n + (i & 3); }

struct Unit { int pm, pn; };
struct Gemm { const bf16_t* A; const bf16_t* Bt; int M, N, K; };

struct StaticOrder {
    int nM, nN, nwg, G, c;
    __host__ __device__ void init(int M, int N, int G_, int c_) { nM = M / BM; nN = N / BM; nwg = nM * nN; G = G_; c = c_; }
    __host__ __device__ bool next(int i, Unit& u) const {
        const long L = (long)i * G + c; if (L >= nwg) return false;
        int wgid = (int)L; { const int q = nwg / NXCD, r = nwg % NXCD, xcd = wgid % NXCD, off = wgid / NXCD; wgid = (xcd < r ? xcd * (q + 1) : r * (q + 1) + (xcd - r) * q) + off; }
        const int nig = WGM * nN, gid = wgid / nig, fm = gid * WGM, gsz = (nM - fm) < WGM ? (nM - fm) : WGM;
        u.pm = fm + ((wgid % nig) % gsz); u.pn = (wgid % nig) / gsz; return true;
    }
    __device__ __forceinline__ void a_ready(const Unit&) const {}
    __device__ __forceinline__ void done(const Unit&) const {}
};

__device__ __forceinline__ unsigned cvt_pk_bf16(float lo, float hi) { unsigned r; asm volatile("v_cvt_pk_bf16_f32 %0, %1, %2" : "=v"(r) : "v"(lo), "v"(hi)); return r; }
typedef float f32x2 __attribute__((ext_vector_type(2)));
typedef unsigned u32x2 __attribute__((ext_vector_type(2)));
__device__ __forceinline__ float sigm(float x) { return __builtin_amdgcn_rcpf(1.f + __expf(-x)); }
__device__ __forceinline__ float silu(float x) { return x * sigm(x); }
__device__ __forceinline__ float bflo(unsigned w) { return __uint_as_float(w << 16); }
__device__ __forceinline__ float bfhi(unsigned w) { return __uint_as_float(w & 0xffff0000u); }
constexpr float RMS_EPS_ = 1e-6f;

struct Order1 {
    StaticOrder so; int nmain;
    __host__ __device__ void init(int G_, int c_) { so.init(8192, 12800, G_, c_); nmain = so.nwg; }
    __host__ __device__ bool next(int i, Unit& u) const {
        const long L = (long)i * so.G + so.c;
        if (L < nmain) return so.next(i, u);
        const int e = (int)(L - nmain); if (e >= 16) return false;
        u.pm = 32 + (e >> 2); u.pn = 50 + (e & 3); return true;
    }
    __device__ __forceinline__ void a_ready(const Unit&) const {}
    __device__ __forceinline__ void done(const Unit&) const {}
};

struct EpiProj {
    static constexpr bool PERM = true, AFTER_DRAIN = false;
    bf16_t* qkv; bf16_t* hg; bf16_t* gates; bf16_t* kvc;
    __device__ __forceinline__ void operator()(const f32x4 (&acc)[2][2][4][2], const Unit& u, int wr, int wc, int fr, int fq) const {
        const int pn = u.pn; bf16_t* base; int ldc, colt, act, rowt = u.pm * BM;
        if (pn < 18) { base = qkv; ldc = 4608; colt = pn * 256; act = 0; }
        else if (pn < 34) { base = hg; ldc = 4096; colt = (pn - 18) * 256; const int s = (pn - 18) >> 2; act = (s == 0 || s == 3) ? 1 : 0; }
        else if (pn < 50) { base = gates; ldc = 4096; colt = (pn - 34) * 256; act = 2; }
        else { base = kvc; ldc = 1024; colt = (pn - 50) * 256; act = 0; rowt -= 8192; }
        const int row0 = rowt + wr * 64 + fr, col0 = colt + wc * 32 + 8 * fq;
#pragma unroll
        for (int ai = 0; ai < 2; ++ai)
#pragma unroll
            for (int m = 0; m < 4; ++m) { bf16_t* rowp = base + (size_t)(row0 + ai * HALF + m * 16) * ldc + col0;
#pragma unroll
                for (int bj = 0; bj < 2; ++bj) { f32x4 v0 = acc[ai][bj][m][0], v1 = acc[ai][bj][m][1];
                    if (act == 1) {
#pragma unroll
                        for (int e = 0; e < 4; ++e) { v0[e] = silu(v0[e]); v1[e] = silu(v1[e]); } }
                    else if (act == 2) {
#pragma unroll
                        for (int e = 0; e < 4; ++e) { v0[e] = sigm(v0[e]); v1[e] = sigm(v1[e]); } }
                    u32x4 w; w.x = cvt_pk_bf16(v0[0], v0[1]); w.y = cvt_pk_bf16(v0[2], v0[3]); w.z = cvt_pk_bf16(v1[0], v1[1]); w.w = cvt_pk_bf16(v1[2], v1[3]);
                    *(u32x4*)(rowp + bj * HALF) = w; } }
    }
};

struct EpiGateA {
    static constexpr bool PERM = true, AFTER_DRAIN = false;
    const bf16_t* gates; float* tmp;
    __device__ __forceinline__ void operator()(const f32x4 (&acc)[2][2][4][2], const Unit& u, int wr, int wc, int fr, int fq) const {
        const int row0 = u.pm * BM + wr * 64 + fr, col0 = u.pn * BM + wc * 32 + 8 * fq;
#pragma unroll
        for (int ai = 0; ai < 2; ++ai)
#pragma unroll
            for (int m = 0; m < 4; ++m) { const size_t r = (size_t)(row0 + ai * HALF + m * 16);
#pragma unroll
                for (int bj = 0; bj < 2; ++bj) { const int c = col0 + bj * HALF; const u32x4 g = *(const u32x4*)(gates + r * 4096 + c);
                    f32x4 o0 = acc[ai][bj][m][0], o1 = acc[ai][bj][m][1];
                    o0[0] *= bflo(g.x); o0[1] *= bfhi(g.x); o0[2] *= bflo(g.y); o0[3] *= bfhi(g.y); o1[0] *= bflo(g.z); o1[1] *= bfhi(g.z); o1[2] *= bflo(g.w); o1[3] *= bfhi(g.w);
                    *(f32x4*)(tmp + r * 2048 + c) = o0; *(f32x4*)(tmp + r * 2048 + c + 4) = o1; } }
    }
};
struct EpiGateB {
    static constexpr bool PERM = true, AFTER_DRAIN = false;
    const bf16_t* gates; const float* tmp; bf16_t* out;
    __device__ __forceinline__ void operator()(const f32x4 (&acc)[2][2][4][2], const Unit& u, int wr, int wc, int fr, int fq) const {
        const int row0 = u.pm * BM + wr * 64 + fr, col0 = u.pn * BM + wc * 32 + 8 * fq;
#pragma unroll
        for (int ai = 0; ai < 2; ++ai)
#pragma unroll
            for (int m = 0; m < 4; ++m) { const size_t r = (size_t)(row0 + ai * HALF + m * 16);
#pragma unroll
                for (int bj = 0; bj < 2; ++bj) { const int c = col0 + bj * HALF; const u32x4 g = *(const u32x4*)(gates + r * 4096 + c);
                    f32x4 o0 = *(const f32x4*)(tmp + r * 2048 + c), o1 = *(const f32x4*)(tmp + r * 2048 + c + 4); const f32x4 a0 = acc[ai][bj][m][0], a1 = acc[ai][bj][m][1];
                    o0[0] += a0[0] * bflo(g.x); o0[1] += a0[1] * bfhi(g.x); o0[2] += a0[2] * bflo(g.y); o0[3] += a0[3] * bfhi(g.y);
                    o1[0] += a1[0] * bflo(g.z); o1[1] += a1[1] * bfhi(g.z); o1[2] += a1[2] * bflo(g.w); o1[3] += a1[3] * bfhi(g.w);
                    u32x4 w; w.x = cvt_pk_bf16(o0[0], o0[1]); w.y = cvt_pk_bf16(o0[2], o0[3]); w.z = cvt_pk_bf16(o1[0], o1[1]); w.w = cvt_pk_bf16(o1[2], o1[3]);
                    *(u32x4*)(out + r * 2048 + c) = w; } }
    }
};
template <bool RES_BF16> struct EpiRes {
    static constexpr bool PERM = true, AFTER_DRAIN = false;
    const void* resid; bf16_t* outb; float* sumsq;
    __device__ __forceinline__ void operator()(const f32x4 (&acc)[2][2][4][2], const Unit& u, int wr, int wc, int fr, int fq) const {
        const int row0 = u.pm * BM + wr * 64 + fr, col0 = u.pn * BM + wc * 32 + 8 * fq;
#pragma unroll
        for (int ai = 0; ai < 2; ++ai)
#pragma unroll
            for (int m = 0; m < 4; ++m) { const size_t r = (size_t)(row0 + ai * HALF + m * 16); float ss = 0.f;
#pragma unroll
                for (int bj = 0; bj < 2; ++bj) { const int c = col0 + bj * HALF; f32x4 o0, o1;
                    if (RES_BF16) { const u32x4 g = *(const u32x4*)((const bf16_t*)resid + r * 2048 + c);
                        o0 = (f32x4){bflo(g.x), bfhi(g.x), bflo(g.y), bfhi(g.y)} + acc[ai][bj][m][0]; o1 = (f32x4){bflo(g.z), bfhi(g.z), bflo(g.w), bfhi(g.w)} + acc[ai][bj][m][1]; }
                    else { o0 = *(const f32x4*)((const float*)resid + r * 2048 + c) + acc[ai][bj][m][0]; o1 = *(const f32x4*)((const float*)resid + r * 2048 + c + 4) + acc[ai][bj][m][1]; }
                    ss += (o0[0] * o0[0] + o0[1] * o0[1]) + (o0[2] * o0[2] + o0[3] * o0[3]) + (o1[0] * o1[0] + o1[1] * o1[1]) + (o1[2] * o1[2] + o1[3] * o1[3]);
                    u32x4 w; w.x = cvt_pk_bf16(o0[0], o0[1]); w.y = cvt_pk_bf16(o0[2], o0[3]); w.z = cvt_pk_bf16(o1[0], o1[1]); w.w = cvt_pk_bf16(o1[2], o1[3]); *(u32x4*)(outb + r * 2048 + c) = w; }
                ss += __shfl_xor(ss, 16); ss += __shfl_xor(ss, 32);
                if (fq == 0) atomicAdd(sumsq + r, ss); }
    }
};
struct EpiQ {
    static constexpr bool PERM = true, AFTER_DRAIN = false;
    const float* sumsq; bf16_t* out; float scale;
    __device__ __forceinline__ void operator()(const f32x4 (&acc)[2][2][4][2], const Unit& u, int wr, int wc, int fr, int fq) const {
        const int row0 = u.pm * BM + wr * 64 + fr, col0 = u.pn * BM + wc * 32 + 8 * fq;
#pragma unroll
        for (int ai = 0; ai < 2; ++ai)
#pragma unroll
            for (int m = 0; m < 4; ++m) { const size_t r = (size_t)(row0 + ai * HALF + m * 16); const float rs = rsqrtf(sumsq[r] * (1.f / 2048.f) + RMS_EPS_) * scale;
#pragma unroll
                for (int bj = 0; bj < 2; ++bj) { const int c = col0 + bj * HALF; const f32x4 v0 = acc[ai][bj][m][0] * rs, v1 = acc[ai][bj][m][1] * rs;
                    u32x4 w; w.x = cvt_pk_bf16(v0[0], v0[1]); w.y = cvt_pk_bf16(v0[2], v0[3]); w.z = cvt_pk_bf16(v1[0], v1[1]); w.w = cvt_pk_bf16(v1[2], v1[3]);
                    *(u32x4*)(out + r * 512 + c) = w; } }
    }
};
struct EpiSwiGLU {
    static constexpr bool PERM = true, AFTER_DRAIN = false;
    const float* sumsq; bf16_t* out;
    __device__ __forceinline__ void operator()(const f32x4 (&acc)[2][2][4][2], const Unit& u, int wr, int wc, int fr, int fq) const {
        const int row0 = u.pm * BM + wr * 64 + fr, col0 = u.pn * HALF + wc * 32 + 8 * fq;
#pragma unroll
        for (int ai = 0; ai < 2; ++ai)
#pragma unroll
            for (int m = 0; m < 4; ++m) { const size_t r = (size_t)(row0 + ai * HALF + m * 16); const float rs = rsqrtf(sumsq[r] * (1.f / 2048.f) + RMS_EPS_);
                float g[8];
#pragma unroll
                for (int n = 0; n < 2; ++n)
#pragma unroll
                    for (int e = 0; e < 4; ++e) g[4 * n + e] = silu(acc[ai][0][m][n][e] * rs) * (acc[ai][1][m][n][e] * rs);
                u32x4 w; w.x = cvt_pk_bf16(g[0], g[1]); w.y = cvt_pk_bf16(g[2], g[3]); w.z = cvt_pk_bf16(g[4], g[5]); w.w = cvt_pk_bf16(g[6], g[7]);
                *(u32x4*)(out + r * 5632 + col0) = w; }
    }
};
struct Unit2 : Unit { const char* A; const char* B; int nt; int mode, slot, aux, pstr; };
__device__ __forceinline__ void part_store(const f32x4 (&acc)[2][2][4][2], float* part, unsigned* flags, const Unit2& u, int tid, int lane) {
    float* p = part + ((size_t)(u.slot * u.pstr + u.aux) * 32) * 2048 + (size_t)tid * 4;
#pragma unroll
    for (int ai = 0; ai < 2; ++ai)
#pragma unroll
        for (int bj = 0; bj < 2; ++bj)
#pragma unroll
            for (int m = 0; m < 4; ++m)
#pragma unroll
                for (int n = 0; n < 2; ++n) *(f32x4*)(p + (size_t)(((ai * 2 + bj) * 4 + m) * 2 + n) * 2048) = acc[ai][bj][m][n];
    __builtin_amdgcn_fence(__ATOMIC_RELEASE, "agent");
    asm volatile("s_waitcnt vmcnt(0)" ::: "memory");
    if (lane == 0) __hip_atomic_fetch_add(flags + 16 * u.slot, 1u, __ATOMIC_RELAXED, __HIP_MEMORY_SCOPE_AGENT);
}
__device__ __forceinline__ void part_wait_add(f32x4 (&acc)[2][2][4][2], const float* part, unsigned* flags, const Unit2& u, int tid, int lane) {
    const int np = (u.mode == 2) ? u.aux : 0;
    if (np > 0) { const unsigned want = 8u * (unsigned)np; unsigned spins = 0;
        for (;;) { unsigned v = 0; if (lane == 0) v = __hip_atomic_load(flags + 16 * u.slot, __ATOMIC_RELAXED, __HIP_MEMORY_SCOPE_AGENT);
            if ((unsigned)__builtin_amdgcn_readfirstlane(v) >= want) break;
            __builtin_amdgcn_s_sleep(1); if (++spins > (1u << 20)) break; }
        __builtin_amdgcn_fence(__ATOMIC_ACQUIRE, "agent"); }
    for (int pi = 0; pi < np; ++pi) { const float* p = part + ((size_t)(u.slot * u.pstr + pi) * 32) * 2048 + (size_t)tid * 4;
#pragma unroll
        for (int ai = 0; ai < 2; ++ai)
#pragma unroll
            for (int bj = 0; bj < 2; ++bj) {
#pragma unroll
                for (int m = 0; m < 4; ++m)
#pragma unroll
                    for (int n = 0; n < 2; ++n) acc[ai][bj][m][n] += *(const f32x4*)(p + (size_t)(((ai * 2 + bj) * 4 + m) * 2 + n) * 2048);
                asm volatile("" ::: "memory"); } }
}

template <class Epi, class Sched>
__device__ __forceinline__ void gemm_phase2(PG8_LAS unsigned char* lds, const Sched& S, const Epi& E, float* part, unsigned* flags, const unsigned ld2  ) {
    const int tid = threadIdx.x, wid = __builtin_amdgcn_readfirstlane(tid >> 6), lane = tid & 63, wr = wid >> 2, wc = wid & 3, fr = lane & 15, fq = lane >> 4;
    unsigned voffA[2], voffB[2];
#pragma unroll
    for (int i = 0; i < 2; ++i) { int R, C; stage_rc(tid * 16 + i * 8192, R, C); const int Rb = Epi::PERM ? ((R & ~31) + perm32(R & 31)) : R;
        voffA[i] = (unsigned)R * ld2 + (unsigned)C * 2u; voffB[i] = (unsigned)Rb * ld2 + (unsigned)C * 2u; }
    const size_t kstep = (size_t)(BK * 2);
    const size_t hs = (size_t)HALF * ld2;
    const unsigned ldsw = (unsigned)wid * 1024u;
    const int aoff = lds_byte(wr * 64 + fr, fq * 8), boff = lds_byte(wc * 32 + fr, fq * 8);
#define PG8_SA(b, h) (((b) * 2 + (h)) * HTB)
#define PG8_SB(b, h) ((4 + (b) * 2 + (h)) * HTB)
#define PG8_STAGE(bufoff, gbase, voff) do { _Pragma("unroll") for (int _i = 0; _i < 2; ++_i) \
        __builtin_amdgcn_global_load_lds((const unsigned*)((const char*)(gbase) + (voff)[_i]), (PG8_LAS unsigned*)(lds + (bufoff) + ldsw + _i * 8192), 16, 0, 0); } while (0)
#define PG8_LDA(dst, b, h) do { _Pragma("unroll") for (int m = 0; m < 4; ++m) _Pragma("unroll") for (int k = 0; k < 2; ++k) dst[m][k] = *(const PG8_LAS bf16x8*)(lds + PG8_SA(b, h) + aoff + m * 2048 + k * 1024); } while (0)
#define PG8_LDB(dst, b, h) do { _Pragma("unroll") for (int n = 0; n < 2; ++n) _Pragma("unroll") for (int k = 0; k < 2; ++k) dst[n][k] = *(const PG8_LAS bf16x8*)(lds + PG8_SB(b, h) + boff + n * 2048 + k * 1024); } while (0)
#define PG8_MMA(ai, bj, At, Bt) do { __builtin_amdgcn_s_setprio(1); _Pragma("unroll") for (int m = 0; m < 4; ++m) _Pragma("unroll") for (int n = 0; n < 2; ++n) _Pragma("unroll") for (int k = 0; k < 2; ++k) \
        acc[ai][bj][m][n] = __builtin_amdgcn_mfma_f32_16x16x32_bf16(Bt[n][k], At[m][k], acc[ai][bj][m][n], 0, 0, 0); __builtin_amdgcn_s_setprio(0); } while (0)
#define PG8_WAIT_V(n) asm volatile("s_waitcnt vmcnt(" #n ")" ::: "memory")
#define PG8_WAIT_L(n) asm volatile("s_waitcnt lgkmcnt(" #n ")" ::: "memory")
#define PG8_BAR __builtin_amdgcn_s_barrier()
#define PG8_SCHED __builtin_amdgcn_sched_barrier(0)
    Unit2 cur, nxt; int ui = 0;
    if (!S.next(0, cur)) return;
    f32x4 acc[2][2][4][2];
#pragma unroll
    for (int a = 0; a < 2; ++a)
#pragma unroll
        for (int b = 0; b < 2; ++b)
#pragma unroll
            for (int m = 0; m < 4; ++m)
#pragma unroll
                for (int n = 0; n < 2; ++n) acc[a][b][m][n] = (f32x4){0.f, 0.f, 0.f, 0.f};
    bf16x8 At[4][2], B0[2][2], B1[2][2];
    const char* cA = cur.A; const char* cB = cur.B;
    {
        PG8_STAGE(PG8_SB(0, 0), cB, voffB); PG8_STAGE(PG8_SB(0, 1), cB + hs, voffB); PG8_STAGE(PG8_SA(0, 0), cA, voffA); PG8_STAGE(PG8_SA(0, 1), cA + hs, voffA);
        if (wr == 1) PG8_BAR;
        PG8_WAIT_V(2); PG8_BAR;
        PG8_STAGE(PG8_SB(1, 0), cB + kstep, voffB); PG8_STAGE(PG8_SA(1, 0), cA + kstep, voffA); PG8_STAGE(PG8_SB(1, 1), cB + hs + kstep, voffB);
        PG8_WAIT_V(6); PG8_BAR;
    }
    for (;;) {
        const bool has_next = S.next(ui + 1, nxt);
        const char* nA = has_next ? nxt.A : cA; const char* nB = has_next ? nxt.B : cB;
        const int nt = cur.nt;
        for (int t = 0; t < nt; t += 2) {
            const bool last = (t == nt - 2);
            const char* a1 = cA + (size_t)(t + 1) * kstep;
            const char* a2 = last ? nA : cA + (size_t)(t + 2) * kstep; const char* b2 = last ? nB : cB + (size_t)(t + 2) * kstep;
            const char* a3 = a2 + kstep; const char* b3 = b2 + kstep;
            PG8_LDB(B0, 0, 0); PG8_LDB(B1, 0, 1); PG8_SCHED; PG8_LDA(At, 0, 0); PG8_STAGE(PG8_SA(1, 1), a1 + hs, voffA);
            PG8_WAIT_V(8); PG8_WAIT_L(0); PG8_BAR; PG8_MMA(0, 0, At, B0); PG8_MMA(0, 1, At, B1); PG8_BAR; PG8_SCHED;
            PG8_LDA(At, 0, 1); PG8_STAGE(PG8_SB(0, 0), b2, voffB); PG8_STAGE(PG8_SB(0, 1), b2 + hs, voffB); PG8_STAGE(PG8_SA(0, 0), a2, voffA);
            PG8_WAIT_V(8); PG8_WAIT_L(0); PG8_BAR; PG8_MMA(1, 0, At, B0); PG8_MMA(1, 1, At, B1); PG8_BAR; PG8_SCHED;
            PG8_LDB(B0, 1, 0); PG8_LDB(B1, 1, 1); PG8_SCHED; PG8_LDA(At, 1, 0); PG8_STAGE(PG8_SA(0, 1), a2 + hs, voffA);
            PG8_WAIT_V(8); PG8_WAIT_L(0); PG8_BAR; PG8_MMA(0, 0, At, B0); PG8_MMA(0, 1, At, B1); PG8_BAR; PG8_SCHED;
            PG8_LDA(At, 1, 1); PG8_STAGE(PG8_SB(1, 0), b3, voffB); PG8_STAGE(PG8_SB(1, 1), b3 + hs, voffB); PG8_STAGE(PG8_SA(1, 0), a3, voffA);
            PG8_WAIT_V(8); PG8_WAIT_L(0); PG8_BAR; PG8_MMA(1, 0, At, B0); PG8_MMA(1, 1, At, B1); PG8_BAR; PG8_SCHED;
        }
        if (wr == 0) PG8_BAR;
        {
            int tid_ = tid, lane_ = lane, fr_ = fr, fq_ = fq; asm volatile("" : "+v"(tid_), "+v"(lane_), "+v"(fr_), "+v"(fq_));
            E(acc, cur, wr, wc, fr_, fq_); }
        if (!has_next) break;
        if (cur.mode != 3) {
#pragma unroll
            for (int a = 0; a < 2; ++a)
#pragma unroll
                for (int b = 0; b < 2; ++b)
#pragma unroll
                    for (int m = 0; m < 4; ++m)
#pragma unroll
                        for (int n = 0; n < 2; ++n) acc[a][b][m][n] = (f32x4){0.f, 0.f, 0.f, 0.f};
        }
        cur = nxt; cA = nA; cB = nB; ++ui;
        if (wr == 1) PG8_BAR;
    }
    PG8_WAIT_V(0);
    PG8_BAR;
#undef PG8_SA
#undef PG8_SB
#undef PG8_STAGE
#undef PG8_LDA
#undef PG8_LDB
#undef PG8_MMA
#undef PG8_WAIT_V
#undef PG8_WAIT_L
#undef PG8_BAR
#undef PG8_SCHED
}

__device__ __forceinline__ void unit_of(int L, int nM, int nN, int& pm, int& pn) {
    const int nwg = nM * nN;
    if (L >= nwg) { const int e = L - nwg; pm = nM + (e >> 2); pn = nN + (e & 3); return; }
    int wgid = L; { const int q = nwg / NXCD, r = nwg % NXCD, xcd = wgid % NXCD, off = wgid / NXCD; wgid = (xcd < r ? xcd * (q + 1) : r * (q + 1) + (xcd - r) * q) + off; }
    const int nig = WGM * nN, gid = wgid / nig, fm = gid * WGM, gsz = (nM - fm) < WGM ? (nM - fm) : WGM;
    pm = fm + ((wgid % nig) % gsz); pn = (wgid % nig) / gsz;
}
struct SplitOrder {
    const bf16_t* A; const bf16_t* B; int K, nM, nN, U, G, c, nfull, tail, ways;
    __device__ __forceinline__ void init(const bf16_t* A_, const bf16_t* B_, int M, int N, int K_, int nextra, int G_, int c_) {
        A = A_; B = B_; K = K_; nM = M / BM; nN = N / BM; U = nM * nN + nextra; G = G_; c = c_; nfull = U / G; tail = U - nfull * G;
        ways = 1;
    }
    __device__ __forceinline__ bool next(int i, Unit2& u) const {
        int L, kt0 = 0, ntu = K / BK; u.mode = 0; u.slot = 0; u.aux = 0; u.pstr = ways - 1;
        if (i < nfull) L = i * G + c;
        else if (i == nfull && c < tail * ways) { const int j = c % tail, p = c / tail; L = nfull * G + j;
            if (ways > 1) { ntu = (K / BK) / ways; kt0 = p * ntu; u.mode = (p == 0) ? 2 : 1; u.slot = j; u.aux = (p == 0) ? ways - 1 : p - 1; } }
        else return false;
        unit_of(L, nM, nN, u.pm, u.pn);
        u.A = (const char*)(A + (size_t)u.pm * BM * K + (size_t)kt0 * BK); u.B = (const char*)(B + (size_t)u.pn * BM * K + (size_t)kt0 * BK); u.nt = ntu;
        return true;
    }
};
struct DeferOrder {
    const bf16_t* A; const bf16_t* B; int K, d0, d1, step;
    __device__ __forceinline__ bool next(int i, Unit2& u) const {
        const int d = d0 + i * step; if (d >= d1) return false;
        if (d < 64) { u.pm = d >> 1; u.pn = 48 + (d & 1); } else { const int e = d - 64; u.pm = 32 + (e >> 2); u.pn = 50 + (e & 3); }
        u.mode = 0; u.slot = 0; u.aux = 0; u.pstr = 0; u.nt = K / BK;
        u.A = (const char*)(A + (size_t)u.pm * BM * K); u.B = (const char*)(B + (size_t)u.pn * BM * K);
        return true;
    }
};
struct ChainOrder {
    const bf16_t *A, *B; int K, nt1, nM, nN, G, c;
    __device__ __forceinline__ bool next(int i, Unit2& u) const {
        const int L = (i >> 1) * G + c; if (L >= nM * nN) return false;
        unit_of(L, nM, nN, u.pm, u.pn); u.slot = 0; u.aux = 0; u.pstr = 0;
        const int kt0 = (i & 1) ? nt1 : 0; u.nt = (i & 1) ? K / BK - nt1 : nt1; u.mode = (i & 1) ? 0 : 3;
        u.A = (const char*)(A + (size_t)u.pm * BM * K + (size_t)kt0 * BK); u.B = (const char*)(B + (size_t)u.pn * BM * K + (size_t)kt0 * BK);
        return true;
    }
};
struct EpiFinal {
    static constexpr bool PERM = true, AFTER_DRAIN = false;
    const bf16_t* resid; float* out; float* sumsq; const float* wf; unsigned* cnt;
    __device__ __forceinline__ void operator()(f32x4 (&acc)[2][2][4][2], const Unit2& u, int wr, int wc, int fr, int fq) const {
        const int row0 = u.pm * BM + wr * 64 + fr, col0 = u.pn * BM + wc * 32 + 8 * fq;
#pragma unroll
        for (int ai = 0; ai < 2; ++ai)
#pragma unroll
            for (int m = 0; m < 4; ++m) { const size_t r = (size_t)(row0 + ai * HALF + m * 16); float ss = 0.f;
#pragma unroll
                for (int bj = 0; bj < 2; ++bj) { const int c = col0 + bj * HALF; const u32x4 g = *(const u32x4*)(resid + r * 2048 + c);
                    const f32x4 o0 = (f32x4){bflo(g.x), bfhi(g.x), bflo(g.y), bfhi(g.y)} + acc[ai][bj][m][0], o1 = (f32x4){bflo(g.z), bfhi(g.z), bflo(g.w), bfhi(g.w)} + acc[ai][bj][m][1];
                    acc[ai][bj][m][0] = o0; acc[ai][bj][m][1] = o1;
                    ss += (o0[0] * o0[0] + o0[1] * o0[1]) + (o0[2] * o0[2] + o0[3] * o0[3]) + (o1[0] * o1[0] + o1[1] * o1[1]) + (o1[2] * o1[2] + o1[3] * o1[3]); }
                ss += __shfl_xor(ss, 16); ss += __shfl_xor(ss, 32);
                if (fq == 0) atomicAdd(sumsq + r, ss); }
        asm volatile("s_waitcnt vmcnt(0)" ::: "memory");
        const int lane = fq * 16 + fr;
        if (lane == 0) __hip_atomic_fetch_add(cnt + 16 * u.pm, 1u, __ATOMIC_RELAXED, __HIP_MEMORY_SCOPE_AGENT);
        { unsigned spins = 0;
          for (;;) { unsigned v = 0; if (lane == 0) v = __hip_atomic_load(cnt + 16 * u.pm, __ATOMIC_RELAXED, __HIP_MEMORY_SCOPE_AGENT);
              if ((unsigned)__builtin_amdgcn_readfirstlane(v) >= 64u) break;
              __builtin_amdgcn_s_sleep(2); if (++spins > (1u << 20)) break; } }
#pragma unroll
        for (int ai = 0; ai < 2; ++ai)
#pragma unroll
            for (int m = 0; m < 4; ++m) { const size_t r = (size_t)(row0 + ai * HALF + m * 16);
                const float rs = rsqrtf(__hip_atomic_load(sumsq + r, __ATOMIC_RELAXED, __HIP_MEMORY_SCOPE_AGENT) * (1.f / 2048.f) + RMS_EPS_);
#pragma unroll
                for (int bj = 0; bj < 2; ++bj) { const int c = col0 + bj * HALF; const f32x4 w0 = *(const f32x4*)(wf + c), w1 = *(const f32x4*)(wf + c + 4);
                    *(f32x4*)(out + r * 2048 + c) = acc[ai][bj][m][0] * rs * w0; *(f32x4*)(out + r * 2048 + c + 4) = acc[ai][bj][m][1] * rs * w1; } }
    }
};
struct EpiMerge {
    static constexpr bool PERM = true, AFTER_DRAIN = false;
    const bf16_t* gates; bf16_t* out;
    __device__ __forceinline__ void operator()(f32x4 (&acc)[2][2][4][2], const Unit2& u, int wr, int wc, int fr, int fq) const {
        const int row0 = u.pm * BM + wr * 64 + fr, col0 = u.pn * BM + wc * 32 + 8 * fq;
#pragma unroll
        for (int ai = 0; ai < 2; ++ai)
#pragma unroll
            for (int m = 0; m < 4; ++m) { const size_t r = (size_t)(row0 + ai * HALF + m * 16);
#pragma unroll
                for (int bj = 0; bj < 2; ++bj) { const int c = col0 + bj * HALF; const u32x4 gb = *(const u32x4*)(gates + r * 4096 + 2048 + c);
                    float b[8] = {bflo(gb.x), bfhi(gb.x), bflo(gb.y), bfhi(gb.y), bflo(gb.z), bfhi(gb.z), bflo(gb.w), bfhi(gb.w)};
                    if (u.mode == 3) { const u32x4 ga = *(const u32x4*)(gates + r * 4096 + c);
                        const float a[8] = {bflo(ga.x), bfhi(ga.x), bflo(ga.y), bfhi(ga.y), bflo(ga.z), bfhi(ga.z), bflo(ga.w), bfhi(ga.w)};
#pragma unroll
                        for (int e = 0; e < 4; ++e) { acc[ai][bj][m][0][e] *= a[e] * __builtin_amdgcn_rcpf(fmaxf(b[e], 1e-30f)); acc[ai][bj][m][1][e] *= a[4 + e] * __builtin_amdgcn_rcpf(fmaxf(b[4 + e], 1e-30f)); } }
                    else { const f32x4 a0 = acc[ai][bj][m][0], a1 = acc[ai][bj][m][1];
                        u32x4 w; w.x = cvt_pk_bf16(a0[0] * b[0], a0[1] * b[1]); w.y = cvt_pk_bf16(a0[2] * b[2], a0[3] * b[3]); w.z = cvt_pk_bf16(a1[0] * b[4], a1[1] * b[5]); w.w = cvt_pk_bf16(a1[2] * b[6], a1[3] * b[7]);
                        *(u32x4*)(out + r * 2048 + c) = w; } } }
    }
};
}
using pg8::bf16_t; using pg8::bf16x8; using pg8::f32x4; using pg8::u32x4; using pg8::u32x2; using pg8::cvt_pk_bf16; using pg8::sigm; using pg8::bflo; using pg8::bfhi;
#define LAS __attribute__((address_space(3)))
constexpr int NTHR = 512;
constexpr int DMODEL = 2048, MTOK = 8192, SEQL = 2048, MMEM = 1024, DFF_ = 5632;
constexpr float EPS = 1e-6f;
constexpr float ATT_SCALE = 0.08838834764831845f;

constexpr size_t MiB = 1u << 20;
constexpr size_t WS_SUMSQ = 0;
constexpr size_t WS_LB = 128 * 1024;
constexpr size_t WS_BAR = 192 * 1024, BAR_BYTES = 48 * 1024, WS_FLAGS = WS_BAR + 16 * 1024;
constexpr size_t WS_LSE = 256 * 1024;
constexpr size_t WS_DEC = 1 * MiB;
constexpr size_t WS_WIN = 2 * MiB, WS_WKV = 52 * MiB, WS_WA = 56 * MiB, WS_WB = 58 * MiB, WS_WOUT = 62 * MiB, WS_WQ = 70 * MiB, WS_WO = 72 * MiB, WS_W13 = 74 * MiB, WS_W2 = 118 * MiB;
constexpr size_t WS_HN = 140 * MiB;
constexpr size_t WS_OG = 140 * MiB;
constexpr size_t WS_OATT = 164 * MiB;
constexpr size_t WS_QC = 164 * MiB;
constexpr size_t WS_OC = 140 * MiB;
constexpr size_t WS_QKV = 176 * MiB;
constexpr size_t WS_OCAT = 176 * MiB;
constexpr size_t WS_XB = 176 * MiB;
constexpr size_t WS_STB = 208 * MiB;
constexpr size_t WS_HG = 248 * MiB;
constexpr size_t WS_TMP = 248 * MiB;
constexpr size_t WS_G = 248 * MiB;
constexpr size_t WS_GATES = 312 * MiB;
constexpr size_t WS_KVC = 376 * MiB;
constexpr size_t WS_OHG = 378 * MiB;
constexpr size_t WS_END = 394 * MiB;

constexpr int LDS_BYTES = 147456, LDS_MISC = 147392;

__device__ __forceinline__ float wave_sum(float v) {
#pragma unroll
    for (int o = 1; o < 64; o <<= 1) v += __shfl_xor(v, o);
    return v;
}
#define LDS_FENCE() asm volatile("s_waitcnt lgkmcnt(0)" ::: "memory")

__device__ __forceinline__ void transpose_item(const float* __restrict__ W, int K, int N, bf16_t* WT, int dst_row0, const float* kscale, LAS float* scr, int k0, int n0, int lane, int dld = 0, int dcol = 0) {
    if (dld == 0) dld = K;
    const int lr = lane >> 4, lc = lane & 15;
    f32x4 v[16];
#pragma unroll
    for (int it = 0; it < 16; ++it) v[it] = __builtin_nontemporal_load((const f32x4*)(W + (size_t)(k0 + it * 4 + lr) * N + n0 + 4 * lc));
    if (kscale) {
#pragma unroll
        for (int it = 0; it < 16; ++it) v[it] = v[it] * kscale[k0 + it * 4 + lr]; }
#pragma unroll
    for (int it = 0; it < 16; ++it) { LAS float* d = scr + (it * 4 + lr) * 65 + 4 * lc; d[0] = v[it][0]; d[1] = v[it][1]; d[2] = v[it][2]; d[3] = v[it][3]; }
    LDS_FENCE();
    const int c = lane & 7;
#pragma unroll
    for (int j = 0; j < 8; ++j) { const int n = (lane >> 3) + 8 * j; const LAS float* s = scr + (8 * c) * 65 + n;
        u32x4 o; o.x = cvt_pk_bf16(s[0], s[65]); o.y = cvt_pk_bf16(s[130], s[195]); o.z = cvt_pk_bf16(s[260], s[325]); o.w = cvt_pk_bf16(s[390], s[455]);
        *(u32x4*)(WT + (size_t)(dst_row0 + n) * dld + dcol + k0 + 8 * c) = o; }
    LDS_FENCE();
}
__device__ __forceinline__ void rms_row_bf16(const float* xrow, const float* w, bf16_t* orow, int lane) {
    f32x4 v[8]; float s = 0.f;
#pragma unroll
    for (int j = 0; j < 8; ++j) { v[j] = __builtin_nontemporal_load(((const f32x4*)xrow) + lane + 64 * j); s += (v[j][0] * v[j][0] + v[j][1] * v[j][1]) + (v[j][2] * v[j][2] + v[j][3] * v[j][3]); }
    const float rstd = rsqrtf(wave_sum(s) * (1.f / 2048.f) + EPS);
#pragma unroll
    for (int j = 0; j < 8; ++j) { const f32x4 ww = ((const f32x4*)w)[lane + 64 * j]; const f32x4 o = v[j] * rstd * ww;
        u32x2 p; p.x = cvt_pk_bf16(o[0], o[1]); p.y = cvt_pk_bf16(o[2], o[3]); ((u32x2*)orow)[lane + 64 * j] = p; }
}

struct Args { const float* in[19]; float* out; unsigned char* ws; int ph_lo, ph_hi; };

__device__ __forceinline__ void phase_prologue(const Args& a, LAS unsigned char* lds, int tid) {
    const int lane = tid & 63, wave = tid >> 6; const int G = gridDim.x;
    LAS float* scr = (LAS float*)(lds + wave * 16896);
    const int gw = blockIdx.x * 8 + wave, NGW = G * 8;
    unsigned char* ws = a.ws;
    const float *w_in = a.in[3], *w_a = a.in[6], *w_b = a.in[7], *w_out = a.in[8], *wq = a.in[11], *wkv = a.in[12], *wo = a.in[13], *w1 = a.in[15], *w3 = a.in[16], *w2 = a.in[17];
    const float *ln_cross = a.in[9], *ln_ffn = a.in[14];
    constexpr int I_IN = 32 * 200, I_KV = 32 * 16, I_A = 8 * 32, I_B = 16 * 32, I_OUT = 32 * 32, I_Q = 32 * 8, I_O = 8 * 32, I_1 = 32 * 88, I_2 = 88 * 32;
    constexpr int NITEMS = I_IN + I_KV + I_A + I_B + I_OUT + I_Q + I_O + 2 * I_1 + I_2;
    for (int it = gw; it < NITEMS; it += NGW) {
        int r = it;
        if (r < I_IN) { transpose_item(w_in, 2048, 12800, (bf16_t*)(ws + WS_WIN), 64 * (r % 200), nullptr, scr, 64 * (r / 200), 64 * (r % 200), lane); continue; } r -= I_IN;
        if (r < I_KV) { transpose_item(wkv, 2048, 1024, (bf16_t*)(ws + WS_WKV), 64 * (r % 16), nullptr, scr, 64 * (r / 16), 64 * (r % 16), lane); continue; } r -= I_KV;
        if (r < I_A) { transpose_item(w_a, 512, 2048, (bf16_t*)(ws + WS_WA), 64 * (r % 32), nullptr, scr, 64 * (r / 32), 64 * (r % 32), lane, 1536, 0); continue; } r -= I_A;
        if (r < I_B) { transpose_item(w_b, 1024, 2048, (bf16_t*)(ws + WS_WA), 64 * (r % 32), nullptr, scr, 64 * (r / 32), 64 * (r % 32), lane, 1536, 512); continue; } r -= I_B;
        if (r < I_OUT) { transpose_item(w_out, 2048, 2048, (bf16_t*)(ws + WS_WOUT), 64 * (r % 32), nullptr, scr, 64 * (r / 32), 64 * (r % 32), lane); continue; } r -= I_OUT;
        if (r < I_Q) { transpose_item(wq, 2048, 512, (bf16_t*)(ws + WS_WQ), 64 * (r % 8), ln_cross, scr, 64 * (r / 8), 64 * (r % 8), lane); continue; } r -= I_Q;
        if (r < I_O) { transpose_item(wo, 512, 2048, (bf16_t*)(ws + WS_WO), 64 * (r % 32), nullptr, scr, 64 * (r / 32), 64 * (r % 32), lane); continue; } r -= I_O;
        if (r < I_1) { const int n0 = 64 * (r % 88); transpose_item(w1, 2048, 5632, (bf16_t*)(ws + WS_W13), 256 * (n0 >> 7) + (n0 & 127), ln_ffn, scr, 64 * (r / 88), n0, lane); continue; } r -= I_1;
        if (r < I_1) { const int n0 = 64 * (r % 88); transpose_item(w3, 2048, 5632, (bf16_t*)(ws + WS_W13), 256 * (n0 >> 7) + 128 + (n0 & 127), ln_ffn, scr, 64 * (r / 88), n0, lane); continue; } r -= I_1;
        transpose_item(w2, 5632, 2048, (bf16_t*)(ws + WS_W2), 64 * (r % 32), nullptr, scr, 64 * (r / 32), 64 * (r % 32), lane);
    }
    bf16_t* hn = (bf16_t*)(ws + WS_HN);
    for (int m = gw; m < MTOK + MMEM; m += NGW) {
        if (m < MTOK) rms_row_bf16(a.in[0] + (size_t)m * 2048, a.in[2], hn + (size_t)m * 2048, lane);
        else rms_row_bf16(a.in[1] + (size_t)(m - MTOK) * 2048, a.in[10], hn + (size_t)m * 2048, lane);
    }
    const int gt = blockIdx.x * NTHR + tid, NGT = G * NTHR;
    float* sumsq = (float*)(ws + WS_SUMSQ);
    for (int i = gt; i < 3 * 8192; i += NGT) sumsq[i] = 0.f;
    float* lb = (float*)(ws + WS_LB); const float* hlb = a.in[5];
    for (int i = gt; i < 1024; i += NGT) lb[i] = 1.f / (1.f + __expf(hlb[1024 + i] - hlb[i]));
}

constexpr int VTS = 132, KSS = 68;
constexpr int ATT_K_OFF = 128 * VTS * 4;
template <bool MASKED, bool QPRE = false>
__device__ __forceinline__ void attn_unit(LAS unsigned char* lds, const bf16_t* Qb, long qs, const bf16_t* Kown, long ks, const bf16_t* Vown, long vs, bool hasprev,
                                          bf16_t* Ob, long os, float* lsep, long lses, int tid, const bf16x8* qpre = nullptr) {
    const int lane = tid & 63, w = tid >> 6, fr = lane & 15, fq = lane >> 4;
    LAS unsigned* VT = (LAS unsigned*)lds; LAS unsigned* KS = (LAS unsigned*)(lds + ATT_K_OFF);
    const int iq = 16 * w + fr;
    u32x4 kx[8], vx[4], vy[4]; bf16x8 qf[4];
#pragma unroll
    for (int it = 0; it < 8; ++it) { const int id = tid + NTHR * it; long r = (id >> 4) - 128; if (!hasprev && r < 0) r = 0; kx[it] = *(const u32x4*)(Kown + r * ks + 8 * (id & 15)); }
#pragma unroll
    for (int it = 0; it < 4; ++it) { const int task = tid + NTHR * it; const int c = task & 15, p = task >> 4;
        long r0 = 2 * p - 128; if (!hasprev && r0 < 0) r0 = 0;
        const bf16_t* src = Vown + r0 * vs + 8 * c; vx[it] = *(const u32x4*)src; vy[it] = *(const u32x4*)(src + vs); }
#pragma unroll
    for (int k4 = 0; k4 < 4; ++k4) { if (QPRE) qf[k4] = qpre[k4]; else qf[k4] = *(const bf16x8*)(Qb + (long)iq * qs + 32 * k4 + 8 * fq); }
    __syncthreads();
#pragma unroll
    for (int it = 0; it < 8; ++it) { const int id = tid + NTHR * it; *(LAS u32x4*)(KS + (id >> 4) * KSS + 4 * (id & 15)) = kx[it]; }
#pragma unroll
    for (int it = 0; it < 4; ++it) { const int task = tid + NTHR * it; const int c = task & 15, p = task >> 4; const u32x4 x = vx[it], y = vy[it];
        LAS unsigned* d = VT + (8 * c) * VTS + ((p + 2 * c) & 127);
        d[0 * VTS] = (x.x & 0xffffu) | (y.x << 16); d[1 * VTS] = (x.x >> 16) | (y.x & 0xffff0000u);
        d[2 * VTS] = (x.y & 0xffffu) | (y.y << 16); d[3 * VTS] = (x.y >> 16) | (y.y & 0xffff0000u);
        d[4 * VTS] = (x.z & 0xffffu) | (y.z << 16); d[5 * VTS] = (x.z >> 16) | (y.z & 0xffff0000u);
        d[6 * VTS] = (x.w & 0xffffu) | (y.w << 16); d[7 * VTS] = (x.w >> 16) | (y.w & 0xffff0000u); }
    __syncthreads();
    constexpr int NT = MASKED ? 10 : 16; const int t0 = MASKED ? w : 0;
    f32x4 s[NT];
    float mx = -INFINITY;
#pragma unroll
    for (int i = 0; i < NT; ++i) { const int t = t0 + i, tc = t < 15 ? t : 15;
        if (MASKED && i == 9) { s[i] = (f32x4){-INFINITY, -INFINITY, -INFINITY, -INFINITY}; continue; }
        const LAS unsigned* kp = KS + (16 * tc + fr) * KSS + 4 * fq;
        f32x4 acc = {0.f, 0.f, 0.f, 0.f};
#pragma unroll
        for (int k4 = 0; k4 < 4; ++k4) { const bf16x8 kf = __builtin_bit_cast(bf16x8, *(const LAS u32x4*)(kp + 16 * k4)); acc = __builtin_amdgcn_mfma_f32_16x16x32_bf16(kf, qf[k4], acc, 0, 0, 0); }
        if (!MASKED) {
#pragma unroll
            for (int j = 0; j < 4; ++j) { const float v = acc[j] * ATT_SCALE; acc[j] = v; mx = fmaxf(mx, v); } }
        else if (i == 0 || i == 8) {
#pragma unroll
            for (int j = 0; j < 4; ++j) { const int kk = 16 * t + 4 * fq + j; const bool ok = (kk >= iq) && (kk <= iq + 128) && (hasprev || kk >= 128);
                const float v = ok ? acc[j] * ATT_SCALE : -INFINITY; acc[j] = v; mx = fmaxf(mx, v); } }
        else { const bool ok = (t <= 15) && (hasprev || t >= 8);
#pragma unroll
            for (int j = 0; j < 4; ++j) { const float v = ok ? acc[j] * ATT_SCALE : -INFINITY; acc[j] = v; mx = fmaxf(mx, v); } }
        s[i] = acc; }
    mx = fmaxf(mx, __shfl_xor(mx, 16)); mx = fmaxf(mx, __shfl_xor(mx, 32));
    float l = 0.f;
#pragma unroll
    for (int i = 0; i < NT; ++i)
#pragma unroll
        for (int j = 0; j < 4; ++j) { const float p = __expf(s[i][j] - mx); s[i][j] = p; l += p; }
    l += __shfl_xor(l, 16); l += __shfl_xor(l, 32);
    f32x4 o[8];
#pragma unroll
    for (int mt = 0; mt < 8; ++mt) o[mt] = (f32x4){0.f, 0.f, 0.f, 0.f};
#pragma unroll
    for (int sp = 0; sp < NT / 2; ++sp) { const int ta = t0 + 2 * sp, tb = ta + 1; const int tca = ta < 15 ? ta : 15, tcb = tb < 15 ? tb : 15;
        u32x4 pw; pw.x = cvt_pk_bf16(s[2 * sp][0], s[2 * sp][1]); pw.y = cvt_pk_bf16(s[2 * sp][2], s[2 * sp][3]); pw.z = cvt_pk_bf16(s[2 * sp + 1][0], s[2 * sp + 1][1]); pw.w = cvt_pk_bf16(s[2 * sp + 1][2], s[2 * sp + 1][3]);
        const bf16x8 pf = __builtin_bit_cast(bf16x8, pw);
#pragma unroll
        for (int mt = 0; mt < 8; ++mt) { const LAS unsigned* vr = VT + (16 * mt + fr) * VTS; const int rot = 2 * fq + 2 * (2 * mt + (fr >> 3));
            const u32x2 lo = *(const LAS u32x2*)(vr + ((8 * tca + rot) & 127)), hi = *(const LAS u32x2*)(vr + ((8 * tcb + rot) & 127));
            u32x4 vw; vw.x = lo.x; vw.y = lo.y; vw.z = hi.x; vw.w = hi.y;
            o[mt] = __builtin_amdgcn_mfma_f32_16x16x32_bf16(__builtin_bit_cast(bf16x8, vw), pf, o[mt], 0, 0, 0); } }
    const float il = 1.f / l;
    bf16_t* op = Ob + (long)iq * os + 4 * fq;
#pragma unroll
    for (int mt = 0; mt < 8; ++mt) { u32x2 wv; wv.x = cvt_pk_bf16(o[mt][0] * il, o[mt][1] * il); wv.y = cvt_pk_bf16(o[mt][2] * il, o[mt][3] * il); *(u32x2*)(op + 16 * mt) = wv; }
    if (lsep && fq == 0) lsep[(long)iq * lses] = mx + __logf(l);
}

constexpr int QB_STRIDE = 144, QB_BYTES = 128 * QB_STRIDE, QT_OFF = 2 * QB_BYTES, QT_STRIDE = 272;
__device__ __forceinline__ void cross_q_tile(LAS unsigned char* lds, const bf16_t* XBp, const bf16_t* WQT, const float* ssq, int tid, bf16x8 (&qf)[4]) {
    const int lane = tid & 63, w = tid >> 6, fr = lane & 15, fq = lane >> 4;
    const bf16_t* ap = XBp + (size_t)(16 * w + fr) * 2048 + 8 * fq;
    const int br = tid >> 3, bc = tid & 7;
    const bf16_t* bp = WQT + (size_t)br * 2048 + 8 * bc;
    f32x4 acc[8];
#pragma unroll
    for (int nt = 0; nt < 8; ++nt) acc[nt] = (f32x4){0.f, 0.f, 0.f, 0.f};
    u32x4 b0[4], b1[4]; bf16x8 a0[4], a1[4];
#pragma unroll
    for (int i = 0; i < 4; ++i) { b0[i] = *(const u32x4*)(bp + 64 * i); b1[i] = *(const u32x4*)(bp + (size_t)64 * 2048 + 64 * i); a0[i] = *(const bf16x8*)(ap + 64 * i); a1[i] = *(const bf16x8*)(ap + 64 * i + 32); }
    __syncthreads();
    for (int kq = 0; kq < 8; ++kq) {
#pragma unroll
        for (int i = 0; i < 4; ++i) { const int kc = 4 * kq + i;
            LAS unsigned char* buf = lds + (i & 1) * QB_BYTES;
            *(LAS u32x4*)(buf + br * QB_STRIDE + 16 * bc) = b0[i]; *(LAS u32x4*)(buf + (br + 64) * QB_STRIDE + 16 * bc) = b1[i];
            const bf16x8 c0 = a0[i], c1 = a1[i];
            if (kq < 7) { b0[i] = *(const u32x4*)(bp + 64 * (kc + 4)); b1[i] = *(const u32x4*)(bp + (size_t)64 * 2048 + 64 * (kc + 4)); a0[i] = *(const bf16x8*)(ap + 64 * (kc + 4)); a1[i] = *(const bf16x8*)(ap + 64 * (kc + 4) + 32); }
            __syncthreads();
#pragma unroll
            for (int nt = 0; nt < 8; ++nt) { const LAS unsigned char* rp = buf + (16 * nt + fr) * QB_STRIDE + 16 * fq;
                const bf16x8 f0 = __builtin_bit_cast(bf16x8, *(const LAS u32x4*)rp), f1 = __builtin_bit_cast(bf16x8, *(const LAS u32x4*)(rp + 64));
                acc[nt] = __builtin_amdgcn_mfma_f32_16x16x32_bf16(c0, f0, acc[nt], 0, 0, 0); acc[nt] = __builtin_amdgcn_mfma_f32_16x16x32_bf16(c1, f1, acc[nt], 0, 0, 0); } }
    }
    float rs[4];
#pragma unroll
    for (int j = 0; j < 4; ++j) rs[j] = rsqrtf(ssq[16 * w + 4 * fq + j] * (1.f / 2048.f) + EPS);
    LAS unsigned char* qt = lds + QT_OFF;
#pragma unroll
    for (int nt = 0; nt < 8; ++nt)
#pragma unroll
        for (int j = 0; j < 4; ++j) *(LAS bf16_t*)(qt + (16 * w + 4 * fq + j) * QT_STRIDE + 2 * (16 * nt + fr)) = (bf16_t)(cvt_pk_bf16(acc[nt][j] * rs[j], 0.f) & 0xffffu);
    __syncthreads();
#pragma unroll
    for (int k4 = 0; k4 < 4; ++k4) qf[k4] = __builtin_bit_cast(bf16x8, *(const LAS u32x4*)(qt + (16 * w + fr) * QT_STRIDE + 2 * (32 * k4 + 8 * fq)));
}

__device__ __forceinline__ void hg_gates(const unsigned (&fw)[8], float lb0, float lb1, LAS float* psum, int tid, float (&f)[2][8], float (&b)[2][8], float (&tot)[2]) {
    const int k0 = 2 * (tid & 63), part = tid >> 6;
    float r0 = 0.f, r1 = 0.f;
#pragma unroll
    for (int cc = 0; cc < 8; ++cc) { const float f0 = lb0 + (1.f - lb0) * sigm(bflo(fw[cc])), f1 = lb1 + (1.f - lb1) * sigm(bfhi(fw[cc]));
        f[0][cc] = f0; f[1][cc] = f1; r0 += __logf(f0); r1 += __logf(f1); b[0][cc] = r0; b[1][cc] = r1; }
    psum[part * 128 + k0] = r0; psum[part * 128 + k0 + 1] = r1;
    __syncthreads();
    float off0 = 0.f, off1 = 0.f, t0 = 0.f, t1 = 0.f;
#pragma unroll
    for (int p = 0; p < 8; ++p) { const float a0 = psum[p * 128 + k0], a1 = psum[p * 128 + k0 + 1]; if (p < part) { off0 += a0; off1 += a1; } t0 += a0; t1 += a1; }
#pragma unroll
    for (int cc = 0; cc < 8; ++cc) { b[0][cc] += off0; b[1][cc] += off1; }
    tot[0] = t0; tot[1] = t1;
}
constexpr int HS = 36;
__device__ __forceinline__ void hg_write_vt(const u32x4 x, const u32x4 y, LAS unsigned* VTh, int tid) {
    const int p = tid & 31, ch = tid >> 5;
    LAS unsigned* d = VTh + (8 * ch) * HS + p;
    d[0 * HS] = (x.x & 0xffffu) | (y.x << 16); d[1 * HS] = (x.x >> 16) | (y.x & 0xffff0000u);
    d[2 * HS] = (x.y & 0xffffu) | (y.y << 16); d[3 * HS] = (x.y >> 16) | (y.y & 0xffff0000u);
    d[4 * HS] = (x.z & 0xffffu) | (y.z << 16); d[5 * HS] = (x.z >> 16) | (y.z & 0xffff0000u);
    d[6 * HS] = (x.w & 0xffffu) | (y.w << 16); d[7 * HS] = (x.w >> 16) | (y.w & 0xffff0000u);
}
struct HgIn { unsigned fw[8]; u32x4 x, y; float lb0, lb1; };
__device__ __forceinline__ void hg_load(HgIn& I, const bf16_t* hg, const float* lbp, int hu, int tid) {
    const int bh = hu >> 5, n = hu & 31, b_ = bh >> 3, h = bh & 7, row0 = b_ * 2048 + n * 64; const int k0 = 2 * (tid & 63), part = tid >> 6;
#pragma unroll
    for (int cc = 0; cc < 8; ++cc) I.fw[cc] = *(const unsigned*)(hg + (size_t)(row0 + part * 8 + cc) * 4096 + 1024 + h * 128 + k0);
    const bf16_t* src = hg + (size_t)(row0 + 2 * (tid & 31)) * 4096 + 2048 + h * 128 + 8 * (tid >> 5);
    I.x = *(const u32x4*)src; I.y = *(const u32x4*)(src + 4096);
    I.lb0 = lbp[h * 128 + k0]; I.lb1 = lbp[h * 128 + k0 + 1];
}
__device__ __forceinline__ void hg_kv_phase(LAS unsigned char* lds, const bf16_t* hg, const float* lbp, bf16_t* ST, float* DEC, int tid, int bid, int G) {
    const int lane = tid & 63, w = tid >> 6, fr = lane & 15, fq = lane >> 4;
    LAS unsigned* VTh = (LAS unsigned*)lds;
    LAS unsigned* KDT = (LAS unsigned*)(lds + 18432);
    LAS float* psum = (LAS float*)(lds + 36864);
    const int k0 = 2 * (tid & 63), part = tid >> 6;
    HgIn I; if (bid < 1024) hg_load(I, hg, lbp, bid, tid);
    for (int hu = bid; hu < 1024; hu += G) {
        __syncthreads();
        hg_write_vt(I.x, I.y, VTh, tid);
        float f[2][8], b[2][8], tot[2];
        hg_gates(I.fw, I.lb0, I.lb1, psum, tid, f, b, tot);
        if (hu + G < 1024) hg_load(I, hg, lbp, hu + G, tid);
#pragma unroll
        for (int q = 0; q < 2; ++q) { float kd[8];
#pragma unroll
            for (int cc = 0; cc < 8; ++cc) kd[cc] = (1.f - f[q][cc]) * __expf(tot[q] - b[q][cc]);
            u32x4 wv; wv.x = cvt_pk_bf16(kd[0], kd[1]); wv.y = cvt_pk_bf16(kd[2], kd[3]); wv.z = cvt_pk_bf16(kd[4], kd[5]); wv.w = cvt_pk_bf16(kd[6], kd[7]);
            *(LAS u32x4*)(KDT + (k0 + q) * HS + 4 * part) = wv; }
        if (part == 0) { DEC[(size_t)hu * 128 + k0] = __expf(tot[0]); DEC[(size_t)hu * 128 + k0 + 1] = __expf(tot[1]); }
        __syncthreads();
        bf16x8 af[2];
#pragma unroll
        for (int k2 = 0; k2 < 2; ++k2) af[k2] = __builtin_bit_cast(bf16x8, *(const LAS u32x4*)(VTh + (16 * w + fr) * HS + 16 * k2 + 4 * fq));
        bf16_t* stp = ST + (size_t)hu * 16384 + (size_t)(16 * w + 4 * fq) * 128 + fr;
#pragma unroll
        for (int nt = 0; nt < 8; ++nt) { f32x4 acc = {0.f, 0.f, 0.f, 0.f};
#pragma unroll
            for (int k2 = 0; k2 < 2; ++k2) { const bf16x8 bf = __builtin_bit_cast(bf16x8, *(const LAS u32x4*)(KDT + (16 * nt + fr) * HS + 16 * k2 + 4 * fq)); acc = __builtin_amdgcn_mfma_f32_16x16x32_bf16(af[k2], bf, acc, 0, 0, 0); }
#pragma unroll
            for (int j = 0; j < 4; ++j) { const float nb = __shfl_down(acc[j], 1); if (!(fr & 1)) *(unsigned*)(stp + j * 128 + 16 * nt) = cvt_pk_bf16(acc[j], nb); } }
    }
}
constexpr int QS = 68;
__device__ __forceinline__ void hg_out_phase(LAS unsigned char* lds, const bf16_t* hg, const float* lbp, const float* hg_norm_w, const bf16_t* STB, bf16_t* OHG, int tid, int bid, int G) {
    const int lane = tid & 63, w = tid >> 6, fr = lane & 15, fq = lane >> 4;
    LAS unsigned* VTh = (LAS unsigned*)lds;
    LAS unsigned* QD = (LAS unsigned*)(lds + 18432);
    LAS unsigned* QM = (LAS unsigned*)(lds + 18432 + 17408);
    LAS unsigned* KM = (LAS unsigned*)(lds + 18432 + 2 * 17408);
    LAS float* psum = (LAS float*)(lds + 18432 + 3 * 17408);
    LAS float* bref = psum + 1024;
    LAS float* ssq = bref + 128;
    const int k0 = 2 * (tid & 63), part = tid >> 6, ct = w & 3, vh = w >> 2, c = 16 * ct + fr;
    HgIn I; unsigned qw[8];
    if (bid < 1024) { hg_load(I, hg, lbp, bid, tid); const int bh = bid >> 5, row0 = (bh >> 3) * 2048 + (bid & 31) * 64;
#pragma unroll
        for (int cc = 0; cc < 8; ++cc) qw[cc] = *(const unsigned*)(hg + (size_t)(row0 + part * 8 + cc) * 4096 + (bh & 7) * 128 + k0); }
    for (int hu = bid; hu < 1024; hu += G) {
        const int bh = hu >> 5, n = hu & 31, b_ = bh >> 3, h = bh & 7, row0 = b_ * 2048 + n * 64;
        u32x4 sa[4][4]; u32x2 gw[4]; f32x4 nw[4];
#pragma unroll
        for (int mi = 0; mi < 4; ++mi) { const bf16_t* sp = STB + (size_t)hu * 16384 + (size_t)(16 * (vh * 4 + mi) + fr) * 128 + 8 * fq;
#pragma unroll
            for (int k4 = 0; k4 < 4; ++k4) sa[mi][k4] = *(const u32x4*)(sp + 32 * k4);
            const int v0 = 16 * (vh * 4 + mi) + 4 * fq; gw[mi] = *(const u32x2*)(hg + (size_t)(row0 + c) * 4096 + 3072 + h * 128 + v0); nw[mi] = *(const f32x4*)(hg_norm_w + v0); }
        __syncthreads();
        hg_write_vt(I.x, I.y, VTh, tid);
        float f[2][8], b[2][8], tot[2];
        hg_gates(I.fw, I.lb0, I.lb1, psum, tid, f, b, tot);
        if (part == 4) { bref[k0] = b[0][0]; bref[k0 + 1] = b[1][0]; }
        __syncthreads();
        const float br0 = bref[k0], br1 = bref[k0 + 1];
#pragma unroll
        for (int cc = 0; cc < 8; ++cc) { const int c_ = part * 8 + cc; const float q0 = bflo(qw[cc]), q1 = bfhi(qw[cc]);
            const float e0 = __expf(b[0][cc] - br0), e1 = __expf(b[1][cc] - br1);
            QD[c_ * QS + (k0 >> 1)] = cvt_pk_bf16(q0 * __expf(b[0][cc]), q1 * __expf(b[1][cc]));
            QM[c_ * QS + (k0 >> 1)] = cvt_pk_bf16(q0 * e0, q1 * e1);
            KM[c_ * QS + (k0 >> 1)] = cvt_pk_bf16((1.f - f[0][cc]) * __builtin_amdgcn_rcpf(e0), (1.f - f[1][cc]) * __builtin_amdgcn_rcpf(e1)); }
        if (hu + G < 1024) { const int hn = hu + G; hg_load(I, hg, lbp, hn, tid); const int bhn = hn >> 5, row0n = (bhn >> 3) * 2048 + (hn & 31) * 64;
#pragma unroll
            for (int cc = 0; cc < 8; ++cc) qw[cc] = *(const unsigned*)(hg + (size_t)(row0n + part * 8 + cc) * 4096 + (bhn & 7) * 128 + k0); }
        __syncthreads();
        bf16x8 qmf[4];
#pragma unroll
        for (int k4 = 0; k4 < 4; ++k4) qmf[k4] = __builtin_bit_cast(bf16x8, *(const LAS u32x4*)(QM + (16 * ct + fr) * QS + 16 * k4 + 4 * fq));
        unsigned ap[4][2];
#pragma unroll
        for (int st = 0; st < 4; ++st) { f32x4 acc = {0.f, 0.f, 0.f, 0.f};
#pragma unroll
            for (int k4 = 0; k4 < 4; ++k4) { const bf16x8 kf = __builtin_bit_cast(bf16x8, *(const LAS u32x4*)(KM + (16 * st + fr) * QS + 16 * k4 + 4 * fq)); acc = __builtin_amdgcn_mfma_f32_16x16x32_bf16(kf, qmf[k4], acc, 0, 0, 0); }
#pragma unroll
            for (int j = 0; j < 4; ++j) { const int s_ = 16 * st + 4 * fq + j; if (s_ > c) acc[j] = 0.f; }
            ap[st][0] = cvt_pk_bf16(acc[0], acc[1]); ap[st][1] = cvt_pk_bf16(acc[2], acc[3]); }
        bf16x8 qdf[4];
#pragma unroll
        for (int k4 = 0; k4 < 4; ++k4) qdf[k4] = __builtin_bit_cast(bf16x8, *(const LAS u32x4*)(QD + (16 * ct + fr) * QS + 16 * k4 + 4 * fq));
        f32x4 o[4]; float ss = 0.f;
#pragma unroll
        for (int mi = 0; mi < 4; ++mi) { const int mt = vh * 4 + mi; f32x4 acc = {0.f, 0.f, 0.f, 0.f};
#pragma unroll
            for (int k4 = 0; k4 < 4; ++k4) acc = __builtin_amdgcn_mfma_f32_16x16x32_bf16(__builtin_bit_cast(bf16x8, sa[mi][k4]), qdf[k4], acc, 0, 0, 0);
#pragma unroll
            for (int s2 = 0; s2 < 2; ++s2) { const LAS unsigned* vr = VTh + (16 * mt + fr) * HS + 16 * s2 + 2 * fq;
                const u32x2 lo = *(const LAS u32x2*)vr, hi = *(const LAS u32x2*)(vr + 8);
                u32x4 vw; vw.x = lo.x; vw.y = lo.y; vw.z = hi.x; vw.w = hi.y;
                u32x4 pw; pw.x = ap[2 * s2][0]; pw.y = ap[2 * s2][1]; pw.z = ap[2 * s2 + 1][0]; pw.w = ap[2 * s2 + 1][1];
                acc = __builtin_amdgcn_mfma_f32_16x16x32_bf16(__builtin_bit_cast(bf16x8, vw), __builtin_bit_cast(bf16x8, pw), acc, 0, 0, 0); }
            o[mi] = acc; ss += (acc[0] * acc[0] + acc[1] * acc[1]) + (acc[2] * acc[2] + acc[3] * acc[3]); }
        ss += __shfl_xor(ss, 16); ss += __shfl_xor(ss, 32);
        if (fq == 0) ssq[vh * 64 + c] = ss;
        __syncthreads();
        const float rstd = rsqrtf((ssq[c] + ssq[64 + c]) * (1.f / 128.f) + EPS);
#pragma unroll
        for (int mi = 0; mi < 4; ++mi) { const int v0 = 16 * (vh * 4 + mi) + 4 * fq;
            u32x2 ov; ov.x = cvt_pk_bf16(o[mi][0] * rstd * nw[mi][0] * bflo(gw[mi].x), o[mi][1] * rstd * nw[mi][1] * bfhi(gw[mi].x)); ov.y = cvt_pk_bf16(o[mi][2] * rstd * nw[mi][2] * bflo(gw[mi].y), o[mi][3] * rstd * nw[mi][3] * bfhi(gw[mi].y));
            *(u32x2*)(OHG + (size_t)(row0 + c) * 1536 + 512 + h * 128 + v0) = ov; }
    }
}

#define XB_TMO      128
#define XB_XCNT(j)  (256  + 64 * (j))
#define XB_XSUB(j)  (1280 + 64 * (j))
#define XB_XGEN(j)  (2304 + 64 * (j))
#define XB_TOP      3328
#define XB_TOPGEN   3392
#define XCD_BAR_WORDS 3456
#define XB_SPIN_CAP (1u << 18)

__device__ __forceinline__ unsigned xb_ld(unsigned* p)              { return __hip_atomic_load(p, __ATOMIC_RELAXED, __HIP_MEMORY_SCOPE_AGENT); }
__device__ __forceinline__ unsigned xb_add(unsigned* p, unsigned v) { return __hip_atomic_fetch_add(p, v, __ATOMIC_RELAXED, __HIP_MEMORY_SCOPE_AGENT); }
__device__ __forceinline__ unsigned xb_xcc_id() { return (unsigned)__builtin_amdgcn_s_getreg((3 << 11) | 20) & 0xFu; }
#define XB_SPIN(cond, bar) do { unsigned _sp = 0; while (cond) { __builtin_amdgcn_s_sleep(1); \
    if ((++_sp & 255u) == 0u) { if (xb_ld(&(bar)[XB_TMO])) break; if (_sp > XB_SPIN_CAP) { atomicAdd(&(bar)[XB_TMO], 1u); break; } } } } while (0)

struct XcdBarrier {
    unsigned* bar; unsigned x;
    volatile LAS unsigned* st;
};

__device__ __forceinline__ XcdBarrier xcd_barrier_post(unsigned* bar, volatile LAS unsigned* st) {
    XcdBarrier b; b.bar = bar; b.x = xb_xcc_id(); b.st = st;
    if (threadIdx.x == 0) (void)xb_add(&bar[XB_XCNT(b.x)], 1u);
    return b;
}
__device__ __forceinline__ void xcd_barrier_complete(unsigned* bar, unsigned x, unsigned& nloc, unsigned& nx) {
    const unsigned G = gridDim.x * gridDim.y * gridDim.z;
    unsigned sum, cnt, mine, sp = 0u;
    for (;;) {
        sum = 0u; cnt = 0u; mine = 0u;
#pragma unroll
        for (unsigned j = 0; j < 16; ++j) { const unsigned c = xb_ld(&bar[XB_XCNT(j)]); sum += c; cnt += (c > 0u) ? 1u : 0u; mine = (j == x) ? c : mine; }
        if (sum == G) break;
        __builtin_amdgcn_s_sleep(1);
        if ((++sp & 255u) == 0u) { if (xb_ld(&bar[XB_TMO])) break; if (sp > XB_SPIN_CAP) { atomicAdd(&bar[XB_TMO], 1u); break; } }
    }
    nloc = mine > 0u ? mine : 1u; nx = cnt > 0u ? cnt : 1u;
}

__device__ __forceinline__ void xcd_barrier(const XcdBarrier& b) {
    asm volatile("s_waitcnt vmcnt(0)" ::: "memory");
    __syncthreads();
    if (threadIdx.x == 0) {
        unsigned* bar = b.bar;
        __builtin_amdgcn_s_waitcnt(0);
        unsigned nloc = b.st[0], nx = b.st[1];
        if (nloc == 0u) { xcd_barrier_complete(bar, b.x, nloc, nx); b.st[0] = nloc; b.st[1] = nx; }
        const unsigned old = xb_add(&bar[XB_XSUB(b.x)], 1u);
        const unsigned gen = old / nloc;
        if (old + 1u == (gen + 1u) * nloc) {
            __builtin_amdgcn_fence(__ATOMIC_RELEASE, "agent");
            asm volatile("s_waitcnt vmcnt(0)" ::: "memory");
            const unsigned og = xb_add(&bar[XB_TOP], 1u);
            const unsigned tg = og / nx;
            if (og + 1u == (tg + 1u) * nx) xb_add(&bar[XB_TOPGEN], 1u);
            else XB_SPIN(xb_ld(&bar[XB_TOPGEN]) == tg, bar);
            __builtin_amdgcn_fence(__ATOMIC_ACQUIRE, "agent");
            xb_add(&bar[XB_XGEN(b.x)], 1u);
            asm volatile("s_waitcnt vmcnt(0)" ::: "memory");
        } else {
            XB_SPIN(xb_ld(&bar[XB_XGEN(b.x)]) == gen, bar);
            __builtin_amdgcn_fence(__ATOMIC_ACQUIRE, "agent");
            asm volatile("s_waitcnt vmcnt(0)" ::: "memory");
        }
    }
    __syncthreads();
}

constexpr int NPHASE = 12;
#ifndef REP_PHASE
#define REP_PHASE -1
#endif
#define REPLOOP(k) _Pragma("nounroll") for (int rep_ = 0; rep_ < ((k) == REP_PHASE ? 2 : 1); ++rep_)
__global__ void __launch_bounds__(NTHR, 2) fwd_kernel(Args a) {
    extern __shared__ __attribute__((aligned(16))) unsigned char lds_raw[];
    LAS unsigned char* lds = (LAS unsigned char*)lds_raw;
    cg::grid_group grid = cg::this_grid();
    const int tid = threadIdx.x, G = gridDim.x, bid = blockIdx.x;
    unsigned char* ws = a.ws;
    const int lo = a.ph_lo, hi = a.ph_hi;
#define IN(k) (lo <= (k) && (k) < hi)
#define SEAM(k) do { if (IN(k) && IN((k) + 1)) { if (lo < 0) grid.sync(); else xcd_barrier(bar); } } while (0)
    if (tid < 2) ((volatile LAS unsigned*)(lds + LDS_MISC))[tid] = 0u;
    __syncthreads();
    XcdBarrier bar = xcd_barrier_post((unsigned*)(ws + WS_BAR), (volatile LAS unsigned*)(lds + LDS_MISC));
    float* sumsq = (float*)(ws + WS_SUMSQ);
    bf16_t* QKV = (bf16_t*)(ws + WS_QKV); bf16_t* HGB = (bf16_t*)(ws + WS_HG); bf16_t* GATES = (bf16_t*)(ws + WS_GATES); bf16_t* KVC = (bf16_t*)(ws + WS_KVC);
    bf16_t* OG = (bf16_t*)((unsigned char*)a.out + 32 * MiB);       float* LSE = (float*)(ws + WS_LSE); bf16_t* OCAT = (bf16_t*)(ws + WS_OCAT);
    bf16_t* ST = (bf16_t*)a.out; bf16_t* STB = (bf16_t*)(ws + WS_STB); float* DEC = (float*)(ws + WS_DEC); const float* LB = (const float*)(ws + WS_LB);
    float* PART = a.out; unsigned* FLAGS = (unsigned*)(ws + WS_FLAGS); bf16_t* MERGED = (bf16_t*)a.out; bf16_t* XB = (bf16_t*)(ws + WS_XB);
    bf16_t* QC = (bf16_t*)(ws + WS_QC); bf16_t* OC = (bf16_t*)(ws + WS_OC); bf16_t* GB = (bf16_t*)(ws + WS_G);

    if (IN(0)) REPLOOP(0) { phase_prologue(a, lds, tid); __syncthreads(); }
    SEAM(0);
    if (IN(1)) REPLOOP(1) {
        pg8::SplitOrder S; S.init((const bf16_t*)(ws + WS_HN), (const bf16_t*)(ws + WS_WIN), MTOK, 12288, 2048, 0, G, bid);
        pg8::EpiProj E{QKV, HGB, GATES, KVC};
        pg8::gemm_phase2<pg8::EpiProj, pg8::SplitOrder>(lds, S, E, PART, FLAGS, 2u * 2048u);
    }
    SEAM(1);
    const int NGEM = G >= 160 ? 80 : 0;
    if (IN(2)) REPLOOP(2) {
      { const int bid_ = bid, G_ = G;
        for (int u = bid_; u < 768; u += G_) {
            const int g_ = u >> 8, rem = u & 255; const int dsh = 2 * g_, d = 1 << dsh, nblk = 16 >> dsh;
            const int n = rem & (nblk - 1), r = (rem >> (4 - dsh)) & (d - 1), bhh = rem >> 4, b_ = bhh >> 2, hg_ = bhh & 3;
            const long row0 = (long)b_ * 2048 + (long)(n * 128) * d + r;
            const bf16_t* qb = QKV + row0 * 4608 + (g_ * 4 + hg_) * 128;
            attn_unit<true>(lds, qb, (long)d * 4608, qb + 1536, (long)d * 4608, qb + 3072, (long)d * 4608, n > 0,
                            OG + (size_t)g_ * (8192 * 512) + row0 * 512 + hg_ * 128, (long)d * 512, LSE + (size_t)g_ * (8192 * 4) + row0 * 4 + hg_, (long)d * 4, tid);
        }
        hg_kv_phase(lds, HGB, LB, ST, DEC, tid, bid_, G_);
      }
    }
    SEAM(2);
    if (IN(3)) {
        const int gt = bid * NTHR + tid, NGT = G * NTHR;
        for (int task = gt; task < 8192 * 64; task += NGT) { const int tok = task >> 6, hg_ = (task >> 4) & 3, c = task & 15;
            const float l0 = LSE[(size_t)tok * 4 + hg_], l1 = LSE[(size_t)(8192 + tok) * 4 + hg_], l2 = LSE[(size_t)(16384 + tok) * 4 + hg_];
            const float mx = fmaxf(l0, fmaxf(l1, l2)); float e0 = __expf(l0 - mx), e1 = __expf(l1 - mx), e2 = __expf(l2 - mx); const float inv = 1.f / (e0 + e1 + e2); e0 *= inv; e1 *= inv; e2 *= inv;
            const size_t off = (size_t)tok * 512 + hg_ * 128 + 8 * c;
            const u32x4 x0 = *(const u32x4*)(OG + off), x1 = *(const u32x4*)(OG + (size_t)8192 * 512 + off), x2 = *(const u32x4*)(OG + (size_t)2 * 8192 * 512 + off);
            u32x4 o;
            o.x = cvt_pk_bf16(e0 * bflo(x0.x) + e1 * bflo(x1.x) + e2 * bflo(x2.x), e0 * bfhi(x0.x) + e1 * bfhi(x1.x) + e2 * bfhi(x2.x));
            o.y = cvt_pk_bf16(e0 * bflo(x0.y) + e1 * bflo(x1.y) + e2 * bflo(x2.y), e0 * bfhi(x0.y) + e1 * bfhi(x1.y) + e2 * bfhi(x2.y));
            o.z = cvt_pk_bf16(e0 * bflo(x0.z) + e1 * bflo(x1.z) + e2 * bflo(x2.z), e0 * bfhi(x0.z) + e1 * bfhi(x1.z) + e2 * bfhi(x2.z));
            o.w = cvt_pk_bf16(e0 * bflo(x0.w) + e1 * bflo(x1.w) + e2 * bflo(x2.w), e0 * bfhi(x0.w) + e1 * bfhi(x1.w) + e2 * bfhi(x2.w));
            *(u32x4*)(OCAT + (size_t)tok * 1536 + hg_ * 128 + 8 * c) = o; }
        for (int task = gt; task < 32 * 4096; task += NGT) { const int bh = task >> 12, e4 = task & 4095;
            f32x4 S_ = {0.f, 0.f, 0.f, 0.f};
            const bf16_t* sp = ST + (size_t)bh * 32 * 16384 + 4 * e4; const float* dp = DEC + (size_t)bh * 32 * 128 + ((4 * e4) & 127); bf16_t* op = STB + (size_t)bh * 32 * 16384 + 4 * e4;
#pragma unroll 8
            for (int n = 0; n < 32; ++n) { const u32x2 kw = *(const u32x2*)(sp + (size_t)n * 16384); const f32x4 kv = {bflo(kw.x), bfhi(kw.x), bflo(kw.y), bfhi(kw.y)}; const f32x4 dc = *(const f32x4*)(dp + n * 128);
                u32x2 wv; wv.x = cvt_pk_bf16(S_[0], S_[1]); wv.y = cvt_pk_bf16(S_[2], S_[3]); *(u32x2*)(op + (size_t)n * 16384) = wv; S_ = dc * S_ + kv; } }
    }
    SEAM(3);
    if (IN(4)) REPLOOP(4) {
      if (bid < NGEM || NGEM == 0) {
        pg8::DeferOrder S{(const bf16_t*)(ws + WS_HN), (const bf16_t*)(ws + WS_WIN), 2048, bid, 80, NGEM ? NGEM : G}; pg8::EpiProj E{QKV, HGB, GATES, KVC};
        pg8::gemm_phase2<pg8::EpiProj, pg8::DeferOrder>(lds, S, E, PART, FLAGS, 2u * 2048u); __syncthreads();
      }
      if (bid >= NGEM) hg_out_phase(lds, HGB, LB, a.in[4], STB, OCAT, tid, bid - NGEM, G - NGEM);
    }
    SEAM(4);
    if (IN(5)) REPLOOP(5) {
        pg8::ChainOrder S{OCAT, (const bf16_t*)(ws + WS_WA), 1536, 8, MTOK / 256, 2048 / 256, G, bid};
        pg8::EpiMerge E{GATES, MERGED};
        pg8::gemm_phase2<pg8::EpiMerge, pg8::ChainOrder>(lds, S, E, nullptr, nullptr, 2u * 1536u);
    }
    SEAM(5);
    if (IN(6)) { pg8::SplitOrder S; S.init(MERGED, (const bf16_t*)(ws + WS_WOUT), MTOK, 2048, 2048, 0, G, bid); pg8::EpiRes<false> E{a.in[0], XB, sumsq};
        pg8::gemm_phase2<pg8::EpiRes<false>, pg8::SplitOrder>(lds, S, E, PART, FLAGS, 2u * 2048u); }
    SEAM(6);
    if (IN(8)) REPLOOP(8) {
        for (int u = bid; u < 256; u += G) { const int b_ = u >> 6, h = (u >> 4) & 3, qb = u & 15; const size_t r0 = (size_t)(b_ * 2048 + qb * 128);
            const bf16_t* kb = KVC + (size_t)(b_ * 256 + 128) * 1024 + h * 128;
            bf16x8 qf[4]; cross_q_tile(lds, XB + r0 * 2048, (const bf16_t*)(ws + WS_WQ) + (size_t)(h * 128) * 2048, sumsq + r0, tid, qf);
            attn_unit<false, true>(lds, nullptr, 512, kb, 1024, kb + 512, 1024, true, OC + r0 * 512 + h * 128, 512, nullptr, 0, tid, qf); }
    }
    SEAM(8);
    if (IN(9)) { pg8::SplitOrder S; S.init(OC, (const bf16_t*)(ws + WS_WO), MTOK, 2048, 512, 0, G, bid); pg8::EpiRes<true> E{XB, XB, sumsq + 8192};
        pg8::gemm_phase2<pg8::EpiRes<true>, pg8::SplitOrder>(lds, S, E, PART, FLAGS, 2u * 512u); }
    SEAM(9);
    if (IN(10)) REPLOOP(10) { pg8::SplitOrder S; S.init(XB, (const bf16_t*)(ws + WS_W13), MTOK, 2 * DFF_, 2048, 0, G, bid); pg8::EpiSwiGLU E{sumsq + 8192, GB};
        pg8::gemm_phase2<pg8::EpiSwiGLU, pg8::SplitOrder>(lds, S, E, PART, FLAGS + 4096, 2u * 2048u); }
    SEAM(10);
    if (IN(11)) { pg8::SplitOrder S; S.init(GB, (const bf16_t*)(ws + WS_W2), MTOK, 2048, DFF_, 0, G, bid); pg8::EpiFinal E{XB, a.out, sumsq + 16384, a.in[18], FLAGS};
        pg8::gemm_phase2<pg8::EpiFinal, pg8::SplitOrder>(lds, S, E, PART, FLAGS, 2u * 5632u); }
#undef IN
#undef SEAM
}

#ifndef N_LAUNCH_MODE
#define N_LAUNCH_MODE 1
#endif
extern "C" void kernel_launch(void* const* d_in, const int* in_sizes, int n_in, void* d_out, int out_size, void* d_ws, size_t ws_size, hipStream_t stream) {
    static int grid = 0;
    if (grid == 0) {
        if (n_in != 19 || out_size != MTOK * DMODEL || ws_size < WS_END) { fprintf(stderr, "kernel_launch: unexpected problem (n_in %d out %d ws %zu)\n", n_in, out_size, ws_size); grid = -1; return; }
        int dev = 0, cus = 0, per_cu = 0;
        hipGetDevice(&dev); hipDeviceGetAttribute(&cus, hipDeviceAttributeMultiprocessorCount, dev);
        if (hipFuncSetAttribute((const void*)fwd_kernel, hipFuncAttributeMaxDynamicSharedMemorySize, LDS_BYTES) != hipSuccess) { fprintf(stderr, "kernel_launch: hipFuncSetAttribute failed\n"); grid = -1; return; }
        if (hipOccupancyMaxActiveBlocksPerMultiprocessor(&per_cu, (const void*)fwd_kernel, NTHR, LDS_BYTES) != hipSuccess || per_cu < 1) { fprintf(stderr, "kernel_launch: occupancy query gave %d\n", per_cu); per_cu = 1; }
        (void)hipGetLastError();
        grid = cus * 1;
        fprintf(stderr, "kernel_launch: grid %d (cus %d, per_cu %d)\n", grid, cus, per_cu);
    }
    if (grid < 0) return;
    if (hipMemsetAsync((char*)d_ws + WS_BAR, 0, BAR_BYTES, stream) != hipSuccess) { fprintf(stderr, "kernel_launch: memset failed\n"); return; }
    Args a{};
    for (int i = 0; i < 19; ++i) a.in[i] = (const float*)d_in[i];
    a.out = (float*)d_out; a.ws = (unsigned char*)d_ws;
#if N_LAUNCH_MODE == 1
    a.ph_lo = 0; a.ph_hi = NPHASE;
    void* args[] = {&a};
    hipError_t e = hipLaunchCooperativeKernel((const void*)fwd_kernel, dim3(grid), dim3(NTHR), args, LDS_BYTES, stream);
    if (e != hipSuccess) fprintf(stderr, "kernel_launch: cooperative launch failed: %s (grid %d)\n", hipGetErrorString(e), grid);
#else
    for (int p = 0; p < NPHASE; ++p) { a.ph_lo = p; a.ph_hi = p + 1; hipLaunchKernelGGL(fwd_kernel, dim3(grid), dim3(NTHR), LDS_BYTES, stream, a); }
#endif
}
```

```cpp
#include <hip/hip_runtime.h>
#include <hip/hip_cooperative_groups.h>
#include <cstdio>
#include <cstdint>
#include <cmath>
namespace cg = cooperative_groups;
namespace pg8 {
#define PG8_LAS __attribute__((address_space(3)))
typedef unsigned short bf16_t;
typedef short bf16x8 __attribute__((ext_vector_type(8)));
typedef float f32x4 __attribute__((ext_vector_type(4)));
typedef unsigned u32x4 __attribute__((ext_vector_type(4)));
constexpr int BM = 256, BK = 64, HALF = 128, HTB = HALF * BK * 2  , STAGE_BYTES = 8 * HTB, NXCD = 8, WGM = 8;

__host__ __device__ __forceinline__ int lds_byte(int r, int c) { const int st = (r >> 4) * 2 + (c >> 5), rr = r & 15, cc = c & 31, ob = rr * 64 + cc * 2; return st * 1024 + (ob ^ (((ob >> 9) & 1) << 5)); }
__host__ __device__ __forceinline__ void stage_rc(int b, int& R, int& C) { const int st = b / 1024, sb = b % 1024, swz = sb ^ (((sb >> 9) & 1) << 5); R = (st >> 1) * 16 + swz / 64; C = (st & 1) * 32 + (swz % 64) / 2; }
__host__ __device__ __forceinline__ int perm32(int rho) { const int n = rho >> 4, i = rho & 15; return 8 * (i >> 2) + 4 * n + (i & 3); }

struct Unit { int pm, pn; };
struct Gemm { const bf16_t* A; const bf16_t* Bt; int M, N, K; };

struct StaticOrder {
    int nM, nN, nwg, G, c;
    __host__ __device__ void init(int M, int N, int G_, int c_) { nM = M / BM; nN = N / BM; nwg = nM * nN; G = G_; c = c_; }
    __host__ __device__ bool next(int i, Unit& u) const {
        const long L = (long)i * G + c; if (L >= nwg) return false;
        int wgid = (int)L; { const int q = nwg / NXCD, r = nwg % NXCD, xcd = wgid % NXCD, off = wgid / NXCD; wgid = (xcd < r ? xcd * (q + 1) : r * (q + 1) + (xcd - r) * q) + off; }
        const int nig = WGM * nN, gid = wgid / nig, fm = gid * WGM, gsz = (nM - fm) < WGM ? (nM - fm) : WGM;
        u.pm = fm + ((wgid % nig) % gsz); u.pn = (wgid % nig) / gsz; return true;
    }
    __device__ __forceinline__ void a_ready(const Unit&) const {}
    __device__ __forceinline__ void done(const Unit&) const {}
};

__device__ __forceinline__ unsigned cvt_pk_bf16(float lo, float hi) { unsigned r; asm volatile("v_cvt_pk_bf16_f32 %0, %1, %2" : "=v"(r) : "v"(lo), "v"(hi)); return r; }
typedef float f32x2 __attribute__((ext_vector_type(2)));
typedef unsigned u32x2 __attribute__((ext_vector_type(2)));
__device__ __forceinline__ float sigm(float x) { return __builtin_amdgcn_rcpf(1.f + __expf(-x)); }
__device__ __forceinline__ float silu(float x) { return x * sigm(x); }
__device__ __forceinline__ float bflo(unsigned w) { return __uint_as_float(w << 16); }
__device__ __forceinline__ float bfhi(unsigned w) { return __uint_as_float(w & 0xffff0000u); }
constexpr float RMS_EPS_ = 1e-6f;

struct Order1 {
    StaticOrder so; int nmain;
    __host__ __device__ void init(int G_, int c_) { so.init(8192, 12800, G_, c_); nmain = so.nwg; }
    __host__ __device__ bool next(int i, Unit& u) const {
        const long L = (long)i * so.G + so.c;
        if (L < nmain) return so.next(i, u);
        const int e = (int)(L - nmain); if (e >= 16) return false;
        u.pm = 32 + (e >> 2); u.pn = 50 + (e & 3); return true;
    }
    __device__ __forceinline__ void a_ready(const Unit&) const {}
    __device__ __forceinline__ void done(const Unit&) const {}
};

struct EpiProj {
    static constexpr bool PERM = true, AFTER_DRAIN = false;
    bf16_t* qkv; bf16_t* hg; bf16_t* gates; bf16_t* kvc;
    __device__ __forceinline__ void operator()(const f32x4 (&acc)[2][2][4][2], const Unit& u, int wr, int wc, int fr, int fq) const {
        const int pn = u.pn; bf16_t* base; int ldc, colt, act, rowt = u.pm * BM;
        if (pn < 18) { base = qkv; ldc = 4608; colt = pn * 256; act = 0; }
        else if (pn < 34) { base = hg; ldc = 4096; colt = (pn - 18) * 256; const int s = (pn - 18) >> 2; act = (s == 0 || s == 3) ? 1 : 0; }
        else if (pn < 50) { base = gates; ldc = 4096; colt = (pn - 34) * 256; act = 2; }
        else { base = kvc; ldc = 1024; colt = (pn - 50) * 256; act = 0; rowt -= 8192; }
        const int row0 = rowt + wr * 64 + fr, col0 = colt + wc * 32 + 8 * fq;
#pragma unroll
        for (int ai = 0; ai < 2; ++ai)
#pragma unroll
            for (int m = 0; m < 4; ++m) { bf16_t* rowp = base + (size_t)(row0 + ai * HALF + m * 16) * ldc + col0;
#pragma unroll
                for (int bj = 0; bj < 2; ++bj) { f32x4 v0 = acc[ai][bj][m][0], v1 = acc[ai][bj][m][1];
                    if (act == 1) {
#pragma unroll
                        for (int e = 0; e < 4; ++e) { v0[e] = silu(v0[e]); v1[e] = silu(v1[e]); } }
                    else if (act == 2) {
#pragma unroll
                        for (int e = 0; e < 4; ++e) { v0[e] = sigm(v0[e]); v1[e] = sigm(v1[e]); } }
                    u32x4 w; w.x = cvt_pk_bf16(v0[0], v0[1]); w.y = cvt_pk_bf16(v0[2], v0[3]); w.z = cvt_pk_bf16(v1[0], v1[1]); w.w = cvt_pk_bf16(v1[2], v1[3]);
                    *(u32x4*)(rowp + bj * HALF) = w; } }
    }
};

struct EpiGateA {
    static constexpr bool PERM = true, AFTER_DRAIN = false;
    const bf16_t* gates; float* tmp;
    __device__ __forceinline__ void operator()(const f32x4 (&acc)[2][2][4][2], const Unit& u, int wr, int wc, int fr, int fq) const {
        const int row0 = u.pm * BM + wr * 64 + fr, col0 = u.pn * BM + wc * 32 + 8 * fq;
#pragma unroll
        for (int ai = 0; ai < 2; ++ai)
#pragma unroll
            for (int m = 0; m < 4; ++m) { const size_t r = (size_t)(row0 + ai * HALF + m * 16);
#pragma unroll
                for (int bj = 0; bj < 2; ++bj) { const int c = col0 + bj * HALF; const u32x4 g = *(const u32x4*)(gates + r * 4096 + c);
                    f32x4 o0 = acc[ai][bj][m][0], o1 = acc[ai][bj][m][1];
                    o0[0] *= bflo(g.x); o0[1] *= bfhi(g.x); o0[2] *= bflo(g.y); o0[3] *= bfhi(g.y); o1[0] *= bflo(g.z); o1[1] *= bfhi(g.z); o1[2] *= bflo(g.w); o1[3] *= bfhi(g.w);
                    *(f32x4*)(tmp + r * 2048 + c) = o0; *(f32x4*)(tmp + r * 2048 + c + 4) = o1; } }
    }
};
struct EpiGateB {
    static constexpr bool PERM = true, AFTER_DRAIN = false;
    const bf16_t* gates; const float* tmp; bf16_t* out;
    __device__ __forceinline__ void operator()(const f32x4 (&acc)[2][2][4][2], const Unit& u, int wr, int wc, int fr, int fq) const {
        const int row0 = u.pm * BM + wr * 64 + fr, col0 = u.pn * BM + wc * 32 + 8 * fq;
#pragma unroll
        for (int ai = 0; ai < 2; ++ai)
#pragma unroll
            for (int m = 0; m < 4; ++m) { const size_t r = (size_t)(row0 + ai * HALF + m * 16);
#pragma unroll
                for (int bj = 0; bj < 2; ++bj) { const int c = col0 + bj * HALF; const u32x4 g = *(const u32x4*)(gates + r * 4096 + c);
                    f32x4 o0 = *(const f32x4*)(tmp + r * 2048 + c), o1 = *(const f32x4*)(tmp + r * 2048 + c + 4); const f32x4 a0 = acc[ai][bj][m][0], a1 = acc[ai][bj][m][1];
                    o0[0] += a0[0] * bflo(g.x); o0[1] += a0[1] * bfhi(g.x); o0[2] += a0[2] * bflo(g.y); o0[3] += a0[3] * bfhi(g.y);
                    o1[0] += a1[0] * bflo(g.z); o1[1] += a1[1] * bfhi(g.z); o1[2] += a1[2] * bflo(g.w); o1[3] += a1[3] * bfhi(g.w);
                    u32x4 w; w.x = cvt_pk_bf16(o0[0], o0[1]); w.y = cvt_pk_bf16(o0[2], o0[3]); w.z = cvt_pk_bf16(o1[0], o1[1]); w.w = cvt_pk_bf16(o1[2], o1[3]);
                    *(u32x4*)(out + r * 2048 + c) = w; } }
    }
};
template <bool RES_BF16> struct EpiRes {
    static constexpr bool PERM = true, AFTER_DRAIN = false;
    const void* resid; bf16_t* outb; float* sumsq;
    __device__ __forceinline__ void operator()(const f32x4 (&acc)[2][2][4][2], const Unit& u, int wr, int wc, int fr, int fq) const {
        const int row0 = u.pm * BM + wr * 64 + fr, col0 = u.pn * BM + wc * 32 + 8 * fq;
#pragma unroll
        for (int ai = 0; ai < 2; ++ai)
#pragma unroll
            for (int m = 0; m < 4; ++m) { const size_t r = (size_t)(row0 + ai * HALF + m * 16); float ss = 0.f;
#pragma unroll
                for (int bj = 0; bj < 2; ++bj) { const int c = col0 + bj * HALF; f32x4 o0, o1;
                    if (RES_BF16) { const u32x4 g = *(const u32x4*)((const bf16_t*)resid + r * 2048 + c);
                        o0 = (f32x4){bflo(g.x), bfhi(g.x), bflo(g.y), bfhi(g.y)} + acc[ai][bj][m][0]; o1 = (f32x4){bflo(g.z), bfhi(g.z), bflo(g.w), bfhi(g.w)} + acc[ai][bj][m][1]; }
                    else { o0 = *(const f32x4*)((const float*)resid + r * 2048 + c) + acc[ai][bj][m][0]; o1 = *(const f32x4*)((const float*)resid + r * 2048 + c + 4) + acc[ai][bj][m][1]; }
                    ss += (o0[0] * o0[0] + o0[1] * o0[1]) + (o0[2] * o0[2] + o0[3] * o0[3]) + (o1[0] * o1[0] + o1[1] * o1[1]) + (o1[2] * o1[2] + o1[3] * o1[3]);
                    u32x4 w; w.x = cvt_pk_bf16(o0[0], o0[1]); w.y = cvt_pk_bf16(o0[2], o0[3]); w.z = cvt_pk_bf16(o1[0], o1[1]); w.w = cvt_pk_bf16(o1[2], o1[3]); *(u32x4*)(outb + r * 2048 + c) = w; }
                ss += __shfl_xor(ss, 16); ss += __shfl_xor(ss, 32);
                if (fq == 0) atomicAdd(sumsq + r, ss); }
    }
};
struct EpiQ {
    static constexpr bool PERM = true, AFTER_DRAIN = false;
    const float* sumsq; bf16_t* out; float scale;
    __device__ __forceinline__ void operator()(const f32x4 (&acc)[2][2][4][2], const Unit& u, int wr, int wc, int fr, int fq) const {
        const int row0 = u.pm * BM + wr * 64 + fr, col0 = u.pn * BM + wc * 32 + 8 * fq;
#pragma unroll
        for (int ai = 0; ai < 2; ++ai)
#pragma unroll
            for (int m = 0; m < 4; ++m) { const size_t r = (size_t)(row0 + ai * HALF + m * 16); const float rs = rsqrtf(sumsq[r] * (1.f / 2048.f) + RMS_EPS_) * scale;
#pragma unroll
                for (int bj = 0; bj < 2; ++bj) { const int c = col0 + bj * HALF; const f32x4 v0 = acc[ai][bj][m][0] * rs, v1 = acc[ai][bj][m][1] * rs;
                    u32x4 w; w.x = cvt_pk_bf16(v0[0], v0[1]); w.y = cvt_pk_bf16(v0[2], v0[3]); w.z = cvt_pk_bf16(v1[0], v1[1]); w.w = cvt_pk_bf16(v1[2], v1[3]);
                    *(u32x4*)(out + r * 512 + c) = w; } }
    }
};
struct EpiSwiGLU {
    static constexpr bool PERM = true, AFTER_DRAIN = false;
    const float* sumsq; bf16_t* out;
    __device__ __forceinline__ void operator()(const f32x4 (&acc)[2][2][4][2], const Unit& u, int wr, int wc, int fr, int fq) const {
        const int row0 = u.pm * BM + wr * 64 + fr, col0 = u.pn * HALF + wc * 32 + 8 * fq;
#pragma unroll
        for (int ai = 0; ai < 2; ++ai)
#pragma unroll
            for (int m = 0; m < 4; ++m) { const size_t r = (size_t)(row0 + ai * HALF + m * 16); const float rs = rsqrtf(sumsq[r] * (1.f / 2048.f) + RMS_EPS_);
                float g[8];
#pragma unroll
                for (int n = 0; n < 2; ++n)
#pragma unroll
                    for (int e = 0; e < 4; ++e) g[4 * n + e] = silu(acc[ai][0][m][n][e] * rs) * (acc[ai][1][m][n][e] * rs);
                u32x4 w; w.x = cvt_pk_bf16(g[0], g[1]); w.y = cvt_pk_bf16(g[2], g[3]); w.z = cvt_pk_bf16(g[4], g[5]); w.w = cvt_pk_bf16(g[6], g[7]);
                *(u32x4*)(out + r * 5632 + col0) = w; }
    }
};
struct Unit2 : Unit { const char* A; const char* B; int nt; int mode, slot, aux, pstr; };
__device__ __forceinline__ void part_store(const f32x4 (&acc)[2][2][4][2], float* part, unsigned* flags, const Unit2& u, int tid, int lane) {
    float* p = part + ((size_t)(u.slot * u.pstr + u.aux) * 32) * 2048 + (size_t)tid * 4;
#pragma unroll
    for (int ai = 0; ai < 2; ++ai)
#pragma unroll
        for (int bj = 0; bj < 2; ++bj)
#pragma unroll
            for (int m = 0; m < 4; ++m)
#pragma unroll
                for (int n = 0; n < 2; ++n) *(f32x4*)(p + (size_t)(((ai * 2 + bj) * 4 + m) * 2 + n) * 2048) = acc[ai][bj][m][n];
    __builtin_amdgcn_fence(__ATOMIC_RELEASE, "agent");
    asm volatile("s_waitcnt vmcnt(0)" ::: "memory");
    if (lane == 0) __hip_atomic_fetch_add(flags + 16 * u.slot, 1u, __ATOMIC_RELAXED, __HIP_MEMORY_SCOPE_AGENT);
}
__device__ __forceinline__ void part_wait_add(f32x4 (&acc)[2][2][4][2], const float* part, unsigned* flags, const Unit2& u, int tid, int lane) {
    const int np = (u.mode == 2) ? u.aux : 0;
    if (np > 0) { const unsigned want = 8u * (unsigned)np; unsigned spins = 0;
        for (;;) { unsigned v = 0; if (lane == 0) v = __hip_atomic_load(flags + 16 * u.slot, __ATOMIC_RELAXED, __HIP_MEMORY_SCOPE_AGENT);
            if ((unsigned)__builtin_amdgcn_readfirstlane(v) >= want) break;
            __builtin_amdgcn_s_sleep(1); if (++spins > (1u << 20)) break; }
        __builtin_amdgcn_fence(__ATOMIC_ACQUIRE, "agent"); }
    for (int pi = 0; pi < np; ++pi) { const float* p = part + ((size_t)(u.slot * u.pstr + pi) * 32) * 2048 + (size_t)tid * 4;
#pragma unroll
        for (int ai = 0; ai < 2; ++ai)
#pragma unroll
            for (int bj = 0; bj < 2; ++bj) {
#pragma unroll
                for (int m = 0; m < 4; ++m)
#pragma unroll
                    for (int n = 0; n < 2; ++n) acc[ai][bj][m][n] += *(const f32x4*)(p + (size_t)(((ai * 2 + bj) * 4 + m) * 2 + n) * 2048);
                asm volatile("" ::: "memory"); } }
}

template <class Epi, class Sched>
__device__ __forceinline__ void gemm_phase2(PG8_LAS unsigned char* lds, const Sched& S, const Epi& E, float* part, unsigned* flags, const unsigned ld2  ) {
    const int tid = threadIdx.x, wid = __builtin_amdgcn_readfirstlane(tid >> 6), lane = tid & 63, wr = wid >> 2, wc = wid & 3, fr = lane & 15, fq = lane >> 4;
    unsigned voffA[2], voffB[2];
#pragma unroll
    for (int i = 0; i < 2; ++i) { int R, C; stage_rc(tid * 16 + i * 8192, R, C); const int Rb = Epi::PERM ? ((R & ~31) + perm32(R & 31)) : R;
        voffA[i] = (unsigned)R * ld2 + (unsigned)C * 2u; voffB[i] = (unsigned)Rb * ld2 + (unsigned)C * 2u; }
    const size_t kstep = (size_t)(BK * 2);
    const size_t hs = (size_t)HALF * ld2;
    const unsigned ldsw = (unsigned)wid * 1024u;
    const int aoff = lds_byte(wr * 64 + fr, fq * 8), boff = lds_byte(wc * 32 + fr, fq * 8);
#define PG8_SA(b, h) (((b) * 2 + (h)) * HTB)
#define PG8_SB(b, h) ((4 + (b) * 2 + (h)) * HTB)
#define PG8_STAGE(bufoff, gbase, voff) do { _Pragma("unroll") for (int _i = 0; _i < 2; ++_i) \
        __builtin_amdgcn_global_load_lds((const unsigned*)((const char*)(gbase) + (voff)[_i]), (PG8_LAS unsigned*)(lds + (bufoff) + ldsw + _i * 8192), 16, 0, 0); } while (0)
#define PG8_LDA(dst, b, h) do { _Pragma("unroll") for (int m = 0; m < 4; ++m) _Pragma("unroll") for (int k = 0; k < 2; ++k) dst[m][k] = *(const PG8_LAS bf16x8*)(lds + PG8_SA(b, h) + aoff + m * 2048 + k * 1024); } while (0)
#define PG8_LDB(dst, b, h) do { _Pragma("unroll") for (int n = 0; n < 2; ++n) _Pragma("unroll") for (int k = 0; k < 2; ++k) dst[n][k] = *(const PG8_LAS bf16x8*)(lds + PG8_SB(b, h) + boff + n * 2048 + k * 1024); } while (0)
#define PG8_MMA(ai, bj, At, Bt) do { __builtin_amdgcn_s_setprio(1); _Pragma("unroll") for (int m = 0; m < 4; ++m) _Pragma("unroll") for (int n = 0; n < 2; ++n) _Pragma("unroll") for (int k = 0; k < 2; ++k) \
        acc[ai][bj][m][n] = __builtin_amdgcn_mfma_f32_16x16x32_bf16(Bt[n][k], At[m][k], acc[ai][bj][m][n], 0, 0, 0); __builtin_amdgcn_s_setprio(0); } while (0)
#define PG8_WAIT_V(n) asm volatile("s_waitcnt vmcnt(" #n ")" ::: "memory")
#define PG8_WAIT_L(n) asm volatile("s_waitcnt lgkmcnt(" #n ")" ::: "memory")
#define PG8_BAR __builtin_amdgcn_s_barrier()
#define PG8_SCHED __builtin_amdgcn_sched_barrier(0)
    Unit2 cur, nxt; int ui = 0;
    if (!S.next(0, cur)) return;
    f32x4 acc[2][2][4][2];
#pragma unroll
    for (int a = 0; a < 2; ++a)
#pragma unroll
        for (int b = 0; b < 2; ++b)
#pragma unroll
            for (int m = 0; m < 4; ++m)
#pragma unroll
                for (int n = 0; n < 2; ++n) acc[a][b][m][n] = (f32x4){0.f, 0.f, 0.f, 0.f};
    bf16x8 At[4][2], B0[2][2], B1[2][2];
    const char* cA = cur.A; const char* cB = cur.B;
    {
        PG8_STAGE(PG8_SB(0, 0), cB, voffB); PG8_STAGE(PG8_SB(0, 1), cB + hs, voffB); PG8_STAGE(PG8_SA(0, 0), cA, voffA); PG8_STAGE(PG8_SA(0, 1), cA + hs, voffA);
        if (wr == 1) PG8_BAR;
        PG8_WAIT_V(2); PG8_BAR;
        PG8_STAGE(PG8_SB(1, 0), cB + kstep, voffB); PG8_STAGE(PG8_SA(1, 0), cA + kstep, voffA); PG8_STAGE(PG8_SB(1, 1), cB + hs + kstep, voffB);
        PG8_WAIT_V(6); PG8_BAR;
    }
    for (;;) {
        const bool has_next = S.next(ui + 1, nxt);
        const char* nA = has_next ? nxt.A : cA; const char* nB = has_next ? nxt.B : cB;
        const int nt = cur.nt;
        for (int t = 0; t < nt; t += 2) {
            const bool last = (t == nt - 2);
            const char* a1 = cA + (size_t)(t + 1) * kstep;
            const char* a2 = last ? nA : cA + (size_t)(t + 2) * kstep; const char* b2 = last ? nB : cB + (size_t)(t + 2) * kstep;
            const char* a3 = a2 + kstep; const char* b3 = b2 + kstep;
            PG8_LDB(B0, 0, 0); PG8_LDB(B1, 0, 1); PG8_SCHED; PG8_LDA(At, 0, 0); PG8_STAGE(PG8_SA(1, 1), a1 + hs, voffA);
            PG8_WAIT_V(8); PG8_WAIT_L(0); PG8_BAR; PG8_MMA(0, 0, At, B0); PG8_MMA(0, 1, At, B1); PG8_BAR; PG8_SCHED;
            PG8_LDA(At, 0, 1); PG8_STAGE(PG8_SB(0, 0), b2, voffB); PG8_STAGE(PG8_SB(0, 1), b2 + hs, voffB); PG8_STAGE(PG8_SA(0, 0), a2, voffA);
            PG8_WAIT_V(8); PG8_WAIT_L(0); PG8_BAR; PG8_MMA(1, 0, At, B0); PG8_MMA(1, 1, At, B1); PG8_BAR; PG8_SCHED;
            PG8_LDB(B0, 1, 0); PG8_LDB(B1, 1, 1); PG8_SCHED; PG8_LDA(At, 1, 0); PG8_STAGE(PG8_SA(0, 1), a2 + hs, voffA);
            PG8_WAIT_V(8); PG8_WAIT_L(0); PG8_BAR; PG8_MMA(0, 0, At, B0); PG8_MMA(0, 1, At, B1); PG8_BAR; PG8_SCHED;
            PG8_LDA(At, 1, 1); PG8_STAGE(PG8_SB(1, 0), b3, voffB); PG8_STAGE(PG8_SB(1, 1), b3 + hs, voffB); PG8_STAGE(PG8_SA(1, 0), a3, voffA);
            PG8_WAIT_V(8); PG8_WAIT_L(0); PG8_BAR; PG8_MMA(1, 0, At, B0); PG8_MMA(1, 1, At, B1); PG8_BAR; PG8_SCHED;
        }
        if (wr == 0) PG8_BAR;
        {
            int tid_ = tid, lane_ = lane, fr_ = fr, fq_ = fq; asm volatile("" : "+v"(tid_), "+v"(lane_), "+v"(fr_), "+v"(fq_));
            E(acc, cur, wr, wc, fr_, fq_); }
        if (!has_next) break;
        if (cur.mode != 3) {
#pragma unroll
            for (int a = 0; a < 2; ++a)
#pragma unroll
                for (int b = 0; b < 2; ++b)
#pragma unroll
                    for (int m = 0; m < 4; ++m)
#pragma unroll
                        for (int n = 0; n < 2; ++n) acc[a][b][m][n] = (f32x4){0.f, 0.f, 0.f, 0.f};
        }
        cur = nxt; cA = nA; cB = nB; ++ui;
        if (wr == 1) PG8_BAR;
    }
    PG8_WAIT_V(0);
    PG8_BAR;
#undef PG8_SA
#undef PG8_SB
#undef PG8_STAGE
#undef PG8_LDA
#undef PG8_LDB
#undef PG8_MMA
#undef PG8_WAIT_V
#undef PG8_WAIT_L
#undef PG8_BAR
#undef PG8_SCHED
}

__device__ __forceinline__ void unit_of(int L, int nM, int nN, int& pm, int& pn) {
    const int nwg = nM * nN;
    if (L >= nwg) { const int e = L - nwg; pm = nM + (e >> 2); pn = nN + (e & 3); return; }
    int wgid = L; { const int q = nwg / NXCD, r = nwg % NXCD, xcd = wgid % NXCD, off = wgid / NXCD; wgid = (xcd < r ? xcd * (q + 1) : r * (q + 1) + (xcd - r) * q) + off; }
    const int nig = WGM * nN, gid = wgid / nig, fm = gid * WGM, gsz = (nM - fm) < WGM ? (nM - fm) : WGM;
    pm = fm + ((wgid % nig) % gsz); pn = (wgid % nig) / gsz;
}
struct SplitOrder {
    const bf16_t* A; const bf16_t* B; int K, nM, nN, U, G, c, nfull, tail, ways;
    __device__ __forceinline__ void init(const bf16_t* A_, const bf16_t* B_, int M, int N, int K_, int nextra, int G_, int c_) {
        A = A_; B = B_; K = K_; nM = M / BM; nN = N / BM; U = nM * nN + nextra; G = G_; c = c_; nfull = U / G; tail = U - nfull * G;
        ways = 1;
    }
    __device__ __forceinline__ bool next(int i, Unit2& u) const {
        int L, kt0 = 0, ntu = K / BK; u.mode = 0; u.slot = 0; u.aux = 0; u.pstr = ways - 1;
        if (i < nfull) L = i * G + c;
        else if (i == nfull && c < tail * ways) { const int j = c % tail, p = c / tail; L = nfull * G + j;
            if (ways > 1) { ntu = (K / BK) / ways; kt0 = p * ntu; u.mode = (p == 0) ? 2 : 1; u.slot = j; u.aux = (p == 0) ? ways - 1 : p - 1; } }
        else return false;
        unit_of(L, nM, nN, u.pm, u.pn);
        u.A = (const char*)(A + (size_t)u.pm * BM * K + (size_t)kt0 * BK); u.B = (const char*)(B + (size_t)u.pn * BM * K + (size_t)kt0 * BK); u.nt = ntu;
        return true;
    }
};
struct DeferOrder {
    const bf16_t* A; const bf16_t* B; int K, d0, d1, step;
    __device__ __forceinline__ bool next(int i, Unit2& u) const {
        const int d = d0 + i * step; if (d >= d1) return false;
        if (d < 64) { u.pm = d >> 1; u.pn = 48 + (d & 1); } else { const int e = d - 64; u.pm = 32 + (e >> 2); u.pn = 50 + (e & 3); }
        u.mode = 0; u.slot = 0; u.aux = 0; u.pstr = 0; u.nt = K / BK;
        u.A = (const char*)(A + (size_t)u.pm * BM * K); u.B = (const char*)(B + (size_t)u.pn * BM * K);
        return true;
    }
};
struct ChainOrder {
    const bf16_t *A, *B; int K, nt1, nM, nN, G, c;
    __device__ __forceinline__ bool next(int i, Unit2& u) const {
        const int L = (i >> 1) * G + c; if (L >= nM * nN) return false;
        unit_of(L, nM, nN, u.pm, u.pn); u.slot = 0; u.aux = 0; u.pstr = 0;
        const int kt0 = (i & 1) ? nt1 : 0; u.nt = (i & 1) ? K / BK - nt1 : nt1; u.mode = (i & 1) ? 0 : 3;
        u.A = (const char*)(A + (size_t)u.pm * BM * K + (size_t)kt0 * BK); u.B = (const char*)(B + (size_t)u.pn * BM * K + (size_t)kt0 * BK);
        return true;
    }
};
struct EpiFinal {
    static constexpr bool PERM = true, AFTER_DRAIN = false;
    const bf16_t* resid; float* out; float* sumsq; const float* wf; unsigned* cnt;
    __device__ __forceinline__ void operator()(f32x4 (&acc)[2][2][4][2], const Unit2& u, int wr, int wc, int fr, int fq) const {
        const int row0 = u.pm * BM + wr * 64 + fr, col0 = u.pn * BM + wc * 32 + 8 * fq;
#pragma unroll
        for (int ai = 0; ai < 2; ++ai)
#pragma unroll
            for (int m = 0; m < 4; ++m) { const size_t r = (size_t)(row0 + ai * HALF + m * 16); float ss = 0.f;
#pragma unroll
                for (int bj = 0; bj < 2; ++bj) { const int c = col0 + bj * HALF; const u32x4 g = *(const u32x4*)(resid + r * 2048 + c);
                    const f32x4 o0 = (f32x4){bflo(g.x), bfhi(g.x), bflo(g.y), bfhi(g.y)} + acc[ai][bj][m][0], o1 = (f32x4){bflo(g.z), bfhi(g.z), bflo(g.w), bfhi(g.w)} + acc[ai][bj][m][1];
                    acc[ai][bj][m][0] = o0; acc[ai][bj][m][1] = o1;
                    ss += (o0[0] * o0[0] + o0[1] * o0[1]) + (o0[2] * o0[2] + o0[3] * o0[3]) + (o1[0] * o1[0] + o1[1] * o1[1]) + (o1[2] * o1[2] + o1[3] * o1[3]); }
                ss += __shfl_xor(ss, 16); ss += __shfl_xor(ss, 32);
                if (fq == 0) atomicAdd(sumsq + r, ss); }
        asm volatile("s_waitcnt vmcnt(0)" ::: "memory");
        const int lane = fq * 16 + fr;
        if (lane == 0) __hip_atomic_fetch_add(cnt + 16 * u.pm, 1u, __ATOMIC_RELAXED, __HIP_MEMORY_SCOPE_AGENT);
        { unsigned spins = 0;
          for (;;) { unsigned v = 0; if (lane == 0) v = __hip_atomic_load(cnt + 16 * u.pm, __ATOMIC_RELAXED, __HIP_MEMORY_SCOPE_AGENT);
              if ((unsigned)__builtin_amdgcn_readfirstlane(v) >= 64u) break;
              __builtin_amdgcn_s_sleep(2); if (++spins > (1u << 20)) break; } }
#pragma unroll
        for (int ai = 0; ai < 2; ++ai)
#pragma unroll
            for (int m = 0; m < 4; ++m) { const size_t r = (size_t)(row0 + ai * HALF + m * 16);
                const float rs = rsqrtf(__hip_atomic_load(sumsq + r, __ATOMIC_RELAXED, __HIP_MEMORY_SCOPE_AGENT) * (1.f / 2048.f) + RMS_EPS_);
#pragma unroll
                for (int bj = 0; bj < 2; ++bj) { const int c = col0 + bj * HALF; const f32x4 w0 = *(const f32x4*)(wf + c), w1 = *(const f32x4*)(wf + c + 4);
                    *(f32x4*)(out + r * 2048 + c) = acc[ai][bj][m][0] * rs * w0; *(f32x4*)(out + r * 2048 + c + 4) = acc[ai][bj][m][1] * rs * w1; } }
    }
};
struct EpiMerge {
    static constexpr bool PERM = true, AFTER_DRAIN = false;
    const bf16_t* gates; bf16_t* out;
    __device__ __forceinline__ void operator()(f32x4 (&acc)[2][2][4][2], const Unit2& u, int wr, int wc, int fr, int fq) const {
        const int row0 = u.pm * BM + wr * 64 + fr, col0 = u.pn * BM + wc * 32 + 8 * fq;
#pragma unroll
        for (int ai = 0; ai < 2; ++ai)
#pragma unroll
            for (int m = 0; m < 4; ++m) { const size_t r = (size_t)(row0 + ai * HALF + m * 16);
#pragma unroll
                for (int bj = 0; bj < 2; ++bj) { const int c = col0 + bj * HALF; const u32x4 gb = *(const u32x4*)(gates + r * 4096 + 2048 + c);
                    float b[8] = {bflo(gb.x), bfhi(gb.x), bflo(gb.y), bfhi(gb.y), bflo(gb.z), bfhi(gb.z), bflo(gb.w), bfhi(gb.w)};
                    if (u.mode == 3) { const u32x4 ga = *(const u32x4*)(gates + r * 4096 + c);
                        const float a[8] = {bflo(ga.x), bfhi(ga.x), bflo(ga.y), bfhi(ga.y), bflo(ga.z), bfhi(ga.z), bflo(ga.w), bfhi(ga.w)};
#pragma unroll
                        for (int e = 0; e < 4; ++e) { acc[ai][bj][m][0][e] *= a[e] * __builtin_amdgcn_rcpf(fmaxf(b[e], 1e-30f)); acc[ai][bj][m][1][e] *= a[4 + e] * __builtin_amdgcn_rcpf(fmaxf(b[4 + e], 1e-30f)); } }
                    else { const f32x4 a0 = acc[ai][bj][m][0], a1 = acc[ai][bj][m][1];
                        u32x4 w; w.x = cvt_pk_bf16(a0[0] * b[0], a0[1] * b[1]); w.y = cvt_pk_bf16(a0[2] * b[2], a0[3] * b[3]); w.z = cvt_pk_bf16(a1[0] * b[4], a1[1] * b[5]); w.w = cvt_pk_bf16(a1[2] * b[6], a1[3] * b[7]);
                        *(u32x4*)(out + r * 2048 + c) = w; } } }
    }
};
}
using pg8::bf16_t; using pg8::bf16x8; using pg8::f32x4; using pg8::u32x4; using pg8::u32x2; using pg8::cvt_pk_bf16; using pg8::sigm; using pg8::bflo; using pg8::bfhi;
#define LAS __attribute__((address_space(3)))
constexpr int NTHR = 512;
constexpr int DMODEL = 2048, MTOK = 8192, SEQL = 2048, MMEM = 1024, DFF_ = 5632;
constexpr float EPS = 1e-6f;
constexpr float ATT_SCALE = 0.08838834764831845f;

constexpr size_t MiB = 1u << 20;
constexpr size_t WS_SUMSQ = 0;
constexpr size_t WS_LB = 128 * 1024;
constexpr size_t WS_BAR = 192 * 1024, BAR_BYTES = 48 * 1024, WS_FLAGS = WS_BAR + 16 * 1024;
constexpr size_t WS_LSE = 256 * 1024;
constexpr size_t WS_DEC = 1 * MiB;
constexpr size_t WS_WIN = 2 * MiB, WS_WKV = 52 * MiB, WS_WA = 56 * MiB, WS_WB = 58 * MiB, WS_WOUT = 62 * MiB, WS_WQ = 70 * MiB, WS_WO = 72 * MiB, WS_W13 = 74 * MiB, WS_W2 = 118 * MiB;
constexpr size_t WS_HN = 140 * MiB;
constexpr size_t WS_OG = 140 * MiB;
constexpr size_t WS_OATT = 164 * MiB;
constexpr size_t WS_QC = 164 * MiB;
constexpr size_t WS_OC = 140 * MiB;
constexpr size_t WS_QKV = 176 * MiB;
constexpr size_t WS_OCAT = 176 * MiB;
constexpr size_t WS_XB = 176 * MiB;
constexpr size_t WS_STB = 208 * MiB;
constexpr size_t WS_HG = 248 * MiB;
constexpr size_t WS_TMP = 248 * MiB;
constexpr size_t WS_G = 248 * MiB;
constexpr size_t WS_GATES = 312 * MiB;
constexpr size_t WS_KVC = 376 * MiB;
constexpr size_t WS_OHG = 378 * MiB;
constexpr size_t WS_END = 394 * MiB;

constexpr int LDS_BYTES = 147456, LDS_MISC = 147392;

__device__ __forceinline__ float wave_sum(float v) {
#pragma unroll
    for (int o = 1; o < 64; o <<= 1) v += __shfl_xor(v, o);
    return v;
}
#define LDS_FENCE() asm volatile("s_waitcnt lgkmcnt(0)" ::: "memory")

__device__ __forceinline__ void transpose_item(const float* __restrict__ W, int K, int N, bf16_t* WT, int dst_row0, const float* kscale, LAS float* scr, int k0, int n0, int lane, int dld = 0, int dcol = 0) {
    if (dld == 0) dld = K;
    const int lr = lane >> 4, lc = lane & 15;
    f32x4 v[16];
#pragma unroll
    for (int it = 0; it < 16; ++it) v[it] = __builtin_nontemporal_load((const f32x4*)(W + (size_t)(k0 + it * 4 + lr) * N + n0 + 4 * lc));
    if (kscale) {
#pragma unroll
        for (int it = 0; it < 16; ++it) v[it] = v[it] * kscale[k0 + it * 4 + lr]; }
#pragma unroll
    for (int it = 0; it < 16; ++it) { LAS float* d = scr + (it * 4 + lr) * 65 + 4 * lc; d[0] = v[it][0]; d[1] = v[it][1]; d[2] = v[it][2]; d[3] = v[it][3]; }
    LDS_FENCE();
    const int c = lane & 7;
#pragma unroll
    for (int j = 0; j < 8; ++j) { const int n = (lane >> 3) + 8 * j; const LAS float* s = scr + (8 * c) * 65 + n;
        u32x4 o; o.x = cvt_pk_bf16(s[0], s[65]); o.y = cvt_pk_bf16(s[130], s[195]); o.z = cvt_pk_bf16(s[260], s[325]); o.w = cvt_pk_bf16(s[390], s[455]);
        *(u32x4*)(WT + (size_t)(dst_row0 + n) * dld + dcol + k0 + 8 * c) = o; }
    LDS_FENCE();
}
__device__ __forceinline__ void rms_row_bf16(const float* xrow, const float* w, bf16_t* orow, int lane) {
    f32x4 v[8]; float s = 0.f;
#pragma unroll
    for (int j = 0; j < 8; ++j) { v[j] = __builtin_nontemporal_load(((const f32x4*)xrow) + lane + 64 * j); s += (v[j][0] * v[j][0] + v[j][1] * v[j][1]) + (v[j][2] * v[j][2] + v[j][3] * v[j][3]); }
    const float rstd = rsqrtf(wave_sum(s) * (1.f / 2048.f) + EPS);
#pragma unroll
    for (int j = 0; j < 8; ++j) { const f32x4 ww = ((const f32x4*)w)[lane + 64 * j]; const f32x4 o = v[j] * rstd * ww;
        u32x2 p; p.x = cvt_pk_bf16(o[0], o[1]); p.y = cvt_pk_bf16(o[2], o[3]); ((u32x2*)orow)[lane + 64 * j] = p; }
}

struct Args { const float* in[19]; float* out; unsigned char* ws; int ph_lo, ph_hi; };

struct TrItem { const float* W; bf16_t* WT; const float* kscale; int N, dld, drow, k0, n0; };
__device__ __forceinline__ TrItem tr_decode(const Args& a, int it) {
    unsigned char* ws = a.ws; int r = it; TrItem T;
    constexpr int I_IN = 32 * 200, I_KV = 32 * 16, I_A = 8 * 32, I_B = 16 * 32, I_OUT = 32 * 32, I_Q = 32 * 8, I_O = 8 * 32, I_1 = 32 * 88;
    if (r < I_IN) { T = TrItem{a.in[3], (bf16_t*)(ws + WS_WIN), nullptr, 12800, 2048, 64 * (r % 200), 64 * (r / 200), 64 * (r % 200)}; return T; } r -= I_IN;
    if (r < I_KV) { T = TrItem{a.in[12], (bf16_t*)(ws + WS_WKV), nullptr, 1024, 2048, 64 * (r % 16), 64 * (r / 16), 64 * (r % 16)}; return T; } r -= I_KV;
    if (r < I_A) { T = TrItem{a.in[6], (bf16_t*)(ws + WS_WA), nullptr, 2048, 1536, 64 * (r % 32), 64 * (r / 32), 64 * (r % 32)}; return T; } r -= I_A;
    if (r < I_B) { T = TrItem{a.in[7], (bf16_t*)(ws + WS_WA) + 512, nullptr, 2048, 1536, 64 * (r % 32), 64 * (r / 32), 64 * (r % 32)}; return T; } r -= I_B;
    if (r < I_OUT) { T = TrItem{a.in[8], (bf16_t*)(ws + WS_WOUT), nullptr, 2048, 2048, 64 * (r % 32), 64 * (r / 32), 64 * (r % 32)}; return T; } r -= I_OUT;
    if (r < I_Q) { T = TrItem{a.in[11], (bf16_t*)(ws + WS_WQ), a.in[9], 512, 2048, 64 * (r % 8), 64 * (r / 8), 64 * (r % 8)}; return T; } r -= I_Q;
    if (r < I_O) { T = TrItem{a.in[13], (bf16_t*)(ws + WS_WO), nullptr, 2048, 512, 64 * (r % 32), 64 * (r / 32), 64 * (r % 32)}; return T; } r -= I_O;
    if (r < I_1) { const int n0 = 64 * (r % 88); T = TrItem{a.in[15], (bf16_t*)(ws + WS_W13), a.in[14], 5632, 2048, 256 * (n0 >> 7) + (n0 & 127), 64 * (r / 88), n0}; return T; } r -= I_1;
    if (r < I_1) { const int n0 = 64 * (r % 88); T = TrItem{a.in[16], (bf16_t*)(ws + WS_W13), a.in[14], 5632, 2048, 256 * (n0 >> 7) + 128 + (n0 & 127), 64 * (r / 88), n0}; return T; } r -= I_1;
    T = TrItem{a.in[17], (bf16_t*)(ws + WS_W2), nullptr, 2048, 5632, 64 * (r % 32), 64 * (r / 32), 64 * (r % 32)}; return T;
}
__device__ __forceinline__ void tr_load(const TrItem& T, f32x4 (&v)[16], float (&ks)[16], int lane) {
    const int lr = lane >> 4, lc = lane & 15;
#pragma unroll
    for (int it = 0; it < 16; ++it) v[it] = __builtin_nontemporal_load((const f32x4*)(T.W + (size_t)(T.k0 + it * 4 + lr) * T.N + T.n0 + 4 * lc));
#pragma unroll
    for (int it = 0; it < 16; ++it) ks[it] = T.kscale ? T.kscale[T.k0 + it * 4 + lr] : 1.f;
}
__device__ __forceinline__ void tr_store(const TrItem& T, const f32x4 (&v)[16], const float (&ks)[16], LAS float* scr, int lane) {
    const int lr = lane >> 4, lc = lane & 15;
#pragma unroll
    for (int it = 0; it < 16; ++it) { const f32x4 x = v[it] * ks[it]; LAS float* d = scr + (it * 4 + lr) * 65 + 4 * lc; d[0] = x[0]; d[1] = x[1]; d[2] = x[2]; d[3] = x[3]; }
    LDS_FENCE();
    const int c = lane & 7;
#pragma unroll
    for (int j = 0; j < 8; ++j) { const int n = (lane >> 3) + 8 * j; const LAS float* s = scr + (8 * c) * 65 + n;
        u32x4 o; o.x = cvt_pk_bf16(s[0], s[65]); o.y = cvt_pk_bf16(s[130], s[195]); o.z = cvt_pk_bf16(s[260], s[325]); o.w = cvt_pk_bf16(s[390], s[455]);
        *(u32x4*)(T.WT + (size_t)(T.drow + n) * T.dld + T.k0 + 8 * c) = o; }
    LDS_FENCE();
}
__device__ __forceinline__ void phase_prologue(const Args& a, LAS unsigned char* lds, int tid) {
    const int lane = tid & 63, wave = __builtin_amdgcn_readfirstlane(tid >> 6); const int G = gridDim.x;
    LAS float* scr = (LAS float*)(lds + wave * 16896);
    const int gw = blockIdx.x * 8 + wave, NGW = G * 8;
    unsigned char* ws = a.ws;
    constexpr int NITEMS = 32 * 200 + 32 * 16 + 8 * 32 + 16 * 32 + 32 * 32 + 32 * 8 + 8 * 32 + 2 * 32 * 88 + 88 * 32;
    {   f32x4 v[16], vn[16]; float ks[16], kn[16]; TrItem T{}, Tn{};
        int it = gw; if (it < NITEMS) { T = tr_decode(a, it); tr_load(T, v, ks, lane); }
        while (it < NITEMS) { const int nit = it + NGW; const bool hn = nit < NITEMS;
            if (hn) { Tn = tr_decode(a, nit); tr_load(Tn, vn, kn, lane); }
            tr_store(T, v, ks, scr, lane);
            it = nit; T = Tn;
#pragma unroll
            for (int q = 0; q < 16; ++q) { v[q] = vn[q]; ks[q] = kn[q]; } }
    }
    bf16_t* hn = (bf16_t*)(ws + WS_HN);
    for (int m = gw; m < MTOK + MMEM; m += NGW) {
        if (m < MTOK) rms_row_bf16(a.in[0] + (size_t)m * 2048, a.in[2], hn + (size_t)m * 2048, lane);
        else rms_row_bf16(a.in[1] + (size_t)(m - MTOK) * 2048, a.in[10], hn + (size_t)m * 2048, lane);
    }
    const int gt = blockIdx.x * NTHR + tid, NGT = G * NTHR;
    float* sumsq = (float*)(ws + WS_SUMSQ);
    for (int i = gt; i < 3 * 8192; i += NGT) sumsq[i] = 0.f;
    float* lb = (float*)(ws + WS_LB); const float* hlb = a.in[5];
    for (int i = gt; i < 1024; i += NGT) lb[i] = 1.f / (1.f + __expf(hlb[1024 + i] - hlb[i]));
}

constexpr int VTS = 132, KSS = 68;
constexpr int ATT_K_OFF = 128 * VTS * 4;
template <bool MASKED, bool QPRE = false>
__device__ __forceinline__ void attn_unit(LAS unsigned char* lds, const bf16_t* Qb, long qs, const bf16_t* Kown, long ks, const bf16_t* Vown, long vs, bool hasprev,
                                          bf16_t* Ob, long os, float* lsep, long lses, int tid, const bf16x8* qpre = nullptr) {
    const int lane = tid & 63, w = tid >> 6, fr = lane & 15, fq = lane >> 4;
    LAS unsigned* VT = (LAS unsigned*)lds; LAS unsigned* KS = (LAS unsigned*)(lds + ATT_K_OFF);
    const int iq = 16 * w + fr;
    u32x4 kx[8], vx[4], vy[4]; bf16x8 qf[4];
#pragma unroll
    for (int it = 0; it < 8; ++it) { const int id = tid + NTHR * it; long r = (id >> 4) - 128; if (!hasprev && r < 0) r = 0; kx[it] = *(const u32x4*)(Kown + r * ks + 8 * (id & 15)); }
#pragma unroll
    for (int it = 0; it < 4; ++it) { const int task = tid + NTHR * it; const int c = task & 15, p = task >> 4;
        long r0 = 2 * p - 128; if (!hasprev && r0 < 0) r0 = 0;
        const bf16_t* src = Vown + r0 * vs + 8 * c; vx[it] = *(const u32x4*)src; vy[it] = *(const u32x4*)(src + vs); }
#pragma unroll
    for (int k4 = 0; k4 < 4; ++k4) { if (QPRE) qf[k4] = qpre[k4]; else qf[k4] = *(const bf16x8*)(Qb + (long)iq * qs + 32 * k4 + 8 * fq); }
    __syncthreads();
#pragma unroll
    for (int it = 0; it < 8; ++it) { const int id = tid + NTHR * it; *(LAS u32x4*)(KS + (id >> 4) * KSS + 4 * (id & 15)) = kx[it]; }
#pragma unroll
    for (int it = 0; it < 4; ++it) { const int task = tid + NTHR * it; const int c = task & 15, p = task >> 4; const u32x4 x = vx[it], y = vy[it];
        LAS unsigned* d = VT + (8 * c) * VTS + ((p + 2 * c) & 127);
        d[0 * VTS] = (x.x & 0xffffu) | (y.x << 16); d[1 * VTS] = (x.x >> 16) | (y.x & 0xffff0000u);
        d[2 * VTS] = (x.y & 0xffffu) | (y.y << 16); d[3 * VTS] = (x.y >> 16) | (y.y & 0xffff0000u);
        d[4 * VTS] = (x.z & 0xffffu) | (y.z << 16); d[5 * VTS] = (x.z >> 16) | (y.z & 0xffff0000u);
        d[6 * VTS] = (x.w & 0xffffu) | (y.w << 16); d[7 * VTS] = (x.w >> 16) | (y.w & 0xffff0000u); }
    __syncthreads();
    constexpr int NT = MASKED ? 10 : 16; const int t0 = MASKED ? w : 0;
    f32x4 s[NT];
    float mx = -INFINITY;
#pragma unroll
    for (int i = 0; i < NT; ++i) { const int t = t0 + i, tc = t < 15 ? t : 15;
        if (MASKED && i == 9) { s[i] = (f32x4){-INFINITY, -INFINITY, -INFINITY, -INFINITY}; continue; }
        const LAS unsigned* kp = KS + (16 * tc + fr) * KSS + 4 * fq;
        f32x4 acc = {0.f, 0.f, 0.f, 0.f};
#pragma unroll
        for (int k4 = 0; k4 < 4; ++k4) { const bf16x8 kf = __builtin_bit_cast(bf16x8, *(const LAS u32x4*)(kp + 16 * k4)); acc = __builtin_amdgcn_mfma_f32_16x16x32_bf16(kf, qf[k4], acc, 0, 0, 0); }
        if (!MASKED) {
#pragma unroll
            for (int j = 0; j < 4; ++j) { const float v = acc[j] * ATT_SCALE; acc[j] = v; mx = fmaxf(mx, v); } }
        else if (i == 0 || i == 8) {
#pragma unroll
            for (int j = 0; j < 4; ++j) { const int kk = 16 * t + 4 * fq + j; const bool ok = (kk >= iq) && (kk <= iq + 128) && (hasprev || kk >= 128);
                const float v = ok ? acc[j] * ATT_SCALE : -INFINITY; acc[j] = v; mx = fmaxf(mx, v); } }
        else { const bool ok = (t <= 15) && (hasprev || t >= 8);
#pragma unroll
            for (int j = 0; j < 4; ++j) { const float v = ok ? acc[j] * ATT_SCALE : -INFINITY; acc[j] = v; mx = fmaxf(mx, v); } }
        s[i] = acc; }
    mx = fmaxf(mx, __shfl_xor(mx, 16)); mx = fmaxf(mx, __shfl_xor(mx, 32));
    float l = 0.f;
#pragma unroll
    for (int i = 0; i < NT; ++i)
#pragma unroll
        for (int j = 0; j < 4; ++j) { const float p = __expf(s[i][j] - mx); s[i][j] = p; l += p; }
    l += __shfl_xor(l, 16); l += __shfl_xor(l, 32);
    f32x4 o[8];
#pragma unroll
    for (int mt = 0; mt < 8; ++mt) o[mt] = (f32x4){0.f, 0.f, 0.f, 0.f};
#pragma unroll
    for (int sp = 0; sp < NT / 2; ++sp) { const int ta = t0 + 2 * sp, tb = ta + 1; const int tca = ta < 15 ? ta : 15, tcb = tb < 15 ? tb : 15;
        u32x4 pw; pw.x = cvt_pk_bf16(s[2 * sp][0], s[2 * sp][1]); pw.y = cvt_pk_bf16(s[2 * sp][2], s[2 * sp][3]); pw.z = cvt_pk_bf16(s[2 * sp + 1][0], s[2 * sp + 1][1]); pw.w = cvt_pk_bf16(s[2 * sp + 1][2], s[2 * sp + 1][3]);
        const bf16x8 pf = __builtin_bit_cast(bf16x8, pw);
#pragma unroll
        for (int mt = 0; mt < 8; ++mt) { const LAS unsigned* vr = VT + (16 * mt + fr) * VTS; const int rot = 2 * fq + 2 * (2 * mt + (fr >> 3));
            const u32x2 lo = *(const LAS u32x2*)(vr + ((8 * tca + rot) & 127)), hi = *(const LAS u32x2*)(vr + ((8 * tcb + rot) & 127));
            u32x4 vw; vw.x = lo.x; vw.y = lo.y; vw.z = hi.x; vw.w = hi.y;
            o[mt] = __builtin_amdgcn_mfma_f32_16x16x32_bf16(__builtin_bit_cast(bf16x8, vw), pf, o[mt], 0, 0, 0); } }
    const float il = 1.f / l;
    bf16_t* op = Ob + (long)iq * os + 4 * fq;
#pragma unroll
    for (int mt = 0; mt < 8; ++mt) { u32x2 wv; wv.x = cvt_pk_bf16(o[mt][0] * il, o[mt][1] * il); wv.y = cvt_pk_bf16(o[mt][2] * il, o[mt][3] * il); *(u32x2*)(op + 16 * mt) = wv; }
    if (lsep && fq == 0) lsep[(long)iq * lses] = mx + __logf(l);
}

constexpr int QB_STRIDE = 144, QB_BYTES = 128 * QB_STRIDE, QT_OFF = 2 * QB_BYTES, QT_STRIDE = 272;
__device__ __forceinline__ void cross_q_tile(LAS unsigned char* lds, const bf16_t* XBp, const bf16_t* WQT, const float* ssq, int tid, bf16x8 (&qf)[4]) {
    const int lane = tid & 63, w = tid >> 6, fr = lane & 15, fq = lane >> 4;
    const bf16_t* ap = XBp + (size_t)(16 * w + fr) * 2048 + 8 * fq;
    const int br = tid >> 3, bc = tid & 7;
    const bf16_t* bp = WQT + (size_t)br * 2048 + 8 * bc;
    f32x4 acc[8];
#pragma unroll
    for (int nt = 0; nt < 8; ++nt) acc[nt] = (f32x4){0.f, 0.f, 0.f, 0.f};
    u32x4 b0[4], b1[4]; bf16x8 a0[4], a1[4];
#pragma unroll
    for (int i = 0; i < 4; ++i) { b0[i] = *(const u32x4*)(bp + 64 * i); b1[i] = *(const u32x4*)(bp + (size_t)64 * 2048 + 64 * i); a0[i] = *(const bf16x8*)(ap + 64 * i); a1[i] = *(const bf16x8*)(ap + 64 * i + 32); }
    __syncthreads();
    for (int kq = 0; kq < 8; ++kq) {
#pragma unroll
        for (int i = 0; i < 4; ++i) { const int kc = 4 * kq + i;
            LAS unsigned char* buf = lds + (i & 1) * QB_BYTES;
            *(LAS u32x4*)(buf + br * QB_STRIDE + 16 * bc) = b0[i]; *(LAS u32x4*)(buf + (br + 64) * QB_STRIDE + 16 * bc) = b1[i];
            const bf16x8 c0 = a0[i], c1 = a1[i];
            if (kq < 7) { b0[i] = *(const u32x4*)(bp + 64 * (kc + 4)); b1[i] = *(const u32x4*)(bp + (size_t)64 * 2048 + 64 * (kc + 4)); a0[i] = *(const bf16x8*)(ap + 64 * (kc + 4)); a1[i] = *(const bf16x8*)(ap + 64 * (kc + 4) + 32); }
            __syncthreads();
#pragma unroll
            for (int nt = 0; nt < 8; ++nt) { const LAS unsigned char* rp = buf + (16 * nt + fr) * QB_STRIDE + 16 * fq;
                const bf16x8 f0 = __builtin_bit_cast(bf16x8, *(const LAS u32x4*)rp), f1 = __builtin_bit_cast(bf16x8, *(const LAS u32x4*)(rp + 64));
                acc[nt] = __builtin_amdgcn_mfma_f32_16x16x32_bf16(c0, f0, acc[nt], 0, 0, 0); acc[nt] = __builtin_amdgcn_mfma_f32_16x16x32_bf16(c1, f1, acc[nt], 0, 0, 0); } }
    }
    float rs[4];
#pragma unroll
    for (int j = 0; j < 4; ++j) rs[j] = rsqrtf(ssq[16 * w + 4 * fq + j] * (1.f / 2048.f) + EPS);
    LAS unsigned char* qt = lds + QT_OFF;
#pragma unroll
    for (int nt = 0; nt < 8; ++nt)
#pragma unroll
        for (int j = 0; j < 4; ++j) *(LAS bf16_t*)(qt + (16 * w + 4 * fq + j) * QT_STRIDE + 2 * (16 * nt + fr)) = (bf16_t)(cvt_pk_bf16(acc[nt][j] * rs[j], 0.f) & 0xffffu);
    __syncthreads();
#pragma unroll
    for (int k4 = 0; k4 < 4; ++k4) qf[k4] = __builtin_bit_cast(bf16x8, *(const LAS u32x4*)(qt + (16 * w + fr) * QT_STRIDE + 2 * (32 * k4 + 8 * fq)));
}

__device__ __forceinline__ void hg_gates(const unsigned (&fw)[8], float lb0, float lb1, LAS float* psum, int tid, float (&f)[2][8], float (&b)[2][8], float (&tot)[2]) {
    const int k0 = 2 * (tid & 63), part = tid >> 6;
    float r0 = 0.f, r1 = 0.f;
#pragma unroll
    for (int cc = 0; cc < 8; ++cc) { const float f0 = lb0 + (1.f - lb0) * sigm(bflo(fw[cc])), f1 = lb1 + (1.f - lb1) * sigm(bfhi(fw[cc]));
        f[0][cc] = f0; f[1][cc] = f1; r0 += __logf(f0); r1 += __logf(f1); b[0][cc] = r0; b[1][cc] = r1; }
    psum[part * 128 + k0] = r0; psum[part * 128 + k0 + 1] = r1;
    __syncthreads();
    float off0 = 0.f, off1 = 0.f, t0 = 0.f, t1 = 0.f;
#pragma unroll
    for (int p = 0; p < 8; ++p) { const float a0 = psum[p * 128 + k0], a1 = psum[p * 128 + k0 + 1]; if (p < part) { off0 += a0; off1 += a1; } t0 += a0; t1 += a1; }
#pragma unroll
    for (int cc = 0; cc < 8; ++cc) { b[0][cc] += off0; b[1][cc] += off1; }
    tot[0] = t0; tot[1] = t1;
}
constexpr int HS = 36;
__device__ __forceinline__ void hg_write_vt(const u32x4 x, const u32x4 y, LAS unsigned* VTh, int tid) {
    const int p = tid & 31, ch = tid >> 5;
    LAS unsigned* d = VTh + (8 * ch) * HS + p;
    d[0 * HS] = (x.x & 0xffffu) | (y.x << 16); d[1 * HS] = (x.x >> 16) | (y.x & 0xffff0000u);
    d[2 * HS] = (x.y & 0xffffu) | (y.y << 16); d[3 * HS] = (x.y >> 16) | (y.y & 0xffff0000u);
    d[4 * HS] = (x.z & 0xffffu) | (y.z << 16); d[5 * HS] = (x.z >> 16) | (y.z & 0xffff0000u);
    d[6 * HS] = (x.w & 0xffffu) | (y.w << 16); d[7 * HS] = (x.w >> 16) | (y.w & 0xffff0000u);
}
struct HgIn { unsigned fw[8]; u32x4 x, y; float lb0, lb1; };
__device__ __forceinline__ void hg_load(HgIn& I, const bf16_t* hg, const float* lbp, int hu, int tid) {
    const int bh = hu >> 5, n = hu & 31, b_ = bh >> 3, h = bh & 7, row0 = b_ * 2048 + n * 64; const int k0 = 2 * (tid & 63), part = tid >> 6;
#pragma unroll
    for (int cc = 0; cc < 8; ++cc) I.fw[cc] = *(const unsigned*)(hg + (size_t)(row0 + part * 8 + cc) * 4096 + 1024 + h * 128 + k0);
    const bf16_t* src = hg + (size_t)(row0 + 2 * (tid & 31)) * 4096 + 2048 + h * 128 + 8 * (tid >> 5);
    I.x = *(const u32x4*)src; I.y = *(const u32x4*)(src + 4096);
    I.lb0 = lbp[h * 128 + k0]; I.lb1 = lbp[h * 128 + k0 + 1];
}
__device__ __forceinline__ void hg_kv_phase(LAS unsigned char* lds, const bf16_t* hg, const float* lbp, bf16_t* ST, float* DEC, int tid, int bid, int G) {
    const int lane = tid & 63, w = tid >> 6, fr = lane & 15, fq = lane >> 4;
    LAS unsigned* VTh = (LAS unsigned*)lds;
    LAS unsigned* KDT = (LAS unsigned*)(lds + 18432);
    LAS float* psum = (LAS float*)(lds + 36864);
    const int k0 = 2 * (tid & 63), part = tid >> 6;
    HgIn I; if (bid < 1024) hg_load(I, hg, lbp, bid, tid);
    for (int hu = bid; hu < 1024; hu += G) {
        __syncthreads();
        hg_write_vt(I.x, I.y, VTh, tid);
        float f[2][8], b[2][8], tot[2];
        hg_gates(I.fw, I.lb0, I.lb1, psum, tid, f, b, tot);
        if (hu + G < 1024) hg_load(I, hg, lbp, hu + G, tid);
#pragma unroll
        for (int q = 0; q < 2; ++q) { float kd[8];
#pragma unroll
            for (int cc = 0; cc < 8; ++cc) kd[cc] = (1.f - f[q][cc]) * __expf(tot[q] - b[q][cc]);
            u32x4 wv; wv.x = cvt_pk_bf16(kd[0], kd[1]); wv.y = cvt_pk_bf16(kd[2], kd[3]); wv.z = cvt_pk_bf16(kd[4], kd[5]); wv.w = cvt_pk_bf16(kd[6], kd[7]);
            *(LAS u32x4*)(KDT + (k0 + q) * HS + 4 * part) = wv; }
        if (part == 0) { DEC[(size_t)hu * 128 + k0] = __expf(tot[0]); DEC[(size_t)hu * 128 + k0 + 1] = __expf(tot[1]); }
        __syncthreads();
        bf16x8 af[2];
#pragma unroll
        for (int k2 = 0; k2 < 2; ++k2) af[k2] = __builtin_bit_cast(bf16x8, *(const LAS u32x4*)(VTh + (16 * w + fr) * HS + 16 * k2 + 4 * fq));
        bf16_t* stp = ST + (size_t)hu * 16384 + (size_t)(16 * w + 4 * fq) * 128 + fr;
#pragma unroll
        for (int nt = 0; nt < 8; ++nt) { f32x4 acc = {0.f, 0.f, 0.f, 0.f};
#pragma unroll
            for (int k2 = 0; k2 < 2; ++k2) { const bf16x8 bf = __builtin_bit_cast(bf16x8, *(const LAS u32x4*)(KDT + (16 * nt + fr) * HS + 16 * k2 + 4 * fq)); acc = __builtin_amdgcn_mfma_f32_16x16x32_bf16(af[k2], bf, acc, 0, 0, 0); }
#pragma unroll
            for (int j = 0; j < 4; ++j) { const float nb = __shfl_down(acc[j], 1); if (!(fr & 1)) *(unsigned*)(stp + j * 128 + 16 * nt) = cvt_pk_bf16(acc[j], nb); } }
    }
}
constexpr int QS = 68;
__device__ __forceinline__ void hg_out_phase(LAS unsigned char* lds, const bf16_t* hg, const float* lbp, const float* hg_norm_w, const bf16_t* STB, bf16_t* OHG, int tid, int bid, int G) {
    const int lane = tid & 63, w = tid >> 6, fr = lane & 15, fq = lane >> 4;
    LAS unsigned* VTh = (LAS unsigned*)lds;
    LAS unsigned* QD = (LAS unsigned*)(lds + 18432);
    LAS unsigned* QM = (LAS unsigned*)(lds + 18432 + 17408);
    LAS unsigned* KM = (LAS unsigned*)(lds + 18432 + 2 * 17408);
    LAS float* psum = (LAS float*)(lds + 18432 + 3 * 17408);
    LAS float* bref = psum + 1024;
    LAS float* ssq = bref + 128;
    const int k0 = 2 * (tid & 63), part = tid >> 6, ct = w & 3, vh = w >> 2, c = 16 * ct + fr;
    HgIn I; unsigned qw[8];
    if (bid < 1024) { hg_load(I, hg, lbp, bid, tid); const int bh = bid >> 5, row0 = (bh >> 3) * 2048 + (bid & 31) * 64;
#pragma unroll
        for (int cc = 0; cc < 8; ++cc) qw[cc] = *(const unsigned*)(hg + (size_t)(row0 + part * 8 + cc) * 4096 + (bh & 7) * 128 + k0); }
    for (int hu = bid; hu < 1024; hu += G) {
        const int bh = hu >> 5, n = hu & 31, b_ = bh >> 3, h = bh & 7, row0 = b_ * 2048 + n * 64;
        u32x4 sa[4][4]; u32x2 gw[4]; f32x4 nw[4];
#pragma unroll
        for (int mi = 0; mi < 4; ++mi) { const bf16_t* sp = STB + (size_t)hu * 16384 + (size_t)(16 * (vh * 4 + mi) + fr) * 128 + 8 * fq;
#pragma unroll
            for (int k4 = 0; k4 < 4; ++k4) sa[mi][k4] = *(const u32x4*)(sp + 32 * k4);
            const int v0 = 16 * (vh * 4 + mi) + 4 * fq; gw[mi] = *(const u32x2*)(hg + (size_t)(row0 + c) * 4096 + 3072 + h * 128 + v0); nw[mi] = *(const f32x4*)(hg_norm_w + v0); }
        __syncthreads();
        hg_write_vt(I.x, I.y, VTh, tid);
        float f[2][8], b[2][8], tot[2];
        hg_gates(I.fw, I.lb0, I.lb1, psum, tid, f, b, tot);
        if (part == 4) { bref[k0] = b[0][0]; bref[k0 + 1] = b[1][0]; }
        __syncthreads();
        const float br0 = bref[k0], br1 = bref[k0 + 1];
#pragma unroll
        for (int cc = 0; cc < 8; ++cc) { const int c_ = part * 8 + cc; const float q0 = bflo(qw[cc]), q1 = bfhi(qw[cc]);
            const float e0 = __expf(b[0][cc] - br0), e1 = __expf(b[1][cc] - br1);
            QD[c_ * QS + (k0 >> 1)] = cvt_pk_bf16(q0 * __expf(b[0][cc]), q1 * __expf(b[1][cc]));
            QM[c_ * QS + (k0 >> 1)] = cvt_pk_bf16(q0 * e0, q1 * e1);
            KM[c_ * QS + (k0 >> 1)] = cvt_pk_bf16((1.f - f[0][cc]) * __builtin_amdgcn_rcpf(e0), (1.f - f[1][cc]) * __builtin_amdgcn_rcpf(e1)); }
        if (hu + G < 1024) { const int hn = hu + G; hg_load(I, hg, lbp, hn, tid); const int bhn = hn >> 5, row0n = (bhn >> 3) * 2048 + (hn & 31) * 64;
#pragma unroll
            for (int cc = 0; cc < 8; ++cc) qw[cc] = *(const unsigned*)(hg + (size_t)(row0n + part * 8 + cc) * 4096 + (bhn & 7) * 128 + k0); }
        __syncthreads();
        bf16x8 qmf[4];
#pragma unroll
        for (int k4 = 0; k4 < 4; ++k4) qmf[k4] = __builtin_bit_cast(bf16x8, *(const LAS u32x4*)(QM + (16 * ct + fr) * QS + 16 * k4 + 4 * fq));
        unsigned ap[4][2];
#pragma unroll
        for (int st = 0; st < 4; ++st) { f32x4 acc = {0.f, 0.f, 0.f, 0.f};
#pragma unroll
            for (int k4 = 0; k4 < 4; ++k4) { const bf16x8 kf = __builtin_bit_cast(bf16x8, *(const LAS u32x4*)(KM + (16 * st + fr) * QS + 16 * k4 + 4 * fq)); acc = __builtin_amdgcn_mfma_f32_16x16x32_bf16(kf, qmf[k4], acc, 0, 0, 0); }
#pragma unroll
            for (int j = 0; j < 4; ++j) { const int s_ = 16 * st + 4 * fq + j; if (s_ > c) acc[j] = 0.f; }
            ap[st][0] = cvt_pk_bf16(acc[0], acc[1]); ap[st][1] = cvt_pk_bf16(acc[2], acc[3]); }
        bf16x8 qdf[4];
#pragma unroll
        for (int k4 = 0; k4 < 4; ++k4) qdf[k4] = __builtin_bit_cast(bf16x8, *(const LAS u32x4*)(QD + (16 * ct + fr) * QS + 16 * k4 + 4 * fq));
        f32x4 o[4]; float ss = 0.f;
#pragma unroll
        for (int mi = 0; mi < 4; ++mi) { const int mt = vh * 4 + mi; f32x4 acc = {0.f, 0.f, 0.f, 0.f};
#pragma unroll
            for (int k4 = 0; k4 < 4; ++k4) acc = __builtin_amdgcn_mfma_f32_16x16x32_bf16(__builtin_bit_cast(bf16x8, sa[mi][k4]), qdf[k4], acc, 0, 0, 0);
#pragma unroll
            for (int s2 = 0; s2 < 2; ++s2) { const LAS unsigned* vr = VTh + (16 * mt + fr) * HS + 16 * s2 + 2 * fq;
                const u32x2 lo = *(const LAS u32x2*)vr, hi = *(const LAS u32x2*)(vr + 8);
                u32x4 vw; vw.x = lo.x; vw.y = lo.y; vw.z = hi.x; vw.w = hi.y;
                u32x4 pw; pw.x = ap[2 * s2][0]; pw.y = ap[2 * s2][1]; pw.z = ap[2 * s2 + 1][0]; pw.w = ap[2 * s2 + 1][1];
                acc = __builtin_amdgcn_mfma_f32_16x16x32_bf16(__builtin_bit_cast(bf16x8, vw), __builtin_bit_cast(bf16x8, pw), acc, 0, 0, 0); }
            o[mi] = acc; ss += (acc[0] * acc[0] + acc[1] * acc[1]) + (acc[2] * acc[2] + acc[3] * acc[3]); }
        ss += __shfl_xor(ss, 16); ss += __shfl_xor(ss, 32);
        if (fq == 0) ssq[vh * 64 + c] = ss;
        __syncthreads();
        const float rstd = rsqrtf((ssq[c] + ssq[64 + c]) * (1.f / 128.f) + EPS);
#pragma unroll
        for (int mi = 0; mi < 4; ++mi) { const int v0 = 16 * (vh * 4 + mi) + 4 * fq;
            u32x2 ov; ov.x = cvt_pk_bf16(o[mi][0] * rstd * nw[mi][0] * bflo(gw[mi].x), o[mi][1] * rstd * nw[mi][1] * bfhi(gw[mi].x)); ov.y = cvt_pk_bf16(o[mi][2] * rstd * nw[mi][2] * bflo(gw[mi].y), o[mi][3] * rstd * nw[mi][3] * bfhi(gw[mi].y));
            *(u32x2*)(OHG + (size_t)(row0 + c) * 1536 + 512 + h * 128 + v0) = ov; }
    }
}

#define XB_TMO      128
#define XB_XCNT(j)  (256  + 64 * (j))
#define XB_XSUB(j)  (1280 + 64 * (j))
#define XB_XGEN(j)  (2304 + 64 * (j))
#define XB_TOP      3328
#define XB_TOPGEN   3392
#define XCD_BAR_WORDS 3456
#define XB_SPIN_CAP (1u << 18)

__device__ __forceinline__ unsigned xb_ld(unsigned* p)              { return __hip_atomic_load(p, __ATOMIC_RELAXED, __HIP_MEMORY_SCOPE_AGENT); }
__device__ __forceinline__ unsigned xb_add(unsigned* p, unsigned v) { return __hip_atomic_fetch_add(p, v, __ATOMIC_RELAXED, __HIP_MEMORY_SCOPE_AGENT); }
__device__ __forceinline__ unsigned xb_xcc_id() { return (unsigned)__builtin_amdgcn_s_getreg((3 << 11) | 20) & 0xFu; }
#define XB_SPIN(cond, bar) do { unsigned _sp = 0; while (cond) { __builtin_amdgcn_s_sleep(1); \
    if ((++_sp & 255u) == 0u) { if (xb_ld(&(bar)[XB_TMO])) break; if (_sp > XB_SPIN_CAP) { atomicAdd(&(bar)[XB_TMO], 1u); break; } } } } while (0)

struct XcdBarrier {
    unsigned* bar; unsigned x;
    volatile LAS unsigned* st;
};

__device__ __forceinline__ XcdBarrier xcd_barrier_post(unsigned* bar, volatile LAS unsigned* st) {
    XcdBarrier b; b.bar = bar; b.x = xb_xcc_id(); b.st = st;
    if (threadIdx.x == 0) (void)xb_add(&bar[XB_XCNT(b.x)], 1u);
    return b;
}
__device__ __forceinline__ void xcd_barrier_complete(unsigned* bar, unsigned x, unsigned& nloc, unsigned& nx) {
    const unsigned G = gridDim.x * gridDim.y * gridDim.z;
    unsigned sum, cnt, mine, sp = 0u;
    for (;;) {
        sum = 0u; cnt = 0u; mine = 0u;
#pragma unroll
        for (unsigned j = 0; j < 16; ++j) { const unsigned c = xb_ld(&bar[XB_XCNT(j)]); sum += c; cnt += (c > 0u) ? 1u : 0u; mine = (j == x) ? c : mine; }
        if (sum == G) break;
        __builtin_amdgcn_s_sleep(1);
        if ((++sp & 255u) == 0u) { if (xb_ld(&bar[XB_TMO])) break; if (sp > XB_SPIN_CAP) { atomicAdd(&bar[XB_TMO], 1u); break; } }
    }
    nloc = mine > 0u ? mine : 1u; nx = cnt > 0u ? cnt : 1u;
}

__device__ __forceinline__ void xcd_barrier(const XcdBarrier& b) {
    asm volatile("s_waitcnt vmcnt(0)" ::: "memory");
    __syncthreads();
    if (threadIdx.x == 0) {
        unsigned* bar = b.bar;
        __builtin_amdgcn_s_waitcnt(0);
        unsigned nloc = b.st[0], nx = b.st[1];
        if (nloc == 0u) { xcd_barrier_complete(bar, b.x, nloc, nx); b.st[0] = nloc; b.st[1] = nx; }
        const unsigned old = xb_add(&bar[XB_XSUB(b.x)], 1u);
        const unsigned gen = old / nloc;
        if (old + 1u == (gen + 1u) * nloc) {
            __builtin_amdgcn_fence(__ATOMIC_RELEASE, "agent");
            asm volatile("s_waitcnt vmcnt(0)" ::: "memory");
            const unsigned og = xb_add(&bar[XB_TOP], 1u);
            const unsigned tg = og / nx;
            if (og + 1u == (tg + 1u) * nx) xb_add(&bar[XB_TOPGEN], 1u);
            else XB_SPIN(xb_ld(&bar[XB_TOPGEN]) == tg, bar);
            __builtin_amdgcn_fence(__ATOMIC_ACQUIRE, "agent");
            xb_add(&bar[XB_XGEN(b.x)], 1u);
            asm volatile("s_waitcnt vmcnt(0)" ::: "memory");
        } else {
            XB_SPIN(xb_ld(&bar[XB_XGEN(b.x)]) == gen, bar);
            __builtin_amdgcn_fence(__ATOMIC_ACQUIRE, "agent");
            asm volatile("s_waitcnt vmcnt(0)" ::: "memory");
        }
    }
    __syncthreads();
}

constexpr int NPHASE = 12;
#ifndef REP_PHASE
#define REP_PHASE -1
#endif
#define REPLOOP(k) _Pragma("nounroll") for (int rep_ = 0; rep_ < ((k) == REP_PHASE ? 2 : 1); ++rep_)
__global__ void __launch_bounds__(NTHR, 2) fwd_kernel(Args a) {
    extern __shared__ __attribute__((aligned(16))) unsigned char lds_raw[];
    LAS unsigned char* lds = (LAS unsigned char*)lds_raw;
    cg::grid_group grid = cg::this_grid();
    const int tid = threadIdx.x, G = gridDim.x, bid = blockIdx.x;
    unsigned char* ws = a.ws;
    const int lo = a.ph_lo, hi = a.ph_hi;
#define IN(k) (lo <= (k) && (k) < hi)
#define SEAM(k) do { if (IN(k) && IN((k) + 1)) { if (lo < 0) grid.sync(); else xcd_barrier(bar); } } while (0)
    if (tid < 2) ((volatile LAS unsigned*)(lds + LDS_MISC))[tid] = 0u;
    __syncthreads();
    XcdBarrier bar = xcd_barrier_post((unsigned*)(ws + WS_BAR), (volatile LAS unsigned*)(lds + LDS_MISC));
    float* sumsq = (float*)(ws + WS_SUMSQ);
    bf16_t* QKV = (bf16_t*)(ws + WS_QKV); bf16_t* HGB = (bf16_t*)(ws + WS_HG); bf16_t* GATES = (bf16_t*)(ws + WS_GATES); bf16_t* KVC = (bf16_t*)(ws + WS_KVC);
    bf16_t* OG = (bf16_t*)((unsigned char*)a.out + 32 * MiB);       float* LSE = (float*)(ws + WS_LSE); bf16_t* OCAT = (bf16_t*)(ws + WS_OCAT);
    bf16_t* ST = (bf16_t*)a.out; bf16_t* STB = (bf16_t*)(ws + WS_STB); float* DEC = (float*)(ws + WS_DEC); const float* LB = (const float*)(ws + WS_LB);
    float* PART = a.out; unsigned* FLAGS = (unsigned*)(ws + WS_FLAGS); bf16_t* MERGED = (bf16_t*)a.out; bf16_t* XB = (bf16_t*)(ws + WS_XB);
    bf16_t* QC = (bf16_t*)(ws + WS_QC); bf16_t* OC = (bf16_t*)(ws + WS_OC); bf16_t* GB = (bf16_t*)(ws + WS_G);

    if (IN(0)) REPLOOP(0) { phase_prologue(a, lds, tid); __syncthreads(); }
    SEAM(0);
    if (IN(1)) REPLOOP(1) {
        pg8::SplitOrder S; S.init((const bf16_t*)(ws + WS_HN), (const bf16_t*)(ws + WS_WIN), MTOK, 12288, 2048, 0, G, bid);
        pg8::EpiProj E{QKV, HGB, GATES, KVC};
        pg8::gemm_phase2<pg8::EpiProj, pg8::SplitOrder>(lds, S, E, PART, FLAGS, 2u * 2048u);
    }
    SEAM(1);
    const int NGEM = G >= 160 ? 80 : 0;
    if (IN(2)) REPLOOP(2) {
      { const int bid_ = bid, G_ = G;
        for (int u = bid_; u < 768; u += G_) {
            const int g_ = u >> 8, rem = u & 255; const int dsh = 2 * g_, d = 1 << dsh, nblk = 16 >> dsh;
            const int n = rem & (nblk - 1), r = (rem >> (4 - dsh)) & (d - 1), bhh = rem >> 4, b_ = bhh >> 2, hg_ = bhh & 3;
            const long row0 = (long)b_ * 2048 + (long)(n * 128) * d + r;
            const bf16_t* qb = QKV + row0 * 4608 + (g_ * 4 + hg_) * 128;
            attn_unit<true>(lds, qb, (long)d * 4608, qb + 1536, (long)d * 4608, qb + 3072, (long)d * 4608, n > 0,
                            OG + (size_t)g_ * (8192 * 512) + row0 * 512 + hg_ * 128, (long)d * 512, LSE + (size_t)g_ * (8192 * 4) + row0 * 4 + hg_, (long)d * 4, tid);
        }
        hg_kv_phase(lds, HGB, LB, ST, DEC, tid, bid_, G_);
      }
    }
    SEAM(2);
    if (IN(3)) {
        const int gt = bid * NTHR + tid, NGT = G * NTHR;
        for (int task = gt; task < 8192 * 64; task += NGT) { const int tok = task >> 6, hg_ = (task >> 4) & 3, c = task & 15;
            const float l0 = LSE[(size_t)tok * 4 + hg_], l1 = LSE[(size_t)(8192 + tok) * 4 + hg_], l2 = LSE[(size_t)(16384 + tok) * 4 + hg_];
            const float mx = fmaxf(l0, fmaxf(l1, l2)); float e0 = __expf(l0 - mx), e1 = __expf(l1 - mx), e2 = __expf(l2 - mx); const float inv = 1.f / (e0 + e1 + e2); e0 *= inv; e1 *= inv; e2 *= inv;
            const size_t off = (size_t)tok * 512 + hg_ * 128 + 8 * c;
            const u32x4 x0 = *(const u32x4*)(OG + off), x1 = *(const u32x4*)(OG + (size_t)8192 * 512 + off), x2 = *(const u32x4*)(OG + (size_t)2 * 8192 * 512 + off);
            u32x4 o;
            o.x = cvt_pk_bf16(e0 * bflo(x0.x) + e1 * bflo(x1.x) + e2 * bflo(x2.x), e0 * bfhi(x0.x) + e1 * bfhi(x1.x) + e2 * bfhi(x2.x));
            o.y = cvt_pk_bf16(e0 * bflo(x0.y) + e1 * bflo(x1.y) + e2 * bflo(x2.y), e0 * bfhi(x0.y) + e1 * bfhi(x1.y) + e2 * bfhi(x2.y));
            o.z = cvt_pk_bf16(e0 * bflo(x0.z) + e1 * bflo(x1.z) + e2 * bflo(x2.z), e0 * bfhi(x0.z) + e1 * bfhi(x1.z) + e2 * bfhi(x2.z));
            o.w = cvt_pk_bf16(e0 * bflo(x0.w) + e1 * bflo(x1.w) + e2 * bflo(x2.w), e0 * bfhi(x0.w) + e1 * bfhi(x1.w) + e2 * bfhi(x2.w));
            *(u32x4*)(OCAT + (size_t)tok * 1536 + hg_ * 128 + 8 * c) = o; }
        for (int task = gt; task < 32 * 4096; task += NGT) { const int bh = task >> 12, e4 = task & 4095;
            f32x4 S_ = {0.f, 0.f, 0.f, 0.f};
            const bf16_t* sp = ST + (size_t)bh * 32 * 16384 + 4 * e4; const float* dp = DEC + (size_t)bh * 32 * 128 + ((4 * e4) & 127); bf16_t* op = STB + (size_t)bh * 32 * 16384 + 4 * e4;
#pragma unroll 8
            for (int n = 0; n < 32; ++n) { const u32x2 kw = *(const u32x2*)(sp + (size_t)n * 16384); const f32x4 kv = {bflo(kw.x), bfhi(kw.x), bflo(kw.y), bfhi(kw.y)}; const f32x4 dc = *(const f32x4*)(dp + n * 128);
                u32x2 wv; wv.x = cvt_pk_bf16(S_[0], S_[1]); wv.y = cvt_pk_bf16(S_[2], S_[3]); *(u32x2*)(op + (size_t)n * 16384) = wv; S_ = dc * S_ + kv; } }
    }
    SEAM(3);
    if (IN(4)) REPLOOP(4) {
      if (bid < NGEM || NGEM == 0) {
        pg8::DeferOrder S{(const bf16_t*)(ws + WS_HN), (const bf16_t*)(ws + WS_WIN), 2048, bid, 80, NGEM ? NGEM : G}; pg8::EpiProj E{QKV, HGB, GATES, KVC};
        pg8::gemm_phase2<pg8::EpiProj, pg8::DeferOrder>(lds, S, E, PART, FLAGS, 2u * 2048u); __syncthreads();
      }
      if (bid >= NGEM) hg_out_phase(lds, HGB, LB, a.in[4], STB, OCAT, tid, bid - NGEM, G - NGEM);
    }
    SEAM(4);
    if (IN(5)) REPLOOP(5) {
        pg8::ChainOrder S{OCAT, (const bf16_t*)(ws + WS_WA), 1536, 8, MTOK / 256, 2048 / 256, G, bid};
        pg8::EpiMerge E{GATES, MERGED};
        pg8::gemm_phase2<pg8::EpiMerge, pg8::ChainOrder>(lds, S, E, nullptr, nullptr, 2u * 1536u);
    }
    SEAM(5);
    if (IN(6)) { pg8::SplitOrder S; S.init(MERGED, (const bf16_t*)(ws + WS_WOUT), MTOK, 2048, 2048, 0, G, bid); pg8::EpiRes<false> E{a.in[0], XB, sumsq};
        pg8::gemm_phase2<pg8::EpiRes<false>, pg8::SplitOrder>(lds, S, E, PART, FLAGS, 2u * 2048u); }
    SEAM(6);
    if (IN(8)) REPLOOP(8) {
        for (int u = bid; u < 256; u += G) { const int b_ = u >> 6, h = (u >> 4) & 3, qb = u & 15; const size_t r0 = (size_t)(b_ * 2048 + qb * 128);
            const bf16_t* kb = KVC + (size_t)(b_ * 256 + 128) * 1024 + h * 128;
            bf16x8 qf[4]; cross_q_tile(lds, XB + r0 * 2048, (const bf16_t*)(ws + WS_WQ) + (size_t)(h * 128) * 2048, sumsq + r0, tid, qf);
            attn_unit<false, true>(lds, nullptr, 512, kb, 1024, kb + 512, 1024, true, OC + r0 * 512 + h * 128, 512, nullptr, 0, tid, qf); }
    }
    SEAM(8);
    if (IN(9)) { pg8::SplitOrder S; S.init(OC, (const bf16_t*)(ws + WS_WO), MTOK, 2048, 512, 0, G, bid); pg8::EpiRes<true> E{XB, XB, sumsq + 8192};
        pg8::gemm_phase2<pg8::EpiRes<true>, pg8::SplitOrder>(lds, S, E, PART, FLAGS, 2u * 512u); }
    SEAM(9);
    if (IN(10)) REPLOOP(10) { pg8::SplitOrder S; S.init(XB, (const bf16_t*)(ws + WS_W13), MTOK, 2 * DFF_, 2048, 0, G, bid); pg8::EpiSwiGLU E{sumsq + 8192, GB};
        pg8::gemm_phase2<pg8::EpiSwiGLU, pg8::SplitOrder>(lds, S, E, PART, FLAGS + 4096, 2u * 2048u); }
    SEAM(10);
    if (IN(11)) { pg8::SplitOrder S; S.init(GB, (const bf16_t*)(ws + WS_W2), MTOK, 2048, DFF_, 0, G, bid); pg8::EpiFinal E{XB, a.out, sumsq + 16384, a.in[18], FLAGS};
        pg8::gemm_phase2<pg8::EpiFinal, pg8::SplitOrder>(lds, S, E, PART, FLAGS, 2u * 5632u); }
#undef IN
#undef SEAM
}

#ifndef N_LAUNCH_MODE
#define N_LAUNCH_MODE 1
#endif
extern "C" void kernel_launch(void* const* d_in, const int* in_sizes, int n_in, void* d_out, int out_size, void* d_ws, size_t ws_size, hipStream_t stream) {
    static int grid = 0;
    if (grid == 0) {
        if (n_in != 19 || out_size != MTOK * DMODEL || ws_size < WS_END) { fprintf(stderr, "kernel_launch: unexpected problem (n_in %d out %d ws %zu)\n", n_in, out_size, ws_size); grid = -1; return; }
        int dev = 0, cus = 0, per_cu = 0;
        hipGetDevice(&dev); hipDeviceGetAttribute(&cus, hipDeviceAttributeMultiprocessorCount, dev);
        if (hipFuncSetAttribute((const void*)fwd_kernel, hipFuncAttributeMaxDynamicSharedMemorySize, LDS_BYTES) != hipSuccess) { fprintf(stderr, "kernel_launch: hipFuncSetAttribute failed\n"); grid = -1; return; }
        if (hipOccupancyMaxActiveBlocksPerMultiprocessor(&per_cu, (const void*)fwd_kernel, NTHR, LDS_BYTES) != hipSuccess || per_cu < 1) { fprintf(stderr, "kernel_launch: occupancy query gave %d\n", per_cu); per_cu = 1; }
        (void)hipGetLastError();
        grid = cus * 1;
        fprintf(stderr, "kernel_launch: grid %d (cus %d, per_cu %d)\n", grid, cus, per_cu);
    }
    if (grid < 0) return;
    if (hipMemsetAsync((char*)d_ws + WS_BAR, 0, BAR_BYTES, stream) != hipSuccess) { fprintf(stderr, "kernel_launch: memset failed\n"); return; }
    Args a{};
    for (int i = 0; i < 19; ++i) a.in[i] = (const float*)d_in[i];
    a.out = (float*)d_out; a.ws = (unsigned char*)d_ws;
#if N_LAUNCH_MODE == 1
    a.ph_lo = 0; a.ph_hi = NPHASE;
    void* args[] = {&a};
    hipError_t e = hipLaunchCooperativeKernel((const void*)fwd_kernel, dim3(grid), dim3(NTHR), args, LDS_BYTES, stream);
    if (e != hipSuccess) fprintf(stderr, "kernel_launch: cooperative launch failed: %s (grid %d)\n", hipGetErrorString(e), grid);
#else
    for (int p = 0; p < NPHASE; ++p) { a.ph_lo = p; a.ph_hi = p + 1; hipLaunchKernelGGL(fwd_kernel, dim3(grid), dim3(NTHR), LDS_BYTES, stream, a); }
#endif
}
```
